# Optimizing an MI355X kernel written in HIP

```python
import jax
import jax.numpy as jnp
from jax import lax
import numpy as np

D_MODEL = 1024
BATCH = 8
SEQ = 4096
DEPTH = 2

GRID_W = 64
CTX_LEN = 256

NA_HEAD_DIM = 64
NA_HEADS = (D_MODEL // 2) // NA_HEAD_DIM
NA_WIDTH = NA_HEADS * NA_HEAD_DIM
NA_KH = 8
NA_KW = 16
ML_HEAD_DIM = 128
ML_HEADS = (D_MODEL // 2) // ML_HEAD_DIM
ML_WIDTH = ML_HEADS * ML_HEAD_DIM
ML_CHUNK = 128
ML_GATE_CAP = 15.0
AB_IN_WIDTH = 3 * NA_WIDTH + 4 * ML_WIDTH + 4 * ML_HEADS
RW_HEAD_DIM = 64
RW_HEADS = D_MODEL // RW_HEAD_DIM
RW_DECAY_LORA = 64
RW_AAA_LORA = 64
RW_GATE_LORA = 160
RW_GN_EPS = 64e-5
D_FF = 4 * D_MODEL
ROPE_BASE = 10000.0
NORM_EPS = 1e-6

kernel_name = 'hybrid_natten_mlstm_rwkv7_dit'


def rms_norm(x, eps=NORM_EPS):
    xf = x.astype(jnp.float32)
    return (xf * lax.rsqrt(jnp.mean(xf * xf, axis=-1, keepdims=True) + eps)).astype(x.dtype)


def modulate(x, shift, scale):
    return rms_norm(x) * (1.0 + scale) + shift


def split_heads(t, n_heads, head_dim):
    return t.reshape(*t.shape[:-1], n_heads, head_dim)


def adaln(cond, w, b):
    return jnp.split(jax.nn.silu(cond) @ w + b, 6, axis=-1)


def squared_relu_mlp(h, w1, w2):
    return jnp.square(jax.nn.relu(h @ w1)) @ w2


def axial_rope_angles(n_tokens, head_dim):
    pos = jnp.arange(n_tokens)
    rows = (pos // GRID_W).astype(jnp.float32)
    cols = (pos % GRID_W).astype(jnp.float32)
    n_freq = head_dim // 4
    inv_freq = ROPE_BASE ** (-jnp.arange(n_freq, dtype=jnp.float32) / n_freq)
    return rows[:, None] * inv_freq, cols[:, None] * inv_freq


def rope_rotate(x, ang):
    x1, x2 = jnp.split(x, 2, axis=-1)
    cos = jnp.cos(ang)[:, None, :].astype(x.dtype)
    sin = jnp.sin(ang)[:, None, :].astype(x.dtype)
    return jnp.concatenate([x1 * cos - x2 * sin, x1 * sin + x2 * cos], axis=-1)


def axial_rope(x, ang_r, ang_c):
    x_row, x_col = jnp.split(x, 2, axis=-1)
    return jnp.concatenate([rope_rotate(x_row, ang_r), rope_rotate(x_col, ang_c)], axis=-1)


def context_attention(q, k, v):
    s = jnp.einsum('bqhd,bkhd->bhqk', q, k).astype(jnp.float32) * (q.shape[-1] ** -0.5)
    p = jax.nn.softmax(s, axis=-1).astype(v.dtype)
    return jnp.einsum('bhqk,bkhd->bqhd', p, v)


def neighbourhood_attention(q, k, v, k_ctx, v_ctx, rpb):
    n_b, n_tok, n_h, d_h = q.shape
    rows = n_tok // GRID_W
    kh = min(NA_KH, rows)
    n_win = kh * NA_KW
    scale = d_h ** -0.5
    qg = q.reshape(n_b, rows, GRID_W, n_h, d_h)
    kg = k.reshape(n_b, rows, GRID_W, n_h, d_h)
    vg = v.reshape(n_b, rows, GRID_W, n_h, d_h)
    row_idx = jnp.arange(rows)
    row_start = jnp.clip(row_idx - kh // 2, 0, rows - kh)
    col_idx = jnp.arange(GRID_W)
    col_win = jnp.clip(col_idx - NA_KW // 2, 0, GRID_W - NA_KW)[:, None] + jnp.arange(NA_KW)[None, :]
    rpb_c = rpb[:, :, col_win - col_idx[:, None] + NA_KW - 1]

    def one_row(args):
        r, rs, q_row = args
        k_nb = lax.dynamic_slice_in_dim(kg, rs, kh, axis=1)[:, :, col_win]
        v_nb = lax.dynamic_slice_in_dim(vg, rs, kh, axis=1)[:, :, col_win]
        bias = rpb_c[:, rs + jnp.arange(kh) - r + NA_KH - 1]
        s_nb = jnp.einsum('bchd,bicjhd->bhcij', q_row, k_nb).astype(jnp.float32) * scale + jnp.transpose(bias, (0, 2, 1, 3))
        s_cx = jnp.einsum('bchd,bnhd->bhcn', q_row, k_ctx).astype(jnp.float32) * scale
        p = jax.nn.softmax(jnp.concatenate([s_nb.reshape(n_b, n_h, GRID_W, n_win), s_cx], axis=-1), axis=-1).astype(v.dtype)
        p_nb = p[..., :n_win].reshape(n_b, n_h, GRID_W, kh, NA_KW)
        return jnp.einsum('bhcij,bicjhd->bchd', p_nb, v_nb) + jnp.einsum('bhcn,bnhd->bchd', p[..., n_win:], v_ctx)

    out = lax.map(one_row, (row_idx, row_start, jnp.moveaxis(qg, 1, 0)))
    return jnp.moveaxis(out, 0, 1).reshape(n_b, n_tok, n_h, d_h)


def mlstm_chunked(q, k, v, log_i, log_f, state, with_out):
    n_b, n_h, n_t, _ = q.shape
    n_c = n_t // ML_CHUNK

    def chunks(t):
        return jnp.moveaxis(t.reshape(n_b, n_h, n_c, ML_CHUNK, *t.shape[3:]), 2, 0)

    tril = jnp.tril(jnp.ones((ML_CHUNK, ML_CHUNK), dtype=bool))

    def step(carry, inp):
        c_st, n_st, m_st = carry
        qc, kc, vc, ic, fc = inp
        b = jnp.cumsum(fc, axis=-1)
        log_d = jnp.where(tril, b[..., :, None] - b[..., None, :] + ic[..., None, :], -jnp.inf)
        log_inter = b + m_st[..., None]
        m_t = jnp.maximum(log_inter, jnp.max(log_d, axis=-1))
        m_new = m_t[..., -1]
        w_s = jnp.exp(b[..., -1:] - b + ic - m_new[..., None])
        decay = jnp.exp(b[..., -1] + m_st - m_new)
        c_new = decay[..., None, None] * c_st + jnp.einsum('bhs,bhsd,bhse->bhde', w_s, kc, vc)
        n_new = decay[..., None] * n_st + jnp.einsum('bhs,bhsd->bhd', w_s, kc)
        if not with_out:
            return (c_new, n_new, m_new), None
        d_mat = jnp.exp(log_d - m_t[..., None])
        w_inter = jnp.exp(log_inter - m_t)
        s = jnp.einsum('bhtd,bhsd->bhts', qc, kc) * d_mat
        num = jnp.einsum('bhts,bhse->bhte', s, vc) + w_inter[..., None] * jnp.einsum('bhtd,bhde->bhte', qc, c_st)
        den = jnp.sum(s, axis=-1) + w_inter * jnp.einsum('bhtd,bhd->bht', qc, n_st)
        h = num / jnp.maximum(jnp.abs(den), jnp.exp(-m_t))[..., None]
        return (c_new, n_new, m_new), h

    state, hs = lax.scan(step, state, tuple(chunks(t) for t in (q, k, v, log_i, log_f)))
    if not with_out:
        return None, state
    return jnp.moveaxis(hs, 0, 2).reshape(n_b, n_h, n_t, -1), state


def mlstm_bidir(q_l, k_l, v_l, g_l, q_c, k_c, v_c, g_c, need_ctx):
    def heads_first(t):
        return jnp.swapaxes(t, 1, 2).astype(jnp.float32)

    def gates(g):
        g = ML_GATE_CAP * jnp.tanh(g.astype(jnp.float32) / ML_GATE_CAP)
        i_f, f_f, i_b, f_b = jnp.split(jnp.swapaxes(g, 1, 2), 4, axis=1)
        return i_f, jax.nn.log_sigmoid(f_f), i_b, jax.nn.log_sigmoid(f_b)

    def flip(t):
        return jnp.flip(t, axis=2)

    n_b = q_l.shape[0]
    zero = (jnp.zeros((n_b, ML_HEADS, ML_HEAD_DIM, ML_HEAD_DIM), jnp.float32),
            jnp.zeros((n_b, ML_HEADS, ML_HEAD_DIM), jnp.float32),
            jnp.zeros((n_b, ML_HEADS), jnp.float32))
    qc, kc, vc = heads_first(q_c), heads_first(k_c), heads_first(v_c)
    if_c, lf_c, ib_c, lb_c = gates(g_c)
    hc_f, st_f = mlstm_chunked(qc, kc, vc, if_c, lf_c, zero, need_ctx)
    hc_b, st_b = mlstm_chunked(flip(qc), flip(kc), flip(vc), flip(ib_c), flip(lb_c), zero, need_ctx)
    ql, kl, vl = heads_first(q_l), heads_first(k_l), heads_first(v_l)
    if_l, lf_l, ib_l, lb_l = gates(g_l)
    hl_f, _ = mlstm_chunked(ql, kl, vl, if_l, lf_l, st_f, True)
    hl_b, _ = mlstm_chunked(flip(ql), flip(kl), flip(vl), flip(ib_l), flip(lb_l), st_b, True)
    h_lat = jnp.swapaxes(hl_f + flip(hl_b), 1, 2)
    h_ctx = jnp.swapaxes(hc_f + flip(hc_b), 1, 2) if need_ctx else None
    return h_lat, h_ctx


def ab_mixer(h_l, h_c, w_in, gate_b, q_norm, k_norm, rpb, head_norm, w_out, ang_r, ang_c, need_ctx):
    splits = [NA_WIDTH, 2 * NA_WIDTH, 3 * NA_WIDTH, 3 * NA_WIDTH + ML_WIDTH, 3 * NA_WIDTH + 2 * ML_WIDTH,
              3 * NA_WIDTH + 3 * ML_WIDTH, 3 * NA_WIDTH + 4 * ML_WIDTH]

    def project(h):
        qa, ka, va, qb, kb, vb, ob, g = jnp.split(h @ w_in, splits, axis=-1)
        qa = rms_norm(split_heads(qa, NA_HEADS, NA_HEAD_DIM)) * q_norm
        ka = rms_norm(split_heads(ka, NA_HEADS, NA_HEAD_DIM)) * k_norm
        va = split_heads(va, NA_HEADS, NA_HEAD_DIM)
        qb = split_heads(qb, ML_HEADS, ML_HEAD_DIM)
        kb = split_heads(kb, ML_HEADS, ML_HEAD_DIM) * (ML_HEAD_DIM ** -0.5)
        vb = split_heads(vb, ML_HEADS, ML_HEAD_DIM)
        return qa, ka, va, qb, kb, vb, ob, g + gate_b

    qa_l, ka_l, va_l, qb_l, kb_l, vb_l, ob_l, g_l = project(h_l)
    qa_c, ka_c, va_c, qb_c, kb_c, vb_c, ob_c, g_c = project(h_c)
    qb_l = axial_rope(qb_l, ang_r, ang_c)
    kb_l = axial_rope(kb_l, ang_r, ang_c)
    na_l = neighbourhood_attention(qa_l, ka_l, va_l, ka_c, va_c, rpb)
    ml_l, ml_c = mlstm_bidir(qb_l, kb_l, vb_l, g_l, qb_c, kb_c, vb_c, g_c, need_ctx)

    def merge(na, ml, o):
        ml = (rms_norm(ml) * head_norm).astype(o.dtype) * jax.nn.sigmoid(split_heads(o, ML_HEADS, ML_HEAD_DIM))
        cat = jnp.concatenate([na.reshape(*na.shape[:2], NA_WIDTH), ml.reshape(*ml.shape[:2], ML_WIDTH)], axis=-1)
        return cat @ w_out

    out_l = merge(na_l, ml_l, ob_l)
    out_c = merge(context_attention(qa_c, ka_c, va_c), ml_c, ob_c) if need_ctx else None
    return out_l, out_c


def centred_shift(x):
    xp = jnp.pad(x, ((0, 0), (1, 1), (0, 0)))
    return 0.5 * (xp[:, :-2] + xp[:, 2:])


def rwkv_prepare(h, mu, w_rkv, w0, w1, w2, a0, a1, a2, g1, g2, k_k, k_a):
    xx = centred_shift(h) - h
    xr, xw, xk, xv, xa, xg = h[None] + xx[None] * mu[:, None, None, :]
    r, k, v = jnp.einsum('sbtd,sde->sbte', jnp.stack([xr, xk, xv]), w_rkv)
    w_logit = w0[:, None, None, :] + jnp.einsum('zbtr,zrd->zbtd', jnp.tanh(jnp.einsum('btd,zdr->zbtr', xw, w1)), w2)
    decay = jnp.exp(-jnp.exp(-jax.nn.softplus(-w_logit.astype(jnp.float32)) - 0.5))
    a = jax.nn.sigmoid(a0[:, None, None, :] + jnp.einsum('zbtr,zrd->zbtd', jnp.einsum('btd,zdr->zbtr', xa, a1), a2))
    g = jax.nn.sigmoid(xg @ g1) @ g2
    kk = split_heads((k * k_k).astype(jnp.float32), RW_HEADS, RW_HEAD_DIM)
    kk = (kk / jnp.maximum(jnp.linalg.norm(kk, axis=-1, keepdims=True), 1e-12)).reshape(k.shape)
    k_dir = k[None] * (1.0 + (a - 1.0) * k_a)
    return r, k_dir, v, decay, -kk, kk[None] * a, g


def rwkv7_scan(r, w, k, v, a, b, state, reverse, with_out):
    def time_major(t):
        return jnp.moveaxis(split_heads(t.astype(jnp.float32), RW_HEADS, RW_HEAD_DIM), 1, 0)

    def step(s, inp):
        rt, wt, kt, vt, at, bt = inp
        sa = jnp.einsum('bhij,bhj->bhi', s, at)
        s = s * wt[:, :, None, :] + sa[..., None] * bt[:, :, None, :] + vt[..., None] * kt[:, :, None, :]
        y = jnp.einsum('bhij,bhj->bhi', s, rt) if with_out else None
        return s, y

    state, ys = lax.scan(step, state, tuple(time_major(t) for t in (r, w, k, v, a, b)), reverse=reverse)
    return (jnp.moveaxis(ys, 0, 1) if with_out else None), state


def rwkv_mixer(h_l, h_c, mu, w_rkv, w0, w1, w2, a0, a1, a2, g1, g2, k_k, k_a, r_k, lnx_w, lnx_b, w_o, need_ctx):
    lat = rwkv_prepare(h_l, mu, w_rkv, w0, w1, w2, a0, a1, a2, g1, g2, k_k, k_a)
    cxt = rwkv_prepare(h_c, mu, w_rkv, w0, w1, w2, a0, a1, a2, g1, g2, k_k, k_a)
    s0 = jnp.zeros((h_l.shape[0], RW_HEADS, RW_HEAD_DIM, RW_HEAD_DIM), jnp.float32)

    def bidir(p, s_f, s_b, with_out):
        r, k_dir, v, decay, a, b_dir, _ = p
        y_f, s_f = rwkv7_scan(r, decay[0], k_dir[0], v, a, b_dir[0], s_f, False, with_out)
        y_b, s_b = rwkv7_scan(r, decay[1], k_dir[1], v, a, b_dir[1], s_b, True, with_out)
        return y_f, y_b, s_f, s_b

    yc_f, yc_b, st_f, st_b = bidir(cxt, s0, s0, need_ctx)
    yl_f, yl_b, _, _ = bidir(lat, st_f, st_b, True)

    def readout(p, y_f, y_b):
        r, k_dir, v, _, _, _, g = p
        y = y_f + y_b
        mean = jnp.mean(y, axis=-1, keepdims=True)
        var = jnp.mean(jnp.square(y - mean), axis=-1, keepdims=True)
        y = ((y - mean) * lax.rsqrt(var + RW_GN_EPS)).reshape(r.shape) * lnx_w + lnx_b
        coef = jnp.sum(split_heads(r, RW_HEADS, RW_HEAD_DIM)[None] * split_heads(k_dir, RW_HEADS, RW_HEAD_DIM)
                       * split_heads(r_k, RW_HEADS, RW_HEAD_DIM), axis=(0, -1))[..., None]
        bonus = (coef * split_heads(v, RW_HEADS, RW_HEAD_DIM)).reshape(r.shape)
        return ((y + bonus) * g).astype(h_l.dtype) @ w_o

    out_l = readout(lat, yl_f, yl_b)
    out_c = readout(cxt, yc_f, yc_b) if need_ctx else None
    return out_l, out_c


def setup_inputs(seed: int = 0) -> dict:
    key = jax.random.key(seed)
    keys = iter(jax.random.split(key, 48))
    n_even = (DEPTH + 1) // 2
    n_odd = DEPTH // 2
    d = D_MODEL

    def normal(shape, scale):
        return scale * jax.random.normal(next(keys), shape, jnp.float32)

    def uniform(shape, lo, hi):
        return jax.random.uniform(next(keys), shape, jnp.float32, lo, hi)

    ab_gate_b = jnp.concatenate([normal((n_even, ML_HEADS), 0.1), uniform((n_even, ML_HEADS), 3.0, 6.0),
                                 normal((n_even, ML_HEADS), 0.1), uniform((n_even, ML_HEADS), 3.0, 6.0)], axis=-1)
    return {
        'x': normal((BATCH, SEQ, d), 1.0),
        'c': normal((BATCH, d), 1.0),
        'ctx': normal((BATCH, CTX_LEN, d), 1.0),
        'c_ctx': normal((d,), 1.0),
        'ada_w': normal((DEPTH, d, 6 * d), 0.5 * d ** -0.5),
        'ada_b': normal((DEPTH, 6 * d), 0.02),
        'ab_w_in': normal((n_even, d, AB_IN_WIDTH), d ** -0.5),
        'ab_gate_b': ab_gate_b,
        'na_q_norm': 1.0 + normal((n_even, NA_HEAD_DIM), 0.05),
        'na_k_norm': 1.0 + normal((n_even, NA_HEAD_DIM), 0.05),
        'na_rpb': normal((n_even, NA_HEADS, 2 * NA_KH - 1, 2 * NA_KW - 1), 0.1),
        'ml_head_norm': 1.0 + normal((n_even, ML_HEADS, ML_HEAD_DIM), 0.05),
        'ab_w_out': normal((n_even, d, d), d ** -0.5),
        'rw_mu': uniform((n_odd, 6, d), 0.0, 1.0),
        'rw_w_rkv': normal((n_odd, 3, d, d), d ** -0.5),
        'rw_w0': uniform((n_odd, 2, d), -6.0, -1.0),
        'rw_w1': normal((n_odd, 2, d, RW_DECAY_LORA), 0.1 * d ** -0.5),
        'rw_w2': normal((n_odd, 2, RW_DECAY_LORA, d), 0.1 * RW_DECAY_LORA ** -0.5),
        'rw_a0': normal((n_odd, 2, d), 0.1),
        'rw_a1': normal((n_odd, 2, d, RW_AAA_LORA), d ** -0.5),
        'rw_a2': normal((n_odd, 2, RW_AAA_LORA, d), 0.5 * RW_AAA_LORA ** -0.5),
        'rw_g1': normal((n_odd, d, RW_GATE_LORA), d ** -0.5),
        'rw_g2': normal((n_odd, RW_GATE_LORA, d), RW_GATE_LORA ** -0.5),
        'rw_k_k': 0.85 + normal((n_odd, d), 0.05),
        'rw_k_a': 1.0 + normal((n_odd, d), 0.05),
        'rw_r_k': normal((n_odd, d), 0.1),
        'rw_lnx_w': 1.0 + normal((n_odd, d), 0.05),
        'rw_lnx_b': normal((n_odd, d), 0.02),
        'rw_w_o': normal((n_odd, d, d), d ** -0.5),
        'mlp_w1': normal((DEPTH, d, D_FF), d ** -0.5),
        'mlp_w2': normal((DEPTH, D_FF, d), D_FF ** -0.5),
    }


def reference(x, c, ctx, c_ctx, ada_w, ada_b, ab_w_in, ab_gate_b, na_q_norm, na_k_norm, na_rpb, ml_head_norm,
              ab_w_out, rw_mu, rw_w_rkv, rw_w0, rw_w1, rw_w2, rw_a0, rw_a1, rw_a2, rw_g1, rw_g2, rw_k_k, rw_k_a,
              rw_r_k, rw_lnx_w, rw_lnx_b, rw_w_o, mlp_w1, mlp_w2):
    ang_r, ang_c = axial_rope_angles(x.shape[1], ML_HEAD_DIM)
    for layer in range(DEPTH):
        need_ctx = layer < DEPTH - 1
        j = layer // 2
        sh_a, sc_a, gt_a, sh_m, sc_m, gt_m = adaln(c[:, None, :], ada_w[layer], ada_b[layer])
        csh_a, csc_a, cgt_a, csh_m, csc_m, cgt_m = adaln(c_ctx, ada_w[layer], ada_b[layer])
        h_l = modulate(x, sh_a, sc_a)
        h_c = modulate(ctx, csh_a, csc_a)
        if layer % 2 == 0:
            o_l, o_c = ab_mixer(h_l, h_c, ab_w_in[j], ab_gate_b[j], na_q_norm[j], na_k_norm[j], na_rpb[j],
                                ml_head_norm[j], ab_w_out[j], ang_r, ang_c, need_ctx)
        else:
            o_l, o_c = rwkv_mixer(h_l, h_c, rw_mu[j], rw_w_rkv[j], rw_w0[j], rw_w1[j], rw_w2[j], rw_a0[j],
                                  rw_a1[j], rw_a2[j], rw_g1[j], rw_g2[j], rw_k_k[j], rw_k_a[j], rw_r_k[j],
                                  rw_lnx_w[j], rw_lnx_b[j], rw_w_o[j], need_ctx)
        x = x + gt_a * o_l
        x = x + gt_m * squared_relu_mlp(modulate(x, sh_m, sc_m), mlp_w1[layer], mlp_w2[layer])
        if need_ctx:
            ctx = ctx + cgt_a * o_c
            ctx = ctx + cgt_m * squared_relu_mlp(modulate(ctx, csh_m, csc_m), mlp_w1[layer], mlp_w2[layer])
    return x
```

```cpp
#include <hip/hip_runtime.h>
#include <hip/hip_cooperative_groups.h>
#include <cstdio>
namespace cg = cooperative_groups;

#ifndef ONE_LAUNCH
#define ONE_LAUNCH 1
#endif

typedef unsigned short u16;
typedef unsigned char u8;
typedef __attribute__((ext_vector_type(8))) short s16x8;
typedef __attribute__((ext_vector_type(4))) float f32x4;

constexpr int D = 1024, NB = 8, T = 4096, CT = 256;
constexpr int ML = NB * T;
constexpr int MC = NB * CT;
constexpr int MA = ML + MC;
constexpr int NTHREADS = 512;
constexpr size_t SLOT = (size_t)MA * 1024 * 2;
constexpr size_t HALF = (size_t)MA * 512;
constexpr int LDS_BYTES = 122880;
constexpr int NPHASES = 19;

struct Params {
    const float* in[31];
    float* out;
    u16* slot[6];
    u16 *w1t[2], *w2t[2], *rkvt, *wot, *lw1t, *la1t, *lg1t, *lw2t, *la2t, *lg2t, *wint, *woutt;
    float *mod, *ropec, *ropes, *gates, *ctxres, *mbc, *mmc, *mst, *mnu, *knorm, *coef;
    u16 *hw, *ha, *hg;
    int ph_lo, ph_hi;
};

__device__ __forceinline__ u16 f2bf(float f) { unsigned u = __float_as_uint(f); u += 0x7fffu + ((u >> 16) & 1u); return (u16)(u >> 16); }
__device__ __forceinline__ float bf2f(u16 h) { return __uint_as_float(((unsigned)h) << 16); }
__device__ __forceinline__ unsigned pack2(float a, float b) { return (unsigned)f2bf(a) | ((unsigned)f2bf(b) << 16); }
__device__ __forceinline__ float lo2f(unsigned u) { return __uint_as_float(u << 16); }
__device__ __forceinline__ float hi2f(unsigned u) { return __uint_as_float(u & 0xffff0000u); }
__device__ __forceinline__ s16x8 as_frag(uint4 v) { return __builtin_bit_cast(s16x8, v); }
__device__ __forceinline__ f32x4 mfma16(s16x8 a, s16x8 b, f32x4 c) { return __builtin_amdgcn_mfma_f32_16x16x32_bf16(a, b, c, 0, 0, 0); }
__device__ __forceinline__ float sigmoidf_(float x) { return 1.f / (1.f + __expf(-x)); }
__device__ __forceinline__ float wave_sum(float v) {
#pragma unroll
    for (int o = 1; o < 64; o <<= 1) v += __shfl_xor(v, o);
    return v;
}
template <int CTRL> __device__ __forceinline__ float dppf(float x) {
    return __int_as_float(__builtin_amdgcn_update_dpp(0, __float_as_int(x), CTRL, 0xf, 0xf, true));
}
__device__ __forceinline__ float sum16(float x) {
    x += dppf<0xB1>(x); x += dppf<0x4E>(x); x += dppf<0x141>(x); x += dppf<0x140>(x);
    return x;
}
__device__ __forceinline__ float* resptr(const Params& P, int m) {
    return m < ML ? P.out + (size_t)m * 1024 : P.ctxres + (size_t)(m - ML) * 1024;
}
__device__ __forceinline__ const float* modrow(const Params& P, int layer, int m) {
    return P.mod + (size_t)(layer * 9 + (m < ML ? (m >> 12) : 8)) * 6144;
}

struct TJob { const float* src; u16* dst; int K, N, Kpad, Npad; };
__device__ __forceinline__ bool get_tjob(const Params& P, int j, TJob& t) {
    switch (j) {
    case 0: t = {P.in[6], P.wint, 1024, 3600, 1024, 3712}; return true;
    case 1: t = {P.in[12], P.woutt, 1024, 1024, 1024, 1024}; return true;
    case 2: t = {P.in[29], P.w1t[0], 1024, 4096, 1024, 4096}; return true;
    case 3: t = {P.in[29] + (size_t)1024 * 4096, P.w1t[1], 1024, 4096, 1024, 4096}; return true;
    case 4: t = {P.in[30], P.w2t[0], 4096, 1024, 4096, 1024}; return true;
    case 5: t = {P.in[30] + (size_t)1024 * 4096, P.w2t[1], 4096, 1024, 4096, 1024}; return true;
    case 6: t = {P.in[14], P.rkvt, 1024, 1024, 1024, 1024}; return true;
    case 7: t = {P.in[14] + (size_t)1024 * 1024, P.rkvt + (size_t)1024 * 1024, 1024, 1024, 1024, 1024}; return true;
    case 8: t = {P.in[14] + (size_t)2 * 1024 * 1024, P.rkvt + (size_t)2 * 1024 * 1024, 1024, 1024, 1024, 1024}; return true;
    case 9: t = {P.in[28], P.wot, 1024, 1024, 1024, 1024}; return true;
    case 10: t = {P.in[16], P.lw1t, 1024, 64, 1024, 64}; return true;
    case 11: t = {P.in[16] + 1024 * 64, P.lw1t + 64 * 1024, 1024, 64, 1024, 64}; return true;
    case 12: t = {P.in[19], P.la1t, 1024, 64, 1024, 64}; return true;
    case 13: t = {P.in[19] + 1024 * 64, P.la1t + 64 * 1024, 1024, 64, 1024, 64}; return true;
    case 14: t = {P.in[21], P.lg1t, 1024, 160, 1024, 256}; return true;
    case 15: t = {P.in[17], P.lw2t, 64, 1024, 64, 1024}; return true;
    case 16: t = {P.in[17] + 64 * 1024, P.lw2t + 1024 * 64, 64, 1024, 64, 1024}; return true;
    case 17: t = {P.in[20], P.la2t, 64, 1024, 64, 1024}; return true;
    case 18: t = {P.in[20] + 64 * 1024, P.la2t + 1024 * 64, 64, 1024, 64, 1024}; return true;
    case 19: t = {P.in[22], P.lg2t, 160, 1024, 192, 1024}; return true;
    default: return false;
    }
}

__device__ __forceinline__ void phase_prep(const Params& P, char* smem) {
    const int tid = threadIdx.x, lane = tid & 63, wave = tid >> 6;
    float* tile = (float*)smem;
    int ubase = 0;
    for (int j = 0; j < 20; ++j) {
        TJob t; get_tjob(P, j, t);
        const int kt = t.Kpad / 64, nt = t.Npad / 64, nu = kt * nt;
        int first = ((int)blockIdx.x - (ubase % (int)gridDim.x) + (int)gridDim.x) % (int)gridDim.x;
        for (int lu = first; lu < nu; lu += gridDim.x) {
            const int k0 = (lu % kt) * 64, n0 = (lu / kt) * 64;
            __syncthreads();
#pragma unroll
            for (int i = 0; i < 2; ++i) {
                int kr = (tid >> 4) + 32 * i, nc = (tid & 15) * 4;
                int k = k0 + kr, n = n0 + nc;
                float4 v = make_float4(0.f, 0.f, 0.f, 0.f);
                if (k < t.K && n < t.N) v = *(const float4*)(t.src + (size_t)k * t.N + n);
                tile[kr * 65 + nc + 0] = v.x; tile[kr * 65 + nc + 1] = v.y; tile[kr * 65 + nc + 2] = v.z; tile[kr * 65 + nc + 3] = v.w;
            }
            __syncthreads();
            {
                int n = tid >> 3, kc = (tid & 7) * 8;
                uint4 o;
                o.x = pack2(tile[(kc + 0) * 65 + n], tile[(kc + 1) * 65 + n]);
                o.y = pack2(tile[(kc + 2) * 65 + n], tile[(kc + 3) * 65 + n]);
                o.z = pack2(tile[(kc + 4) * 65 + n], tile[(kc + 5) * 65 + n]);
                o.w = pack2(tile[(kc + 6) * 65 + n], tile[(kc + 7) * 65 + n]);
                *(uint4*)(t.dst + (size_t)(n0 + n) * t.Kpad + k0 + kc) = o;
            }
        }
        ubase += nu;
    }
    if (blockIdx.x == 0) {
        for (int e = tid; e < 64 * 32; e += NTHREADS) {
            int pos = e >> 5, f = e & 31;
            float inv = powf(10000.f, -(float)f / 32.f);
            float ang = (float)pos * inv;
            P.ropec[e] = cosf(ang); P.ropes[e] = sinf(ang);
        }
    }
    const float* c = P.in[1]; const float* cctx = P.in[3];
    const int gw = blockIdx.x * 8 + wave, nw = gridDim.x * 8;
    for (int u = gw; u < 2 * 384; u += nw) {
        const int l = u / 384, n0 = (u % 384) * 16;
        const int ksub = lane >> 2, nq = lane & 3;
        const float* W = P.in[4] + (size_t)l * 1024 * 6144 + n0 + nq * 4;
        float acc[9][4];
#pragma unroll
        for (int r = 0; r < 9; ++r) { acc[r][0] = acc[r][1] = acc[r][2] = acc[r][3] = 0.f; }
#pragma unroll 4
        for (int it = 0; it < 64; ++it) {
            const int k = it * 16 + ksub;
            float4 w = *(const float4*)(W + (size_t)k * 6144);
#pragma unroll
            for (int r = 0; r < 9; ++r) {
                float cv = (r < 8) ? c[r * 1024 + k] : cctx[k];
                cv = cv / (1.f + __expf(-cv));
                acc[r][0] += cv * w.x; acc[r][1] += cv * w.y; acc[r][2] += cv * w.z; acc[r][3] += cv * w.w;
            }
        }
#pragma unroll
        for (int r = 0; r < 9; ++r)
#pragma unroll
            for (int q = 0; q < 4; ++q) {
                float v = acc[r][q];
                v += __shfl_xor(v, 4); v += __shfl_xor(v, 8); v += __shfl_xor(v, 16); v += __shfl_xor(v, 32);
                acc[r][q] = v;
            }
        if (ksub == 0) {
#pragma unroll
            for (int r = 0; r < 9; ++r)
#pragma unroll
                for (int q = 0; q < 4; ++q) {
                    int n = n0 + nq * 4 + q;
                    P.mod[(size_t)(l * 9 + r) * 6144 + n] = acc[r][q] + P.in[5][l * 6144 + n];
                }
        }
    }
}

__device__ __forceinline__ void phase_norm(const Params& P, int which, u16* dst, int nrows) {
    const int lane = threadIdx.x & 63, wave = threadIdx.x >> 6;
    const int layer = which >> 1, shc = (which & 1) ? 3 : 0;
    for (int m = blockIdx.x * 8 + wave; m < nrows; m += gridDim.x * 8) {
        const float* src;
        if (which == 0) src = (m < ML) ? P.in[0] + (size_t)m * 1024 : P.in[2] + (size_t)(m - ML) * 1024;
        else src = resptr(P, m);
        float4 v[4];
        float ss = 0.f;
#pragma unroll
        for (int i = 0; i < 4; ++i) {
            v[i] = ((const float4*)src)[lane + 64 * i];
            ss += v[i].x * v[i].x + v[i].y * v[i].y + v[i].z * v[i].z + v[i].w * v[i].w;
        }
        ss = wave_sum(ss);
        const float rinv = rsqrtf(ss * (1.f / 1024.f) + 1e-6f);
        const float* mr = modrow(P, layer, m);
#pragma unroll
        for (int i = 0; i < 4; ++i) {
            const int col = (lane + 64 * i) * 4;
            float4 sh = *(const float4*)(mr + shc * 1024 + col);
            float4 sc = *(const float4*)(mr + (shc + 1) * 1024 + col);
            uint2 o;
            o.x = pack2(v[i].x * rinv * (1.f + sc.x) + sh.x, v[i].y * rinv * (1.f + sc.y) + sh.y);
            o.y = pack2(v[i].z * rinv * (1.f + sc.z) + sh.z, v[i].w * rinv * (1.f + sc.w) + sh.w);
            *(uint2*)(dst + (size_t)m * 1024 + col) = o;
        }
    }
}

constexpr int BM = 256, BN = 128, BK = 64, LDK = 72;
enum { E_INPROJ = 1, E_OUT0, E_MLPUP, E_MLPDN, E_R, E_K, E_V, E_HW, E_HA, E_HG, E_E, E_A, E_GZ, E_RWOUT };

struct Epi {
    int mode, layer, z;
    u16* o16;
    int ldo;
};

__device__ __forceinline__ void epilogue(const Params& P, const Epi& E, int mb, int nb, f32x4 (&acc)[4][4], int lane) {
    const int quad = lane >> 4, l15 = lane & 15;
    switch (E.mode) {
    case E_INPROJ: {
        const int region = nb >> 9;
        if (region <= 1) {
            const float* nw = P.in[region == 0 ? 8 : 9];
            const float scale = region == 0 ? 0.125f : 1.f;
            u16* dst = P.slot[1] + (region == 0 ? 0 : HALF);
            const int cb = nb & 511;
#pragma unroll
            for (int i = 0; i < 4; ++i)
#pragma unroll
                for (int r = 0; r < 4; ++r) {
                    float ss = 0.f;
#pragma unroll
                    for (int j = 0; j < 4; ++j) ss += acc[i][j][r] * acc[i][j][r];
                    ss = sum16(ss);
                    const float rinv = rsqrtf(ss * (1.f / 64.f) + 1e-6f) * scale;
                    const int m = mb + i * 16 + quad * 4 + r;
#pragma unroll
                    for (int j = 0; j < 4; ++j)
                        dst[(size_t)m * 512 + cb + j * 16 + l15] = f2bf(acc[i][j][r] * rinv * nw[j * 16 + l15]);
                }
        } else if (region == 2 || region == 5) {
            const int hd = region == 2 ? 64 : 128, nh = region == 2 ? 8 : 4;
            u16* dst = region == 2 ? P.slot[2] : P.slot[4];
            const int cb = nb & 511;
#pragma unroll
            for (int i = 0; i < 4; ++i) {
                const int m = mb + i * 16 + quad * 4;
#pragma unroll
                for (int j = 0; j < 4; ++j) {
                    const int col = cb + j * 16 + l15, h = col / hd, d = col % hd;
                    uint2 o; o.x = pack2(acc[i][j][0], acc[i][j][1]); o.y = pack2(acc[i][j][2], acc[i][j][3]);
                    size_t off;
                    if (m < ML) off = ((size_t)((m >> 12) * nh + h) * hd + d) * 4096 + (m & 4095);
                    else { int mc = m - ML; off = (size_t)ML * 512 + ((size_t)((mc >> 8) * nh + h) * hd + d) * 256 + (mc & 255); }
                    *(uint2*)(dst + off) = o;
                }
            }
        } else if (region == 3 || region == 4) {
            const int cb = nb & 511;
            const bool colhalf = (cb & 64) != 0;
            const float scale = region == 4 ? 0.08838834764831845f : 1.f;
            u16* dst = region == 3 ? P.slot[2] + HALF : P.slot[3];
            u16* dstT = P.slot[3] + HALF;
#pragma unroll
            for (int i = 0; i < 4; ++i) {
                const int m0 = mb + i * 16 + quad * 4;
                float o[4][4];
#pragma unroll
                for (int r = 0; r < 4; ++r) {
                    const int m = m0 + r;
                    if (m < ML) {
                        const int t = m & 4095, pos = colhalf ? (t & 63) : (t >> 6);
#pragma unroll
                        for (int j = 0; j < 2; ++j) {
                            const int f = j * 16 + l15;
                            const float c = P.ropec[pos * 32 + f], s = P.ropes[pos * 32 + f];
                            const float x1 = acc[i][j][r] * scale, x2 = acc[i][j + 2][r] * scale;
                            o[j][r] = x1 * c - x2 * s; o[j + 2][r] = x1 * s + x2 * c;
                        }
                    } else {
#pragma unroll
                        for (int j = 0; j < 4; ++j) o[j][r] = acc[i][j][r] * scale;
                    }
                }
#pragma unroll
                for (int j = 0; j < 4; ++j) {
                    const int col = cb + j * 16 + l15;
#pragma unroll
                    for (int r = 0; r < 4; ++r) dst[(size_t)(m0 + r) * 512 + col] = f2bf(o[j][r]);
                    if (region == 4) {
                        const int h = col >> 7, d = col & 127;
                        uint2 q; q.x = pack2(o[j][0], o[j][1]); q.y = pack2(o[j][2], o[j][3]);
                        size_t off;
                        if (m0 < ML) off = ((size_t)((m0 >> 12) * 4 + h) * 128 + d) * 4096 + (m0 & 4095);
                        else { int mc = m0 - ML; off = (size_t)ML * 512 + ((size_t)((mc >> 8) * 4 + h) * 128 + d) * 256 + (mc & 255); }
                        *(uint2*)(dstT + off) = q;
                    }
                }
            }
        } else if (region == 6) {
            u16* dst = P.slot[4] + HALF;
            const int cb = nb & 511;
#pragma unroll
            for (int i = 0; i < 4; ++i)
#pragma unroll
                for (int r = 0; r < 4; ++r) {
                    const int m = mb + i * 16 + quad * 4 + r;
#pragma unroll
                    for (int j = 0; j < 4; ++j) dst[(size_t)m * 512 + cb + j * 16 + l15] = f2bf(acc[i][j][r]);
                }
        } else if (nb == 3584) {
            const float gb = P.in[7][l15];
            const bool isf = (l15 & 4) != 0;
#pragma unroll
            for (int i = 0; i < 4; ++i)
#pragma unroll
                for (int r = 0; r < 4; ++r) {
                    const int m = mb + i * 16 + quad * 4 + r;
                    float g = acc[i][0][r] + gb;
                    g = 15.f * tanhf(g * (1.f / 15.f));
                    if (isf) g = fminf(g, 0.f) - log1pf(__expf(-fabsf(g)));
                    P.gates[(size_t)m * 16 + l15] = g;
                }
        }
    } break;
    case E_OUT0: case E_MLPDN: case E_RWOUT: {
        const int gch = (E.mode == E_MLPDN) ? 5 : 2;
#pragma unroll
        for (int i = 0; i < 4; ++i)
#pragma unroll
            for (int r = 0; r < 4; ++r) {
                const int m = mb + i * 16 + quad * 4 + r;
                const float* mr = modrow(P, E.layer, m) + gch * 1024;
                float* rp = resptr(P, m);
                const float* xin = rp;
                if (E.mode == E_OUT0) xin = (m < ML) ? P.in[0] + (size_t)m * 1024 : P.in[2] + (size_t)(m - ML) * 1024;
#pragma unroll
                for (int j = 0; j < 4; ++j) {
                    const int n = nb + j * 16 + l15;
                    rp[n] = xin[n] + mr[n] * acc[i][j][r];
                }
            }
    } break;
    case E_MLPUP: case E_R: case E_V: case E_HW: case E_HA: case E_HG: {
#pragma unroll
        for (int i = 0; i < 4; ++i)
#pragma unroll
            for (int r = 0; r < 4; ++r) {
                const int m = mb + i * 16 + quad * 4 + r;
#pragma unroll
                for (int j = 0; j < 4; ++j) {
                    const int n = nb + j * 16 + l15;
                    float v = acc[i][j][r];
                    if (E.mode == E_MLPUP) { v = fmaxf(v, 0.f); v = v * v; }
                    else if (E.mode == E_HW) v = tanhf(v);
                    else if (E.mode == E_HG) v = sigmoidf_(v);
                    if (n < E.ldo) E.o16[(size_t)m * E.ldo + n] = f2bf(v);
                }
            }
    } break;
    case E_K: {
        const int hd = nb >> 6;
        const float* kk = P.in[23];
#pragma unroll
        for (int i = 0; i < 4; ++i)
#pragma unroll
            for (int r = 0; r < 4; ++r) {
                const int m = mb + i * 16 + quad * 4 + r;
                float ss = 0.f;
#pragma unroll
                for (int j = 0; j < 4; ++j) { float v = acc[i][j][r] * kk[nb + j * 16 + l15]; ss += v * v; }
                ss = sum16(ss);
                if (l15 == 0) P.knorm[(size_t)m * 16 + hd] = 1.f / fmaxf(sqrtf(ss), 1e-12f);
#pragma unroll
                for (int j = 0; j < 4; ++j) E.o16[(size_t)m * 1024 + nb + j * 16 + l15] = f2bf(acc[i][j][r]);
            }
    } break;
    case E_E: {
        const float* w0 = P.in[15] + E.z * 1024;
#pragma unroll
        for (int i = 0; i < 4; ++i)
#pragma unroll
            for (int r = 0; r < 4; ++r) {
                const int m = mb + i * 16 + quad * 4 + r;
#pragma unroll
                for (int j = 0; j < 4; ++j) {
                    const int n = nb + j * 16 + l15;
                    E.o16[(size_t)m * 1024 + n] = f2bf(sigmoidf_(w0[n] + acc[i][j][r]) * 0.6065306597126334f);
                }
            }
    } break;
    case E_A: {
        const float* a0 = P.in[18] + E.z * 1024;
        u8* dst = (u8*)P.slot[0] + (size_t)E.z * MA * 1024;
#pragma unroll
        for (int i = 0; i < 4; ++i)
#pragma unroll
            for (int r = 0; r < 4; ++r) {
                const int m = mb + i * 16 + quad * 4 + r;
#pragma unroll
                for (int j = 0; j < 4; ++j) {
                    const int n = nb + j * 16 + l15;
                    float a = sigmoidf_(a0[n] + acc[i][j][r]);
                    dst[(size_t)m * 1024 + n] = (u8)__float2int_rn(a * 255.f);
                }
            }
    } break;
    case E_GZ: {
        const int hd = nb >> 6;
        const u16* yf = P.slot[4]; const u16* yb = P.slot[5]; const u16* V = P.slot[3];
        const float* lw = P.in[26]; const float* lb = P.in[27];
#pragma unroll
        for (int i = 0; i < 4; ++i)
#pragma unroll
            for (int r = 0; r < 4; ++r) {
                const int m = mb + i * 16 + quad * 4 + r;
                float y[4], s = 0.f;
#pragma unroll
                for (int j = 0; j < 4; ++j) {
                    const size_t o = (size_t)m * 1024 + nb + j * 16 + l15;
                    y[j] = bf2f(yf[o]) + bf2f(yb[o]); s += y[j];
                }
                s = sum16(s);
                const float mean = s * (1.f / 64.f);
                float vs = 0.f;
#pragma unroll
                for (int j = 0; j < 4; ++j) { float d = y[j] - mean; vs += d * d; }
                vs = sum16(vs);
                const float rinv = rsqrtf(vs * (1.f / 64.f) + 64e-5f);
                const float cf = P.coef[(size_t)m * 16 + hd] + P.coef[(size_t)ML * 16 + (size_t)m * 16 + hd];
#pragma unroll
                for (int j = 0; j < 4; ++j) {
                    const int n = nb + j * 16 + l15;
                    float yn = (y[j] - mean) * rinv * lw[n] + lb[n];
                    float z = (yn + cf * bf2f(V[(size_t)m * 1024 + n])) * acc[i][j][r];
                    P.slot[1][(size_t)m * 1024 + n] = f2bf(z);
                }
            }
    } break;
    default: break;
    }
}

template <int AMODE>
__device__ __forceinline__ void gemm_tile(const Params& P, const u16* __restrict__ A, int lda, const u16* __restrict__ Bt, int K,
                                          int m0, int n0, const float* mu, const Epi& E, char* smem) {
    const int tid = threadIdx.x, lane = tid & 63, wave = tid >> 6;
    const int quad = lane >> 4, l15 = lane & 15;
    const int wm = wave >> 1, wn = wave & 1;
    u16* sA = (u16*)smem;
    u16* sB = sA + 2 * BM * LDK;
    const int lrow = tid >> 3, lkc = (tid & 7) * 8;
    f32x4 acc[4][4];
#pragma unroll
    for (int i = 0; i < 4; ++i)
#pragma unroll
        for (int j = 0; j < 4; ++j) acc[i][j] = (f32x4){0.f, 0.f, 0.f, 0.f};

    uint4 ra[4];
    uint4 rb0 = make_uint4(0, 0, 0, 0), rb1 = make_uint4(0, 0, 0, 0);
#pragma unroll
    for (int i = 0; i < 4; ++i) ra[i] = make_uint4(0, 0, 0, 0);
    const int nk = K / BK;
    for (int kt = -1; kt < nk; ++kt) {
        const bool more = kt + 1 < nk;
        if (more) {
            const int k0 = (kt + 1) * BK;
#pragma unroll
            for (int i = 0; i < 4; ++i) {
                const u16* p = A + (size_t)(m0 + lrow + 64 * i) * lda + k0 + lkc;
                if (!AMODE) ra[i] = *(const uint4*)p;
            }
            rb0 = *(const uint4*)(Bt + (size_t)(n0 + lrow) * K + k0 + lkc);
            rb1 = *(const uint4*)(Bt + (size_t)(n0 + lrow + 64) * K + k0 + lkc);
        }
        if (kt >= 0) {
            const u16* a = sA + (kt & 1) * BM * LDK + (wm * 64 + l15) * LDK + quad * 8;
            const u16* b = sB + (kt & 1) * BN * LDK + (wn * 64 + l15) * LDK + quad * 8;
#pragma unroll
            for (int ks = 0; ks < 2; ++ks) {
                s16x8 af[4], bfr[4];
#pragma unroll
                for (int i = 0; i < 4; ++i) af[i] = as_frag(*(const uint4*)(a + i * 16 * LDK + ks * 32));
#pragma unroll
                for (int j = 0; j < 4; ++j) bfr[j] = as_frag(*(const uint4*)(b + j * 16 * LDK + ks * 32));
#pragma unroll
                for (int i = 0; i < 4; ++i)
#pragma unroll
                    for (int j = 0; j < 4; ++j) acc[i][j] = mfma16(af[i], bfr[j], acc[i][j]);
            }
        }
        if (more) {
            const int k0 = (kt + 1) * BK, buf = (kt + 1) & 1;
            u16* a = sA + buf * BM * LDK; u16* b = sB + buf * BN * LDK;
            if (AMODE) {
                const float4 mu0 = *(const float4*)(mu + k0 + lkc), mu1 = *(const float4*)(mu + k0 + lkc + 4);
#pragma unroll 1
                for (int i = 0; i < 4; ++i) {
                    const int m = m0 + lrow + 64 * i;
                    int t, len;
                    if (m < ML) { t = m & 4095; len = 4096; } else { t = (m - ML) & 255; len = 256; }
                    const float fpv = t > 0 ? 0.5f : 0.f, fnv = t < len - 1 ? 0.5f : 0.f;
                    const u16* p = A + (size_t)m * lda + k0 + lkc;
                    const uint4 c = *(const uint4*)p;
                    const uint4 pm = *(const uint4*)(p - (t > 0 ? lda : 0));
                    const uint4 pn = *(const uint4*)(p + (t < len - 1 ? lda : 0));
                    uint4 o;
                    {
                        float c0 = lo2f(c.x), c1 = hi2f(c.x);
                        float x0 = fpv * lo2f(pm.x) + fnv * lo2f(pn.x) - c0, x1 = fpv * hi2f(pm.x) + fnv * hi2f(pn.x) - c1;
                        o.x = pack2(c0 + x0 * mu0.x, c1 + x1 * mu0.y);
                    }
                    {
                        float c0 = lo2f(c.y), c1 = hi2f(c.y);
                        float x0 = fpv * lo2f(pm.y) + fnv * lo2f(pn.y) - c0, x1 = fpv * hi2f(pm.y) + fnv * hi2f(pn.y) - c1;
                        o.y = pack2(c0 + x0 * mu0.z, c1 + x1 * mu0.w);
                    }
                    {
                        float c0 = lo2f(c.z), c1 = hi2f(c.z);
                        float x0 = fpv * lo2f(pm.z) + fnv * lo2f(pn.z) - c0, x1 = fpv * hi2f(pm.z) + fnv * hi2f(pn.z) - c1;
                        o.z = pack2(c0 + x0 * mu1.x, c1 + x1 * mu1.y);
                    }
                    {
                        float c0 = lo2f(c.w), c1 = hi2f(c.w);
                        float x0 = fpv * lo2f(pm.w) + fnv * lo2f(pn.w) - c0, x1 = fpv * hi2f(pm.w) + fnv * hi2f(pn.w) - c1;
                        o.w = pack2(c0 + x0 * mu1.z, c1 + x1 * mu1.w);
                    }
                    *(uint4*)(a + (lrow + 64 * i) * LDK + lkc) = o;
                }
            } else {
#pragma unroll
                for (int i = 0; i < 4; ++i) *(uint4*)(a + (lrow + 64 * i) * LDK + lkc) = ra[i];
            }
            *(uint4*)(b + lrow * LDK + lkc) = rb0;
            *(uint4*)(b + (lrow + 64) * LDK + lkc) = rb1;
        }
        __syncthreads();
    }
    epilogue(P, E, m0 + wm * 64, n0 + wn * 64, acc, lane);
}

struct GJob { const u16* A; int lda; const u16* Bt; int K; const float* mu; Epi E; };

__device__ __forceinline__ void rw2_job(const Params& P, int ntile, GJob& g, int& nt) {
    const int j = ntile >> 3; nt = ntile & 7;
    if (j == 0) g = {P.hw, 128, P.lw2t, 64, nullptr, {E_E, 1, 0, P.slot[4], 1024}};
    else if (j == 1) g = {P.hw + 64, 128, P.lw2t + 1024 * 64, 64, nullptr, {E_E, 1, 1, P.slot[5], 1024}};
    else if (j == 2) g = {P.ha, 128, P.la2t, 64, nullptr, {E_A, 1, 0, nullptr, 0}};
    else g = {P.ha + 64, 128, P.la2t + 1024 * 64, 64, nullptr, {E_A, 1, 1, nullptr, 0}};
}
__device__ __forceinline__ void phase_rw1(const Params& P, char* smem) {
    const int total = 28 * (MA / BM);
    for (int u = blockIdx.x; u < total; u += gridDim.x) {
        const int ntile = u % 28;
        const int jid = ntile < 24 ? (ntile >> 3) : (ntile == 24 ? 3 : (ntile == 25 ? 4 : 5));
        const int nt = ntile < 24 ? (ntile & 7) : (ntile < 26 ? 0 : ntile - 26);
        const int muidx = (0x541320 >> (4 * jid)) & 15;
        const u16* Bt = jid == 0 ? P.rkvt : jid == 1 ? P.rkvt + (size_t)1024 * 1024 : jid == 2 ? P.rkvt + (size_t)2 * 1024 * 1024
                        : jid == 3 ? P.lw1t : jid == 4 ? P.la1t : P.lg1t;
        u16* o16 = jid == 0 ? P.slot[1] : jid == 1 ? P.slot[2] : jid == 2 ? P.slot[3] : jid == 3 ? P.hw : jid == 4 ? P.ha : P.hg;
        Epi E;
        E.mode = E_R + jid; E.layer = 1; E.z = 0; E.o16 = o16; E.ldo = jid < 3 ? 1024 : (jid < 5 ? 128 : 192);
        gemm_tile<1>(P, P.slot[0], 1024, Bt, 1024, (u / 28) * BM, nt * BN, P.in[13] + muidx * 1024, E, smem);
    }
}
__device__ __forceinline__ void phase_rw2(const Params& P, char* smem) {
    const int total = 32 * (MA / BM);
    for (int u = blockIdx.x; u < total; u += gridDim.x) {
        GJob g; int nt; rw2_job(P, u % 32, g, nt);
        gemm_tile<0>(P, g.A, g.lda, g.Bt, g.K, (u / 32) * BM, nt * BN, nullptr, g.E, smem);
    }
}

__device__ __forceinline__ void gemm_single(const Params& P, const u16* A, int lda, const u16* Bt, int K, int ntn, int m_tiles, Epi E, char* smem) {
    const int total = ntn * m_tiles;
    for (int u = blockIdx.x; u < total; u += gridDim.x) {
        const int nt = u % ntn, mt = u / ntn;
        gemm_tile<0>(P, A, lda, Bt, K, mt * BM, nt * BN, nullptr, E, smem);
    }
}

__device__ __forceinline__ void na_unit(const Params& P, int b, int h, int rp, bool ctxq, int half, char* smem) {
    const int tid = threadIdx.x, lane = tid & 63, wave = tid >> 6, quad = lane >> 4, l15 = lane & 15;
    u16* sK = (u16*)smem;
    u16* sVT = sK + 64 * 72;
    float* sBias = (float*)(sVT + 64 * 72);
    const u16* QA = P.slot[1]; const u16* KA = P.slot[1] + HALF; const u16* VAT = P.slot[2];
    u16* CAT = P.slot[0];
    int qrow = 0, c = 0, m, rs_q = 0, rsA = 0, nrows = 0, cs = 0;
    if (!ctxq) {
        const int r0 = 2 * rp;
        qrow = r0 + (wave >> 2); c = (wave & 3) * 16 + l15;
        m = b * 4096 + qrow * 64 + c;
        rs_q = min(max(qrow - 4, 0), 56);
        rsA = min(max(r0 - 4, 0), 56);
        const int rsB = min(max(r0 + 1 - 4, 0), 56);
        nrows = rsB - rsA + 8;
        cs = min(max(c - 8, 0), 48);
    } else {
        m = ML + b * 256 + (half * 8 + wave) * 16 + l15;
    }
    __syncthreads();
    if (!ctxq) for (int e = tid; e < 15 * 31; e += NTHREADS) sBias[e] = P.in[10][h * 465 + e];
    s16x8 qf[2];
#pragma unroll
    for (int ks = 0; ks < 2; ++ks) qf[ks] = as_frag(*(const uint4*)(QA + (size_t)m * 512 + h * 64 + ks * 32 + quad * 8));
    float m_run = -INFINITY, l_run = 0.f;
    f32x4 o[4];
#pragma unroll
    for (int dt = 0; dt < 4; ++dt) o[dt] = (f32x4){0.f, 0.f, 0.f, 0.f};
    const int nblk = nrows + 4;
    const int lrow = tid >> 3, lch = (tid & 7) * 8;
    for (int blk = 0; blk < nblk; ++blk) {
        const bool isctx = blk >= nrows;
        __syncthreads();
        {
            const u16 *kp, *vp;
            if (!isctx) {
                const int tk = (rsA + blk) * 64;
                kp = KA + (size_t)(b * 4096 + tk + lrow) * 512 + h * 64 + lch;
                vp = VAT + ((size_t)(b * 8 + h) * 64 + lrow) * 4096 + tk + lch;
            } else {
                const int nk0 = (blk - nrows) * 64;
                kp = KA + (size_t)(ML + b * 256 + nk0 + lrow) * 512 + h * 64 + lch;
                vp = VAT + (size_t)ML * 512 + ((size_t)(b * 8 + h) * 64 + lrow) * 256 + nk0 + lch;
            }
            *(uint4*)(sK + lrow * 72 + lch) = *(const uint4*)kp;
            *(uint4*)(sVT + lrow * 72 + lch) = *(const uint4*)vp;
        }
        __syncthreads();
        const int kr = rsA + blk;
        if (!isctx && (kr < rs_q || kr >= rs_q + 8)) continue;
        f32x4 s[4];
#pragma unroll
        for (int kt = 0; kt < 4; ++kt) {
            s[kt] = (f32x4){0.f, 0.f, 0.f, 0.f};
#pragma unroll
            for (int ks = 0; ks < 2; ++ks) {
                s16x8 a = as_frag(*(const uint4*)(sK + (kt * 16 + l15) * 72 + ks * 32 + quad * 8));
                s[kt] = mfma16(a, qf[ks], s[kt]);
            }
        }
        float mx = -INFINITY;
#pragma unroll
        for (int kt = 0; kt < 4; ++kt)
#pragma unroll
            for (int r = 0; r < 4; ++r) {
                float v = s[kt][r];
                if (!isctx) {
                    const int kc = kt * 16 + quad * 4 + r;
                    const bool valid = (kc >= cs) && (kc < cs + 16);
                    v = valid ? v + sBias[(kr - qrow + 7) * 31 + (kc - c + 15)] : -INFINITY;
                }
                s[kt][r] = v; mx = fmaxf(mx, v);
            }
        mx = fmaxf(mx, __shfl_xor(mx, 16)); mx = fmaxf(mx, __shfl_xor(mx, 32));
        const float m_new = fmaxf(m_run, mx);
        const float alpha = __expf(m_run - m_new);
        m_run = m_new;
        float ps = 0.f;
#pragma unroll
        for (int kt = 0; kt < 4; ++kt)
#pragma unroll
            for (int r = 0; r < 4; ++r) { float pv = __expf(s[kt][r] - m_new); s[kt][r] = pv; ps += pv; }
        l_run = l_run * alpha + ps;
#pragma unroll
        for (int dt = 0; dt < 4; ++dt) { o[dt][0] *= alpha; o[dt][1] *= alpha; o[dt][2] *= alpha; o[dt][3] *= alpha; }
#pragma unroll
        for (int sb = 0; sb < 2; ++sb) {
            uint4 pb;
            pb.x = pack2(s[2 * sb][0], s[2 * sb][1]); pb.y = pack2(s[2 * sb][2], s[2 * sb][3]);
            pb.z = pack2(s[2 * sb + 1][0], s[2 * sb + 1][1]); pb.w = pack2(s[2 * sb + 1][2], s[2 * sb + 1][3]);
            const s16x8 bfrag = as_frag(pb);
#pragma unroll
            for (int dt = 0; dt < 4; ++dt) {
                const u16* vr = sVT + (dt * 16 + l15) * 72 + sb * 32 + quad * 4;
                uint2 lo = *(const uint2*)vr, hi = *(const uint2*)(vr + 16);
                s16x8 a = as_frag(make_uint4(lo.x, lo.y, hi.x, hi.y));
                o[dt] = mfma16(a, bfrag, o[dt]);
            }
        }
    }
    l_run += __shfl_xor(l_run, 16); l_run += __shfl_xor(l_run, 32);
    const float inv = 1.f / l_run;
#pragma unroll
    for (int dt = 0; dt < 4; ++dt) {
        uint2 q; q.x = pack2(o[dt][0] * inv, o[dt][1] * inv); q.y = pack2(o[dt][2] * inv, o[dt][3] * inv);
        *(uint2*)(CAT + (size_t)m * 1024 + h * 64 + dt * 16 + quad * 4) = q;
    }
}

struct ChunkGeo { int m0; size_t tb; int len; };
__device__ __forceinline__ ChunkGeo chunk_geo(int b, int dir, int pc) {
    ChunkGeo g;
    if (pc < 2) { int oc = dir ? 1 - pc : pc; g.m0 = ML + b * 256 + oc * 128; g.tb = oc * 128; g.len = 256; }
    else { int pp = pc - 2; int oc = dir ? 31 - pp : pp; g.m0 = b * 4096 + oc * 128; g.tb = oc * 128; g.len = 4096; }
    return g;
}
__device__ __forceinline__ size_t tbase(int b, int h, int len) {
    return len == 4096 ? (size_t)(b * 4 + h) * 128 * 4096 : (size_t)ML * 512 + (size_t)(b * 4 + h) * 128 * 256;
}

__device__ __forceinline__ void ml_c1_unit(const Params& P, int chain, int pc, char* smem) {
    const int tid = threadIdx.x, lane = tid & 63, wave = tid >> 6, quad = lane >> 4, l15 = lane & 15;
    const int dir = chain & 1, h = (chain >> 1) & 3, b = chain >> 3;
    float* sS = (float*)smem;
    float* sW = sS + 128;
    float* sRed = sW + 128;
    const ChunkGeo g = chunk_geo(b, dir, pc);
    const u16* KBT = P.slot[3] + HALF + tbase(b, h, g.len) + g.tb;
    const u16* VBT = P.slot[4] + tbase(b, h, g.len) + g.tb;
    __syncthreads();
    float gi = 0.f;
    if (tid < 128) {
        gi = P.gates[(size_t)(g.m0 + tid) * 16 + dir * 8 + h];
        sS[tid] = P.gates[(size_t)(g.m0 + tid) * 16 + dir * 8 + 4 + h];
    }
    __syncthreads();
    for (int off = 1; off < 128; off <<= 1) {
        float v = 0.f;
        if (tid < 128) { int src = dir ? tid + off : tid - off; if (src >= 0 && src < 128) v = sS[src]; }
        __syncthreads();
        if (tid < 128) sS[tid] += v;
        __syncthreads();
    }
    const float Bc = sS[dir ? 0 : 127];
    float wl = -INFINITY;
    if (tid < 128) wl = Bc - sS[tid] + gi;
    float mx = wl;
#pragma unroll
    for (int o = 1; o < 64; o <<= 1) mx = fmaxf(mx, __shfl_xor(mx, o));
    if (lane == 0 && wave < 2) sRed[wave] = mx;
    __syncthreads();
    const float Mc = fmaxf(sRed[0], sRed[1]);
    if (tid < 128) sW[tid] = __expf(wl - Mc);
    __syncthreads();
    const int e0 = (wave >> 1) * 32, d0 = (wave & 1) * 64;
    f32x4 acc[2][4];
#pragma unroll
    for (int i = 0; i < 2; ++i)
#pragma unroll
        for (int j = 0; j < 4; ++j) acc[i][j] = (f32x4){0.f, 0.f, 0.f, 0.f};
#pragma unroll
    for (int ks = 0; ks < 4; ++ks) {
        const int s0 = ks * 32 + quad * 8;
        float wv[8];
#pragma unroll
        for (int q = 0; q < 8; ++q) wv[q] = sW[s0 + q];
        s16x8 af[2], bfr[4];
#pragma unroll
        for (int i = 0; i < 2; ++i) {
            uint4 raw = *(const uint4*)(VBT + (size_t)(e0 + i * 16 + l15) * g.len + s0);
            uint4 sc;
            sc.x = pack2(lo2f(raw.x) * wv[0], hi2f(raw.x) * wv[1]); sc.y = pack2(lo2f(raw.y) * wv[2], hi2f(raw.y) * wv[3]);
            sc.z = pack2(lo2f(raw.z) * wv[4], hi2f(raw.z) * wv[5]); sc.w = pack2(lo2f(raw.w) * wv[6], hi2f(raw.w) * wv[7]);
            af[i] = as_frag(sc);
        }
#pragma unroll
        for (int j = 0; j < 4; ++j) bfr[j] = as_frag(*(const uint4*)(KBT + (size_t)(d0 + j * 16 + l15) * g.len + s0));
#pragma unroll
        for (int i = 0; i < 2; ++i)
#pragma unroll
            for (int j = 0; j < 4; ++j) acc[i][j] = mfma16(af[i], bfr[j], acc[i][j]);
    }
    u16* ST = P.slot[5] + (size_t)(chain * 34 + pc) * 16384;
#pragma unroll
    for (int i = 0; i < 2; ++i)
#pragma unroll
        for (int j = 0; j < 4; ++j)
#pragma unroll
            for (int r = 0; r < 4; ++r)
                ST[(e0 + i * 16 + quad * 4 + r) * 128 + d0 + j * 16 + l15] = f2bf(acc[i][j][r]);
    if (tid < 128) {
        float nu = 0.f;
        const u16* kr = KBT + (size_t)tid * g.len;
        for (int s = 0; s < 128; s += 8) {
            uint4 raw = *(const uint4*)(kr + s);
            nu += lo2f(raw.x) * sW[s] + hi2f(raw.x) * sW[s + 1] + lo2f(raw.y) * sW[s + 2] + hi2f(raw.y) * sW[s + 3]
                + lo2f(raw.z) * sW[s + 4] + hi2f(raw.z) * sW[s + 5] + lo2f(raw.w) * sW[s + 6] + hi2f(raw.w) * sW[s + 7];
        }
        P.mnu[(size_t)(chain * 34 + pc) * 128 + tid] = nu;
    }
    if (tid == 0) { P.mbc[chain * 34 + pc] = Bc; P.mmc[chain * 34 + pc] = Mc; }
}

__device__ __forceinline__ void phase_mix0(const Params& P, char* smem) {
    const int n_c1 = 64 * 33, n_na = 8 * 8 * 32, n_cx = 8 * 8 * 2;
    for (int u = blockIdx.x; u < n_c1 + n_na + n_cx; u += gridDim.x) {
        if (u < n_c1) ml_c1_unit(P, u / 33, u % 33, smem);
        else if (u < n_c1 + n_na) { int v = u - n_c1; na_unit(P, v >> 8, (v >> 5) & 7, v & 31, false, 0, smem); }
        else { int v = u - n_c1 - n_na; na_unit(P, v >> 4, (v >> 1) & 7, 0, true, v & 1, smem); }
    }
}

__device__ __forceinline__ void phase_mlscan(const Params& P) {
    const int tid = threadIdx.x;
    for (int u = blockIdx.x; u < 64 * 33; u += gridDim.x) {
        const int chain = u / 33, grp = u % 33;
        if (grp == 32 && tid >= 128) continue;
        const float* bc = P.mbc + chain * 34; const float* mc = P.mmc + chain * 34;
        float U[33];
        if (grp < 32) {
            u16* st = P.slot[5] + (size_t)chain * 34 * 16384 + grp * 512 + tid;
#pragma unroll
            for (int pc = 0; pc < 33; ++pc) U[pc] = bf2f(st[(size_t)pc * 16384]);
            float C = 0.f, mm = 0.f;
#pragma unroll
            for (int pc = 0; pc < 34; ++pc) {
                st[(size_t)pc * 16384] = f2bf(C);
                if (pc < 33) {
                    const float Bc = bc[pc], Mc = mc[pc];
                    const float mn = fmaxf(Bc + mm, Mc);
                    C = __expf(Bc + mm - mn) * C + __expf(Mc - mn) * U[pc];
                    mm = mn;
                }
            }
        } else {
            float* nu = P.mnu + (size_t)chain * 34 * 128 + tid;
#pragma unroll
            for (int pc = 0; pc < 33; ++pc) U[pc] = nu[pc * 128];
            float C = 0.f, mm = 0.f;
#pragma unroll
            for (int pc = 0; pc < 34; ++pc) {
                nu[pc * 128] = C;
                if (tid == 0) P.mst[chain * 34 + pc] = mm;
                if (pc < 33) {
                    const float Bc = bc[pc], Mc = mc[pc];
                    const float mn = fmaxf(Bc + mm, Mc);
                    C = __expf(Bc + mm - mn) * C + __expf(Mc - mn) * U[pc];
                    mm = mn;
                }
            }
        }
    }
}

__device__ __forceinline__ void ml_c3_unit(const Params& P, int b, int h, int cid, char* smem) {
    const int tid = threadIdx.x, lane = tid & 63, wave = tid >> 6, quad = lane >> 4, l15 = lane & 15;
    float* sB = (float*)smem;
    float* sI = sB + 256;
    float* sX = sI + 256;
    const bool isctx = cid < 2;
    const int oc = isctx ? cid : cid - 2;
    const int nseg = isctx ? 2 : 32, len = isctx ? 256 : 4096;
    const int m0 = isctx ? ML + b * 256 + oc * 128 : b * 4096 + oc * 128;
    const u16* QB = P.slot[2] + HALF; const u16* KB = P.slot[3];
    const u16* VBT = P.slot[4] + tbase(b, h, len) + oc * 128;
    const u16* OB = P.slot[4] + HALF;
    u16* CAT = P.slot[0];
    __syncthreads();
    const int sd = (tid >> 7) & 1, ss = tid & 127;
    if (tid < 256) {
        sI[tid] = P.gates[(size_t)(m0 + ss) * 16 + sd * 8 + h];
        sB[tid] = P.gates[(size_t)(m0 + ss) * 16 + sd * 8 + 4 + h];
    }
    __syncthreads();
    for (int off = 1; off < 128; off <<= 1) {
        float v = 0.f;
        if (tid < 256) { int src = sd ? ss + off : ss - off; if (src >= 0 && src < 128) v = sB[sd * 128 + src]; }
        __syncthreads();
        if (tid < 256) sB[tid] += v;
        __syncthreads();
    }
    if (tid < 256) sX[tid] = sI[tid] - sB[tid];
    __syncthreads();
    for (int off = 1; off < 128; off <<= 1) {
        float v = -INFINITY;
        if (tid < 256) { int src = sd ? ss + off : ss - off; if (src >= 0 && src < 128) v = sX[sd * 128 + src]; }
        __syncthreads();
        if (tid < 256) sX[tid] = fmaxf(sX[tid], v);
        __syncthreads();
    }
    const int t = wave * 16 + l15;
    s16x8 qf[4];
#pragma unroll
    for (int ks = 0; ks < 4; ++ks) qf[ks] = as_frag(*(const uint4*)(QB + (size_t)(m0 + t) * 512 + h * 128 + ks * 32 + quad * 8));
    float* sH = sX + 256;
    f32x4 hsum[8];
#pragma unroll 1
    for (int dir = 0; dir < 2; ++dir) {
        const int chain = (b * 4 + h) * 2 + dir;
        const int pc = (dir ? nseg - 1 - oc : oc) + (isctx ? 0 : 2);
        const float mst = P.mst[chain * 34 + pc];
        const float bt = sB[dir * 128 + t];
        const float mt = fmaxf(bt + mst, bt + sX[dir * 128 + t]);
        const float winter = __expf(bt + mst - mt);
        const u16* ST = P.slot[5] + (size_t)(chain * 34 + pc) * 16384;
        const float* NS = P.mnu + (size_t)(chain * 34 + pc) * 128;
        f32x4 acc[8];
#pragma unroll
        for (int et = 0; et < 8; ++et) {
            acc[et] = (f32x4){0.f, 0.f, 0.f, 0.f};
#pragma unroll
            for (int ks = 0; ks < 4; ++ks) {
                s16x8 a = as_frag(*(const uint4*)(ST + (et * 16 + l15) * 128 + ks * 32 + quad * 8));
                acc[et] = mfma16(a, qf[ks], acc[et]);
            }
            acc[et][0] *= winter; acc[et][1] *= winter; acc[et][2] *= winter; acc[et][3] *= winter;
        }
        float qn = 0.f;
#pragma unroll
        for (int ks = 0; ks < 4; ++ks) {
            const float* np = NS + ks * 32 + quad * 8;
#pragma unroll
            for (int q = 0; q < 8; ++q) qn += bf2f((u16)qf[ks][q]) * np[q];
        }
        qn += __shfl_xor(qn, 16); qn += __shfl_xor(qn, 32);
        float den = 0.f;
        for (int sb = 0; sb < 4; ++sb) {
            if (dir == 0 ? (2 * sb > wave) : (2 * sb + 1 < wave)) continue;
            float sv[2][4];
#pragma unroll
            for (int hh = 0; hh < 2; ++hh) {
                const int st = 2 * sb + hh;
                f32x4 a4 = (f32x4){0.f, 0.f, 0.f, 0.f};
#pragma unroll
                for (int ks = 0; ks < 4; ++ks) {
                    s16x8 a = as_frag(*(const uint4*)(KB + (size_t)(m0 + st * 16 + l15) * 512 + h * 128 + ks * 32 + quad * 8));
                    a4 = mfma16(a, qf[ks], a4);
                }
#pragma unroll
                for (int r = 0; r < 4; ++r) {
                    const int s = st * 16 + quad * 4 + r;
                    const bool valid = dir ? (s >= t) : (s <= t);
                    const float dv = valid ? __expf(bt - sB[dir * 128 + s] + sI[dir * 128 + s] - mt) : 0.f;
                    sv[hh][r] = a4[r] * dv; den += sv[hh][r];
                }
            }
            uint4 pb;
            pb.x = pack2(sv[0][0], sv[0][1]); pb.y = pack2(sv[0][2], sv[0][3]);
            pb.z = pack2(sv[1][0], sv[1][1]); pb.w = pack2(sv[1][2], sv[1][3]);
            const s16x8 bfrag = as_frag(pb);
#pragma unroll
            for (int et = 0; et < 8; ++et) {
                const u16* vr = VBT + (size_t)(et * 16 + l15) * len + sb * 32 + quad * 4;
                uint2 lo = *(const uint2*)vr, hi = *(const uint2*)(vr + 16);
                acc[et] = mfma16(as_frag(make_uint4(lo.x, lo.y, hi.x, hi.y)), bfrag, acc[et]);
            }
        }
        den += __shfl_xor(den, 16); den += __shfl_xor(den, 32);
        den += winter * qn;
        const float hs = 1.f / fmaxf(fabsf(den), __expf(-mt));
#pragma unroll
        for (int et = 0; et < 8; ++et) {
#pragma unroll
            for (int r = 0; r < 4; ++r) {
                if (dir == 0) sH[(et * 4 + r) * NTHREADS + tid] = acc[et][r] * hs;
                else hsum[et][r] = sH[(et * 4 + r) * NTHREADS + tid] + acc[et][r] * hs;
            }
        }
    }
    float sq = 0.f;
#pragma unroll
    for (int et = 0; et < 8; ++et) sq += hsum[et][0] * hsum[et][0] + hsum[et][1] * hsum[et][1] + hsum[et][2] * hsum[et][2] + hsum[et][3] * hsum[et][3];
    sq += __shfl_xor(sq, 16); sq += __shfl_xor(sq, 32);
    const float rinv = rsqrtf(sq * (1.f / 128.f) + 1e-6f);
    const float* hn = P.in[11] + h * 128;
#pragma unroll
    for (int et = 0; et < 8; ++et) {
        const int e = et * 16 + quad * 4;
        uint2 ob = *(const uint2*)(OB + (size_t)(m0 + t) * 512 + h * 128 + e);
        float o0 = hsum[et][0] * rinv * hn[e + 0] * sigmoidf_(lo2f(ob.x));
        float o1 = hsum[et][1] * rinv * hn[e + 1] * sigmoidf_(hi2f(ob.x));
        float o2 = hsum[et][2] * rinv * hn[e + 2] * sigmoidf_(lo2f(ob.y));
        float o3 = hsum[et][3] * rinv * hn[e + 3] * sigmoidf_(hi2f(ob.y));
        uint2 q; q.x = pack2(o0, o1); q.y = pack2(o2, o3);
        *(uint2*)(CAT + (size_t)(m0 + t) * 1024 + 512 + h * 128 + e) = q;
    }
}

constexpr int TB = 32;
__device__ __forceinline__ void phase_scan(const Params& P, char* smem) {
    const int tid = threadIdx.x, lane = tid & 63, wave = tid >> 6;
    float* sDec = (float*)smem;
    float* sA = sDec + TB * 64;
    float* sBb = sA + TB * 64;
    float* sKd = sBb + TB * 64;
    float* sWr = sKd + TB * 64;
    float* sV = sWr + TB * 64;
    float* sY = sV + TB * 64;
    float* sBr = sY + TB * 64;
    float* sKr = sBr + TB;
    const u16* R = P.slot[1]; const u16* K = P.slot[2]; const u16* V = P.slot[3];
    for (int chain = blockIdx.x; chain < 256; chain += gridDim.x) {
        const int z = chain & 1, hd = (chain >> 1) & 15, b = chain >> 5;
        u16* EY = P.slot[4 + z];
        const u8* AZ = (const u8*)P.slot[0] + (size_t)z * MA * 1024;
        const int sp = tid >> 4, scg = tid & 15, sn = hd * 64 + scg * 4;
        const float4 kk4 = *(const float4*)(P.in[23] + sn), ka4 = *(const float4*)(P.in[24] + sn), rk4 = *(const float4*)(P.in[25] + sn);
        const float kkv[4] = {kk4.x, kk4.y, kk4.z, kk4.w}, kav[4] = {ka4.x, ka4.y, ka4.z, ka4.w}, rkv[4] = {rk4.x, rk4.y, rk4.z, rk4.w};
        const int rg = lane >> 4, cgq = lane & 15, row0 = wave * 16 + rg * 4;
        float S[4][4];
#pragma unroll
        for (int i = 0; i < 4; ++i)
#pragma unroll
            for (int j = 0; j < 4; ++j) S[i][j] = 0.f;
        for (int blk = 0; blk < 8 + 128; ++blk) {
            const bool lat = blk >= 8;
            const int len = lat ? 4096 : 256;
            const int pos = (lat ? blk - 8 : blk) * TB + sp;
            const int tok = z ? len - 1 - pos : pos;
            const int m = lat ? b * 4096 + tok : ML + b * 256 + tok;
            __syncthreads();
            {
                const size_t o = (size_t)m * 1024 + sn;
                const uint2 r2 = *(const uint2*)(R + o), k2 = *(const uint2*)(K + o), v2 = *(const uint2*)(V + o), e2 = *(const uint2*)(EY + o);
                const unsigned a4 = *(const unsigned*)(AZ + o);
                const float kn = P.knorm[(size_t)m * 16 + hd];
                const float rv[4] = {lo2f(r2.x), hi2f(r2.x), lo2f(r2.y), hi2f(r2.y)};
                const float kv[4] = {lo2f(k2.x), hi2f(k2.x), lo2f(k2.y), hi2f(k2.y)};
                const float vv[4] = {lo2f(v2.x), hi2f(v2.x), lo2f(v2.y), hi2f(v2.y)};
                const float ev[4] = {lo2f(e2.x), hi2f(e2.x), lo2f(e2.y), hi2f(e2.y)};
                float dec[4], an[4], bb[4], kd[4], wr[4];
                float br = 0.f, kr = 0.f, cf = 0.f;
#pragma unroll
                for (int q = 0; q < 4; ++q) {
                    const float a = (float)((a4 >> (8 * q)) & 255u) * (1.f / 255.f);
                    const float kkn = kv[q] * kkv[q] * kn;
                    an[q] = -kkn; bb[q] = kkn * a;
                    kd[q] = kv[q] * (1.f + (a - 1.f) * kav[q]);
                    dec[q] = __expf(-ev[q]);
                    wr[q] = dec[q] * rv[q];
                    br += bb[q] * rv[q]; kr += kd[q] * rv[q]; cf += rv[q] * kd[q] * rkv[q];
                }
                br = sum16(br); kr = sum16(kr); cf = sum16(cf);
                const int lo = sp * 64 + scg * 4;
                *(float4*)(sDec + lo) = make_float4(dec[0], dec[1], dec[2], dec[3]);
                *(float4*)(sA + lo) = make_float4(an[0], an[1], an[2], an[3]);
                *(float4*)(sBb + lo) = make_float4(bb[0], bb[1], bb[2], bb[3]);
                *(float4*)(sKd + lo) = make_float4(kd[0], kd[1], kd[2], kd[3]);
                *(float4*)(sWr + lo) = make_float4(wr[0], wr[1], wr[2], wr[3]);
                *(float4*)(sV + lo) = make_float4(vv[0], vv[1], vv[2], vv[3]);
                if (scg == 0) {
                    sBr[sp] = br; sKr[sp] = kr;
                    if (lat) P.coef[(size_t)z * ML * 16 + (size_t)m * 16 + hd] = cf;
                }
            }
            __syncthreads();
            if (wave < 4) {
#pragma unroll 4
                for (int p = 0; p < TB; ++p) {
                    const float4 dc = *(const float4*)(sDec + p * 64 + cgq * 4);
                    const float4 a4 = *(const float4*)(sA + p * 64 + cgq * 4);
                    const float4 b4 = *(const float4*)(sBb + p * 64 + cgq * 4);
                    const float4 k4 = *(const float4*)(sKd + p * 64 + cgq * 4);
                    const float4 w4 = *(const float4*)(sWr + p * 64 + cgq * 4);
                    const float4 v4 = *(const float4*)(sV + p * 64 + row0);
                    const float br = sBr[p], kr = sKr[p];
                    const float vr[4] = {v4.x, v4.y, v4.z, v4.w};
                    float sa[4], sw[4];
#pragma unroll
                    for (int i = 0; i < 4; ++i) {
                        sa[i] = S[i][0] * a4.x + S[i][1] * a4.y + S[i][2] * a4.z + S[i][3] * a4.w;
                        sw[i] = S[i][0] * w4.x + S[i][1] * w4.y + S[i][2] * w4.z + S[i][3] * w4.w;
                    }
#pragma unroll
                    for (int i = 0; i < 4; ++i) { sa[i] = sum16(sa[i]); sw[i] = sum16(sw[i]); }
#pragma unroll
                    for (int i = 0; i < 4; ++i) {
                        S[i][0] = S[i][0] * dc.x + (sa[i] * b4.x + vr[i] * k4.x);
                        S[i][1] = S[i][1] * dc.y + (sa[i] * b4.y + vr[i] * k4.y);
                        S[i][2] = S[i][2] * dc.z + (sa[i] * b4.z + vr[i] * k4.z);
                        S[i][3] = S[i][3] * dc.w + (sa[i] * b4.w + vr[i] * k4.w);
                    }
                    if (lat && cgq == 0)
                        *(float4*)(sY + p * 64 + row0) = make_float4(sw[0] + sa[0] * br + vr[0] * kr, sw[1] + sa[1] * br + vr[1] * kr,
                                                                     sw[2] + sa[2] * br + vr[2] * kr, sw[3] + sa[3] * br + vr[3] * kr);
                }
            }
            __syncthreads();
            if (lat) {
                const float4 y4 = *(const float4*)(sY + sp * 64 + scg * 4);
                uint2 q; q.x = pack2(y4.x, y4.y); q.y = pack2(y4.z, y4.w);
                *(uint2*)(EY + (size_t)m * 1024 + sn) = q;
            }
        }
    }
}

__device__ __forceinline__ void do_phase(const Params& P, const int ph, char* smem) {
        switch (ph) {
        case 0: phase_prep(P, smem); break;
        case 1: phase_norm(P, 0, P.slot[0], MA); break;
        case 2: { Epi E{E_INPROJ, 0, 0, nullptr, 0}; gemm_single(P, P.slot[0], 1024, P.wint, 1024, 29, MA / BM, E, smem); } break;
        case 3: phase_mix0(P, smem); break;
        case 4: phase_mlscan(P); break;
        case 5: for (int u = blockIdx.x; u < 8 * 4 * 34; u += gridDim.x) ml_c3_unit(P, u / 136, (u / 34) & 3, u % 34, smem); break;
        case 6: { Epi E{E_OUT0, 0, 0, nullptr, 0}; gemm_single(P, P.slot[0], 1024, P.woutt, 1024, 8, MA / BM, E, smem); } break;
        case 7: phase_norm(P, 1, P.slot[0], MA); break;
        case 8: { Epi E{E_MLPUP, 0, 0, P.slot[1], 4096}; gemm_single(P, P.slot[0], 1024, P.w1t[0], 1024, 32, MA / BM, E, smem); } break;
        case 9: { Epi E{E_MLPDN, 0, 0, nullptr, 0}; gemm_single(P, P.slot[1], 4096, P.w2t[0], 4096, 8, MA / BM, E, smem); } break;
        case 10: phase_norm(P, 2, P.slot[0], MA); break;
        case 11: phase_rw1(P, smem); break;
        case 12: phase_rw2(P, smem); break;
        case 13: phase_scan(P, smem); break;
        case 14: { Epi E{E_GZ, 1, 0, nullptr, 0}; gemm_single(P, P.hg, 192, P.lg2t, 192, 8, ML / BM, E, smem); } break;
        case 15: { Epi E{E_RWOUT, 1, 0, nullptr, 0}; gemm_single(P, P.slot[1], 1024, P.wot, 1024, 8, ML / BM, E, smem); } break;
        case 16: phase_norm(P, 3, P.slot[0], ML); break;
        case 17: { Epi E{E_MLPUP, 1, 0, P.slot[1], 4096}; gemm_single(P, P.slot[0], 1024, P.w1t[1], 1024, 32, ML / BM, E, smem); } break;
        case 18: { Epi E{E_MLPDN, 1, 0, nullptr, 0}; gemm_single(P, P.slot[1], 4096, P.w2t[1], 4096, 8, ML / BM, E, smem); } break;
        default: break;
        }
}

__global__ void __launch_bounds__(NTHREADS) mega(Params P) {
    extern __shared__ __align__(16) char smem[];
#if ONE_LAUNCH
    cg::grid_group grid = cg::this_grid();
#define PH(n) do_phase(P, n, smem); grid.sync();
    PH(0) PH(1) PH(2) PH(3) PH(4) PH(5) PH(6) PH(7) PH(8) PH(9) PH(10) PH(11) PH(12) PH(13) PH(14) PH(15) PH(16) PH(17)
    do_phase(P, 18, smem);
#undef PH
#else
    do_phase(P, P.ph_lo, smem);
#endif
}

extern "C" void kernel_launch(void* const* d_in, const int* in_sizes, int n_in, void* d_out, int out_size, void* d_ws, size_t ws_size,
                              hipStream_t stream) {
    static int grid = 0;
    if (grid == 0) {
        int dev = 0, cus = 0, per_cu = 0;
        hipGetDevice(&dev);
        hipDeviceGetAttribute(&cus, hipDeviceAttributeMultiprocessorCount, dev);
        hipFuncSetAttribute((const void*)mega, hipFuncAttributeMaxDynamicSharedMemorySize, LDS_BYTES);
        hipOccupancyMaxActiveBlocksPerMultiprocessor(&per_cu, (const void*)mega, NTHREADS, LDS_BYTES);
        if (per_cu < 1) { fprintf(stderr, "occupancy query says %d blocks/CU\n", per_cu); per_cu = 1; }
        grid = cus;
        if (grid <= 0) grid = 256;
    }
    Params P{};
    for (int i = 0; i < 31; ++i) P.in[i] = (const float*)d_in[i];
    P.out = (float*)d_out;
    char* w = (char*)d_ws;
    size_t off = 0;
    auto take = [&](size_t bytes) { char* p = w + off; off += (bytes + 255) & ~(size_t)255; return p; };
    for (int i = 0; i < 6; ++i) P.slot[i] = (u16*)take(SLOT);
    P.w1t[1] = (u16*)take((size_t)4096 * 1024 * 2);
    P.w2t[1] = (u16*)take((size_t)4096 * 1024 * 2);
    P.rkvt = (u16*)take((size_t)3 * 1024 * 1024 * 2);
    P.wot = (u16*)take((size_t)1024 * 1024 * 2);
    P.lw1t = (u16*)take(128 * 1024 * 2);
    P.la1t = (u16*)take(128 * 1024 * 2);
    P.lg1t = (u16*)take(256 * 1024 * 2);
    P.lw2t = (u16*)take(2 * 1024 * 64 * 2);
    P.la2t = (u16*)take(2 * 1024 * 64 * 2);
    P.lg2t = (u16*)take(1024 * 192 * 2);
    P.mod = (float*)take(2 * 9 * 6144 * 4);
    P.ropec = (float*)take(64 * 32 * 4);
    P.ropes = (float*)take(64 * 32 * 4);
    const size_t ov = off;
    P.wint = (u16*)take((size_t)3712 * 1024 * 2);
    P.woutt = (u16*)take((size_t)1024 * 1024 * 2);
    P.w1t[0] = (u16*)take((size_t)4096 * 1024 * 2);
    P.w2t[0] = (u16*)take((size_t)4096 * 1024 * 2);
    P.gates = (float*)take((size_t)MA * 16 * 4);
    P.ctxres = (float*)take((size_t)MC * 1024 * 4);
    P.mbc = (float*)take(64 * 34 * 4);
    P.mmc = (float*)take(64 * 34 * 4);
    P.mst = (float*)take(64 * 34 * 4);
    P.mnu = (float*)take((size_t)64 * 34 * 128 * 4);
    const size_t end0 = off;
    off = ov;
    P.knorm = (float*)take((size_t)MA * 16 * 4);
    P.coef = (float*)take((size_t)2 * ML * 16 * 4);
    P.hw = (u16*)take((size_t)MA * 128 * 2);
    P.ha = (u16*)take((size_t)MA * 128 * 2);
    P.hg = (u16*)take((size_t)MA * 192 * 2);
    const size_t end1 = off;
    const size_t need = end0 > end1 ? end0 : end1;
    if (need > ws_size || n_in != 31) { fprintf(stderr, "kernel_launch: need %zu bytes of ws, have %zu (n_in %d)\n", need, ws_size, n_in); return; }
#if ONE_LAUNCH
    P.ph_lo = 0; P.ph_hi = NPHASES;
    void* args[] = {&P};
    hipError_t e = hipLaunchCooperativeKernel((const void*)mega, dim3(grid), dim3(NTHREADS), args, LDS_BYTES, stream);
    if (e != hipSuccess) fprintf(stderr, "cooperative launch failed: %s\n", hipGetErrorString(e));
#else
    for (int ph = 0; ph < NPHASES; ++ph) {
        P.ph_lo = ph; P.ph_hi = ph + 1;
        hipLaunchKernelGGL(mega, dim3(grid), dim3(NTHREADS), LDS_BYTES, stream, P);
    }
#endif
}
```

```cpp
#include <hip/hip_runtime.h>
#include <hip/hip_cooperative_groups.h>
#include <cstdio>
namespace cg = cooperative_groups;

#ifndef ONE_LAUNCH
#define ONE_LAUNCH 1
#endif

typedef unsigned short u16;
typedef unsigned char u8;
typedef __attribute__((ext_vector_type(8))) short s16x8;
typedef __attribute__((ext_vector_type(4))) float f32x4;

constexpr int D = 1024, NB = 8, T = 4096, CT = 256;
constexpr int ML = NB * T;
constexpr int MC = NB * CT;
constexpr int MA = ML + MC;
constexpr int NTHREADS = 512;
constexpr size_t SLOT = (size_t)MA * 1024 * 2;
constexpr size_t HALF = (size_t)MA * 512;
constexpr int LDS_BYTES = 147456;
constexpr int NPHASES = 19;

struct Params {
    const float* in[31];
    float* out;
    u16* slot[6];
    u16 *w1t[2], *w2t[2], *rkvt, *wot, *lw1t, *la1t, *lg1t, *lw2t, *la2t, *lg2t, *wint, *woutt;
    float *mod, *ropec, *ropes, *gates, *ctxres, *mbc, *mmc, *mst, *mnu, *knorm, *coef;
    u16 *hw, *ha, *hg;
    int ph_lo, ph_hi;
};

__device__ __forceinline__ int get_tid() { int t = (int)threadIdx.x; asm volatile("" : "+v"(t)); return t; }
__device__ __forceinline__ u16 f2bf(float f) { unsigned u = __float_as_uint(f); u += 0x7fffu + ((u >> 16) & 1u); return (u16)(u >> 16); }
__device__ __forceinline__ float bf2f(u16 h) { return __uint_as_float(((unsigned)h) << 16); }
__device__ __forceinline__ unsigned pack2(float a, float b) { return (unsigned)f2bf(a) | ((unsigned)f2bf(b) << 16); }
__device__ __forceinline__ float lo2f(unsigned u) { return __uint_as_float(u << 16); }
__device__ __forceinline__ float hi2f(unsigned u) { return __uint_as_float(u & 0xffff0000u); }
__device__ __forceinline__ s16x8 as_frag(uint4 v) { return __builtin_bit_cast(s16x8, v); }
__device__ __forceinline__ f32x4 mfma16(s16x8 a, s16x8 b, f32x4 c) { return __builtin_amdgcn_mfma_f32_16x16x32_bf16(a, b, c, 0, 0, 0); }
__device__ __forceinline__ float sigmoidf_(float x) { return 1.f / (1.f + __expf(-x)); }
__device__ __forceinline__ float wave_sum(float v) {
#pragma unroll
    for (int o = 1; o < 64; o <<= 1) v += __shfl_xor(v, o);
    return v;
}
template <int CTRL> __device__ __forceinline__ float dppf(float x) {
    return __int_as_float(__builtin_amdgcn_update_dpp(0, __float_as_int(x), CTRL, 0xf, 0xf, true));
}
__device__ __forceinline__ float sum16(float x) {
    x += dppf<0xB1>(x); x += dppf<0x4E>(x); x += dppf<0x141>(x); x += dppf<0x140>(x);
    return x;
}
__device__ __forceinline__ float* resptr(const Params& P, int m) {
    return m < ML ? P.out + (size_t)m * 1024 : P.ctxres + (size_t)(m - ML) * 1024;
}
__device__ __forceinline__ const float* modrow(const Params& P, int layer, int m) {
    return P.mod + (size_t)(layer * 9 + (m < ML ? (m >> 12) : 8)) * 6144;
}

struct TJob { const float* src; u16* dst; int K, N, Kpad, Npad; };
__device__ __forceinline__ bool get_tjob(const Params& P, int j, TJob& t) {
    switch (j) {
    case 0: t = {P.in[6], P.wint, 1024, 3600, 1024, 3840}; return true;
    case 1: t = {P.in[12], P.woutt, 1024, 1024, 1024, 1024}; return true;
    case 2: t = {P.in[29], P.w1t[0], 1024, 4096, 1024, 4096}; return true;
    case 3: t = {P.in[29] + (size_t)1024 * 4096, P.w1t[1], 1024, 4096, 1024, 4096}; return true;
    case 4: t = {P.in[30], P.w2t[0], 4096, 1024, 4096, 1024}; return true;
    case 5: t = {P.in[30] + (size_t)1024 * 4096, P.w2t[1], 4096, 1024, 4096, 1024}; return true;
    case 6: t = {P.in[14], P.rkvt, 1024, 1024, 1024, 1024}; return true;
    case 7: t = {P.in[14] + (size_t)1024 * 1024, P.rkvt + (size_t)1024 * 1024, 1024, 1024, 1024, 1024}; return true;
    case 8: t = {P.in[14] + (size_t)2 * 1024 * 1024, P.rkvt + (size_t)2 * 1024 * 1024, 1024, 1024, 1024, 1024}; return true;
    case 9: t = {P.in[28], P.wot, 1024, 1024, 1024, 1024}; return true;
    case 10: t = {P.in[16], P.lw1t, 1024, 64, 1024, 64}; return true;
    case 11: t = {P.in[16] + 1024 * 64, P.lw1t + 64 * 1024, 1024, 64, 1024, 64}; return true;
    case 12: t = {P.in[19], P.la1t, 1024, 64, 1024, 64}; return true;
    case 13: t = {P.in[19] + 1024 * 64, P.la1t + 64 * 1024, 1024, 64, 1024, 64}; return true;
    case 14: t = {P.in[21], P.lg1t, 1024, 160, 1024, 256}; return true;
    case 15: t = {P.in[17], P.lw2t, 64, 1024, 64, 1024}; return true;
    case 16: t = {P.in[17] + 64 * 1024, P.lw2t + 1024 * 64, 64, 1024, 64, 1024}; return true;
    case 17: t = {P.in[20], P.la2t, 64, 1024, 64, 1024}; return true;
    case 18: t = {P.in[20] + 64 * 1024, P.la2t + 1024 * 64, 64, 1024, 64, 1024}; return true;
    case 19: t = {P.in[22], P.lg2t, 160, 1024, 192, 1024}; return true;
    default: return false;
    }
}

__device__ __forceinline__ void phase_prep(const Params& P, char* smem) {
    const int tid = get_tid(), lane = tid & 63, wave = tid >> 6;
    float* tile = (float*)smem;
    int ubase = 0;
    for (int j = 0; j < 20; ++j) {
        TJob t; get_tjob(P, j, t);
        const int kt = t.Kpad / 64, nt = t.Npad / 64, nu = kt * nt;
        int first = ((int)blockIdx.x - (ubase % (int)gridDim.x) + (int)gridDim.x) % (int)gridDim.x;
        for (int lu = first; lu < nu; lu += gridDim.x) {
            const int k0 = (lu % kt) * 64, n0 = (lu / kt) * 64;
            __syncthreads();
#pragma unroll
            for (int i = 0; i < 2; ++i) {
                int kr = (tid >> 4) + 32 * i, nc = (tid & 15) * 4;
                int k = k0 + kr, n = n0 + nc;
                float4 v = make_float4(0.f, 0.f, 0.f, 0.f);
                if (k < t.K && n < t.N) v = *(const float4*)(t.src + (size_t)k * t.N + n);
                tile[kr * 65 + nc + 0] = v.x; tile[kr * 65 + nc + 1] = v.y; tile[kr * 65 + nc + 2] = v.z; tile[kr * 65 + nc + 3] = v.w;
            }
            __syncthreads();
            {
                int n = tid >> 3, kc = (tid & 7) * 8;
                uint4 o;
                o.x = pack2(tile[(kc + 0) * 65 + n], tile[(kc + 1) * 65 + n]);
                o.y = pack2(tile[(kc + 2) * 65 + n], tile[(kc + 3) * 65 + n]);
                o.z = pack2(tile[(kc + 4) * 65 + n], tile[(kc + 5) * 65 + n]);
                o.w = pack2(tile[(kc + 6) * 65 + n], tile[(kc + 7) * 65 + n]);
                *(uint4*)(t.dst + (size_t)(n0 + n) * t.Kpad + k0 + kc) = o;
            }
        }
        ubase += nu;
    }
    if (blockIdx.x == 0) {
        for (int e = tid; e < 64 * 32; e += NTHREADS) {
            int pos = e >> 5, f = e & 31;
            float inv = powf(10000.f, -(float)f / 32.f);
            float ang = (float)pos * inv;
            P.ropec[e] = cosf(ang); P.ropes[e] = sinf(ang);
        }
    }
    const float* c = P.in[1]; const float* cctx = P.in[3];
    const int gw = blockIdx.x * 8 + wave, nw = gridDim.x * 8;
    for (int u = gw; u < 2 * 384; u += nw) {
        const int l = u / 384, n0 = (u % 384) * 16;
        const int ksub = lane >> 2, nq = lane & 3;
        const float* W = P.in[4] + (size_t)l * 1024 * 6144 + n0 + nq * 4;
        float acc[9][4];
#pragma unroll
        for (int r = 0; r < 9; ++r) { acc[r][0] = acc[r][1] = acc[r][2] = acc[r][3] = 0.f; }
#pragma unroll 4
        for (int it = 0; it < 64; ++it) {
            const int k = it * 16 + ksub;
            float4 w = *(const float4*)(W + (size_t)k * 6144);
#pragma unroll
            for (int r = 0; r < 9; ++r) {
                float cv = (r < 8) ? c[r * 1024 + k] : cctx[k];
                cv = cv / (1.f + __expf(-cv));
                acc[r][0] += cv * w.x; acc[r][1] += cv * w.y; acc[r][2] += cv * w.z; acc[r][3] += cv * w.w;
            }
        }
#pragma unroll
        for (int r = 0; r < 9; ++r)
#pragma unroll
            for (int q = 0; q < 4; ++q) {
                float v = acc[r][q];
                v += __shfl_xor(v, 4); v += __shfl_xor(v, 8); v += __shfl_xor(v, 16); v += __shfl_xor(v, 32);
                acc[r][q] = v;
            }
        if (ksub == 0) {
#pragma unroll
            for (int r = 0; r < 9; ++r)
#pragma unroll
                for (int q = 0; q < 4; ++q) {
                    int n = n0 + nq * 4 + q;
                    P.mod[(size_t)(l * 9 + r) * 6144 + n] = acc[r][q] + P.in[5][l * 6144 + n];
                }
        }
    }
}

__device__ __forceinline__ void phase_norm(const Params& P, int which, u16* dst, int nrows) {
    const int lane = get_tid() & 63, wave = get_tid() >> 6;
    const int layer = which >> 1, shc = (which & 1) ? 3 : 0;
    for (int m = blockIdx.x * 8 + wave; m < nrows; m += gridDim.x * 8) {
        const float* src;
        if (which == 0) src = (m < ML) ? P.in[0] + (size_t)m * 1024 : P.in[2] + (size_t)(m - ML) * 1024;
        else src = resptr(P, m);
        float4 v[4];
        float ss = 0.f;
#pragma unroll
        for (int i = 0; i < 4; ++i) {
            v[i] = ((const float4*)src)[lane + 64 * i];
            ss += v[i].x * v[i].x + v[i].y * v[i].y + v[i].z * v[i].z + v[i].w * v[i].w;
        }
        ss = wave_sum(ss);
        const float rinv = rsqrtf(ss * (1.f / 1024.f) + 1e-6f);
        const float* mr = modrow(P, layer, m);
#pragma unroll
        for (int i = 0; i < 4; ++i) {
            const int col = (lane + 64 * i) * 4;
            float4 sh = *(const float4*)(mr + shc * 1024 + col);
            float4 sc = *(const float4*)(mr + (shc + 1) * 1024 + col);
            uint2 o;
            o.x = pack2(v[i].x * rinv * (1.f + sc.x) + sh.x, v[i].y * rinv * (1.f + sc.y) + sh.y);
            o.y = pack2(v[i].z * rinv * (1.f + sc.z) + sh.z, v[i].w * rinv * (1.f + sc.w) + sh.w);
            *(uint2*)(dst + (size_t)m * 1024 + col) = o;
        }
    }
}

constexpr int BM = 256, BN = 256, BK = 64, LDK = 72;
enum { E_INPROJ = 1, E_OUT0, E_MLPUP, E_MLPDN, E_R, E_K, E_V, E_HW, E_HA, E_HG, E_E, E_A, E_GZ, E_RWOUT };

struct Epi {
    int mode, layer, z;
    u16* o16;
    int ldo;
};

__device__ __forceinline__ void epilogue(const Params& P, const Epi& E, int mb, int nb, f32x4 (&acc)[4][4], int lane) {
    const int quad = lane >> 4, l15 = lane & 15;
    switch (E.mode) {
    case E_INPROJ: {
        const int region = nb >> 9;
        if (region <= 1) {
            const float* nw = P.in[region == 0 ? 8 : 9];
            const float scale = region == 0 ? 0.125f : 1.f;
            u16* dst = P.slot[1] + (region == 0 ? 0 : HALF);
            const int cb = nb & 511;
#pragma unroll
            for (int i = 0; i < 4; ++i)
#pragma unroll
                for (int r = 0; r < 4; ++r) { __builtin_amdgcn_sched_barrier(0);
                    float ss = 0.f;
#pragma unroll
                    for (int j = 0; j < 4; ++j) ss += acc[i][j][r] * acc[i][j][r];
                    ss = sum16(ss);
                    const float rinv = rsqrtf(ss * (1.f / 64.f) + 1e-6f) * scale;
                    const int m = mb + i * 16 + quad * 4 + r;
#pragma unroll
                    for (int j = 0; j < 4; ++j)
                        dst[(size_t)m * 512 + cb + j * 16 + l15] = f2bf(acc[i][j][r] * rinv * nw[j * 16 + l15]);
                }
        } else if (region == 2 || region == 5) {
            const int hd = region == 2 ? 64 : 128, nh = region == 2 ? 8 : 4;
            u16* dst = region == 2 ? P.slot[2] : P.slot[4];
            const int cb = nb & 511;
#pragma unroll
            for (int i = 0; i < 4; ++i) {
                const int m = mb + i * 16 + quad * 4;
#pragma unroll
                for (int j = 0; j < 4; ++j) {
                    const int col = cb + j * 16 + l15, h = col / hd, d = col % hd;
                    uint2 o; o.x = pack2(acc[i][j][0], acc[i][j][1]); o.y = pack2(acc[i][j][2], acc[i][j][3]);
                    size_t off;
                    if (m < ML) off = ((size_t)((m >> 12) * nh + h) * hd + d) * 4096 + (m & 4095);
                    else { int mc = m - ML; off = (size_t)ML * 512 + ((size_t)((mc >> 8) * nh + h) * hd + d) * 256 + (mc & 255); }
                    *(uint2*)(dst + off) = o;
                }
            }
        } else if (region == 3 || region == 4) {
            const int cb = nb & 511;
            const bool colhalf = (cb & 64) != 0;
            const float scale = region == 4 ? 0.08838834764831845f : 1.f;
            u16* dst = region == 3 ? P.slot[2] + HALF : P.slot[3];
            u16* dstT = P.slot[3] + HALF;
#pragma unroll
            for (int i = 0; i < 4; ++i) {
                const int m0 = mb + i * 16 + quad * 4;
                float o[4][4];
#pragma unroll
                for (int r = 0; r < 4; ++r) { __builtin_amdgcn_sched_barrier(0);
                    const int m = m0 + r;
                    if (m < ML) {
                        const int t = m & 4095, pos = colhalf ? (t & 63) : (t >> 6);
#pragma unroll
                        for (int j = 0; j < 2; ++j) {
                            const int f = j * 16 + l15;
                            const float c = P.ropec[pos * 32 + f], s = P.ropes[pos * 32 + f];
                            const float x1 = acc[i][j][r] * scale, x2 = acc[i][j + 2][r] * scale;
                            o[j][r] = x1 * c - x2 * s; o[j + 2][r] = x1 * s + x2 * c;
                        }
                    } else {
#pragma unroll
                        for (int j = 0; j < 4; ++j) o[j][r] = acc[i][j][r] * scale;
                    }
                }
#pragma unroll
                for (int j = 0; j < 4; ++j) {
                    const int col = cb + j * 16 + l15;
#pragma unroll
                    for (int r = 0; r < 4; ++r) dst[(size_t)(m0 + r) * 512 + col] = f2bf(o[j][r]);
                    if (region == 4) {
                        const int h = col >> 7, d = col & 127;
                        uint2 q; q.x = pack2(o[j][0], o[j][1]); q.y = pack2(o[j][2], o[j][3]);
                        size_t off;
                        if (m0 < ML) off = ((size_t)((m0 >> 12) * 4 + h) * 128 + d) * 4096 + (m0 & 4095);
                        else { int mc = m0 - ML; off = (size_t)ML * 512 + ((size_t)((mc >> 8) * 4 + h) * 128 + d) * 256 + (mc & 255); }
                        *(uint2*)(dstT + off) = q;
                    }
                }
            }
        } else if (region == 6) {
            u16* dst = P.slot[4] + HALF;
            const int cb = nb & 511;
#pragma unroll
            for (int i = 0; i < 4; ++i)
#pragma unroll
                for (int r = 0; r < 4; ++r) { __builtin_amdgcn_sched_barrier(0);
                    const int m = mb + i * 16 + quad * 4 + r;
#pragma unroll
                    for (int j = 0; j < 4; ++j) dst[(size_t)m * 512 + cb + j * 16 + l15] = f2bf(acc[i][j][r]);
                }
        } else if (nb == 3584) {
            const float gb = P.in[7][l15];
            const bool isf = (l15 & 4) != 0;
#pragma unroll
            for (int i = 0; i < 4; ++i)
#pragma unroll
                for (int r = 0; r < 4; ++r) { __builtin_amdgcn_sched_barrier(0);
                    const int m = mb + i * 16 + quad * 4 + r;
                    float g = acc[i][0][r] + gb;
                    g = 15.f * tanhf(g * (1.f / 15.f));
                    if (isf) g = fminf(g, 0.f) - log1pf(__expf(-fabsf(g)));
                    P.gates[(size_t)m * 16 + l15] = g;
                }
        }
    } break;
    case E_OUT0: case E_MLPDN: case E_RWOUT: {
        const int gch = (E.mode == E_MLPDN) ? 5 : 2;
#pragma unroll
        for (int i = 0; i < 4; ++i)
#pragma unroll
            for (int r = 0; r < 4; ++r) { __builtin_amdgcn_sched_barrier(0);
                const int m = mb + i * 16 + quad * 4 + r;
                const float* mr = modrow(P, E.layer, m) + gch * 1024;
                float* rp = resptr(P, m);
                const float* xin = rp;
                if (E.mode == E_OUT0) xin = (m < ML) ? P.in[0] + (size_t)m * 1024 : P.in[2] + (size_t)(m - ML) * 1024;
#pragma unroll
                for (int j = 0; j < 4; ++j) {
                    const int n = nb + j * 16 + l15;
                    rp[n] = xin[n] + mr[n] * acc[i][j][r];
                }
            }
    } break;
    case E_MLPUP: case E_R: case E_V: case E_HW: case E_HA: case E_HG: {
#pragma unroll
        for (int i = 0; i < 4; ++i)
#pragma unroll
            for (int r = 0; r < 4; ++r) { __builtin_amdgcn_sched_barrier(0);
                const int m = mb + i * 16 + quad * 4 + r;
#pragma unroll
                for (int j = 0; j < 4; ++j) {
                    const int n = nb + j * 16 + l15;
                    float v = acc[i][j][r];
                    if (E.mode == E_MLPUP) { v = fmaxf(v, 0.f); v = v * v; }
                    else if (E.mode == E_HW) v = tanhf(v);
                    else if (E.mode == E_HG) v = sigmoidf_(v);
                    if (n < E.ldo) E.o16[(size_t)m * E.ldo + n] = f2bf(v);
                }
            }
    } break;
    case E_K: {
        const int hd = nb >> 6;
        const float* kk = P.in[23];
#pragma unroll
        for (int i = 0; i < 4; ++i)
#pragma unroll
            for (int r = 0; r < 4; ++r) { __builtin_amdgcn_sched_barrier(0);
                const int m = mb + i * 16 + quad * 4 + r;
                float ss = 0.f;
#pragma unroll
                for (int j = 0; j < 4; ++j) { float v = acc[i][j][r] * kk[nb + j * 16 + l15]; ss += v * v; }
                ss = sum16(ss);
                if (l15 == 0) P.knorm[(size_t)m * 16 + hd] = 1.f / fmaxf(sqrtf(ss), 1e-12f);
#pragma unroll
                for (int j = 0; j < 4; ++j) E.o16[(size_t)m * 1024 + nb + j * 16 + l15] = f2bf(acc[i][j][r]);
            }
    } break;
    case E_E: {
        const float* w0 = P.in[15] + E.z * 1024;
#pragma unroll
        for (int i = 0; i < 4; ++i)
#pragma unroll
            for (int r = 0; r < 4; ++r) { __builtin_amdgcn_sched_barrier(0);
                const int m = mb + i * 16 + quad * 4 + r;
#pragma unroll
                for (int j = 0; j < 4; ++j) {
                    const int n = nb + j * 16 + l15;
                    E.o16[(size_t)m * 1024 + n] = f2bf(sigmoidf_(w0[n] + acc[i][j][r]) * 0.6065306597126334f);
                }
            }
    } break;
    case E_A: {
        const float* a0 = P.in[18] + E.z * 1024;
        u8* dst = (u8*)P.slot[0] + (size_t)E.z * MA * 1024;
#pragma unroll
        for (int i = 0; i < 4; ++i)
#pragma unroll
            for (int r = 0; r < 4; ++r) { __builtin_amdgcn_sched_barrier(0);
                const int m = mb + i * 16 + quad * 4 + r;
#pragma unroll
                for (int j = 0; j < 4; ++j) {
                    const int n = nb + j * 16 + l15;
                    float a = sigmoidf_(a0[n] + acc[i][j][r]);
                    dst[(size_t)m * 1024 + n] = (u8)__float2int_rn(a * 255.f);
                }
            }
    } break;
    default: break;
    }
}

template <int AMODE>
__device__ __forceinline__ void gemm_tile(const Params& P, const u16* __restrict__ A, int lda, const u16* __restrict__ Bt, int K,
                                          int m0, int n0, const float* mu, const Epi& E, char* smem) {
    const int tid = get_tid(), lane = tid & 63, wave = tid >> 6;
    const int quad = lane >> 4, l15 = lane & 15;
    const int wm = wave >> 1, wn = wave & 1;
    u16* sA = (u16*)smem;
    u16* sB = sA + 2 * BM * LDK;
    const int lrow = tid >> 3, lkc = (tid & 7) * 8;
    f32x4 acc[2][4][4];
#pragma unroll
    for (int h = 0; h < 2; ++h)
#pragma unroll
        for (int i = 0; i < 4; ++i)
#pragma unroll
            for (int j = 0; j < 4; ++j) acc[h][i][j] = (f32x4){0.f, 0.f, 0.f, 0.f};

    uint4 ra0 = make_uint4(0, 0, 0, 0), ra1 = ra0, ra2 = ra0, ra3 = ra0;
    uint4 rb0 = ra0, rb1 = ra0, rb2 = ra0, rb3 = ra0;
    int nk = K / BK;
    asm volatile("" : "+s"(nk));
    for (int kt = -1; kt < nk; ++kt) {
        const bool more = kt + 1 < nk;
        if (more) {
            const int k0 = (kt + 1) * BK;
            if (!AMODE) {
                const u16* p = A + (size_t)(m0 + lrow) * lda + k0 + lkc;
                ra0 = *(const uint4*)p; ra1 = *(const uint4*)(p + (size_t)64 * lda);
                ra2 = *(const uint4*)(p + (size_t)128 * lda); ra3 = *(const uint4*)(p + (size_t)192 * lda);
            }
            if (!AMODE) {
                const u16* q = Bt + (size_t)(n0 + lrow) * K + k0 + lkc;
                rb0 = *(const uint4*)q; rb1 = *(const uint4*)(q + (size_t)64 * K);
                rb2 = *(const uint4*)(q + (size_t)128 * K); rb3 = *(const uint4*)(q + (size_t)192 * K);
            }
        }
        if (kt >= 0) {
            const u16* a = sA + (kt & 1) * BM * LDK + (wm * 64 + l15) * LDK + quad * 8;
            const u16* b = sB + (kt & 1) * BN * LDK + (wn * 128 + l15) * LDK + quad * 8;
#pragma unroll
            for (int ks = 0; ks < 2; ++ks) {
                s16x8 af[4];
#pragma unroll
                for (int i = 0; i < 4; ++i) af[i] = as_frag(*(const uint4*)(a + i * 16 * LDK + ks * 32));
#pragma unroll
                for (int h = 0; h < 2; ++h) {
                    s16x8 bfr[4];
#pragma unroll
                    for (int j = 0; j < 4; ++j) bfr[j] = as_frag(*(const uint4*)(b + (h * 64 + j * 16) * LDK + ks * 32));
#pragma unroll
                    for (int i = 0; i < 4; ++i)
#pragma unroll
                        for (int j = 0; j < 4; ++j) acc[h][i][j] = mfma16(af[i], bfr[j], acc[h][i][j]);
                }
            }
        }
        if (more) {
            const int k0 = (kt + 1) * BK, buf = (kt + 1) & 1;
            u16* a = sA + buf * BM * LDK; u16* b = sB + buf * BN * LDK;
            if (AMODE) {
                const float4 mu0 = *(const float4*)(mu + k0 + lkc), mu1 = *(const float4*)(mu + k0 + lkc + 4);
#pragma unroll 1
                for (int i = 0; i < 4; ++i) {
                    const int m = m0 + lrow + 64 * i;
                    int t, len;
                    if (m < ML) { t = m & 4095; len = 4096; } else { t = (m - ML) & 255; len = 256; }
                    const float fpv = t > 0 ? 0.5f : 0.f, fnv = t < len - 1 ? 0.5f : 0.f;
                    const u16* p = A + (size_t)m * lda + k0 + lkc;
                    const uint4 bq = *(const uint4*)(Bt + (size_t)(n0 + lrow + 64 * i) * K + k0 + lkc);
                    const uint4 c = *(const uint4*)p;
                    const uint4 pm = *(const uint4*)(p - (t > 0 ? lda : 0));
                    const uint4 pn = *(const uint4*)(p + (t < len - 1 ? lda : 0));
                    uint4 o;
                    {
                        float c0 = lo2f(c.x), c1 = hi2f(c.x);
                        float x0 = fpv * lo2f(pm.x) + fnv * lo2f(pn.x) - c0, x1 = fpv * hi2f(pm.x) + fnv * hi2f(pn.x) - c1;
                        o.x = pack2(c0 + x0 * mu0.x, c1 + x1 * mu0.y);
                    }
                    {
                        float c0 = lo2f(c.y), c1 = hi2f(c.y);
                        float x0 = fpv * lo2f(pm.y) + fnv * lo2f(pn.y) - c0, x1 = fpv * hi2f(pm.y) + fnv * hi2f(pn.y) - c1;
                        o.y = pack2(c0 + x0 * mu0.z, c1 + x1 * mu0.w);
                    }
                    {
                        float c0 = lo2f(c.z), c1 = hi2f(c.z);
                        float x0 = fpv * lo2f(pm.z) + fnv * lo2f(pn.z) - c0, x1 = fpv * hi2f(pm.z) + fnv * hi2f(pn.z) - c1;
                        o.z = pack2(c0 + x0 * mu1.x, c1 + x1 * mu1.y);
                    }
                    {
                        float c0 = lo2f(c.w), c1 = hi2f(c.w);
                        float x0 = fpv * lo2f(pm.w) + fnv * lo2f(pn.w) - c0, x1 = fpv * hi2f(pm.w) + fnv * hi2f(pn.w) - c1;
                        o.w = pack2(c0 + x0 * mu1.z, c1 + x1 * mu1.w);
                    }
                    *(uint4*)(a + (lrow + 64 * i) * LDK + lkc) = o;
                    *(uint4*)(b + (lrow + 64 * i) * LDK + lkc) = bq;
                }
            } else {
                *(uint4*)(a + lrow * LDK + lkc) = ra0; *(uint4*)(a + (lrow + 64) * LDK + lkc) = ra1;
                *(uint4*)(a + (lrow + 128) * LDK + lkc) = ra2; *(uint4*)(a + (lrow + 192) * LDK + lkc) = ra3;
            }
            if (!AMODE) {
                *(uint4*)(b + lrow * LDK + lkc) = rb0; *(uint4*)(b + (lrow + 64) * LDK + lkc) = rb1;
                *(uint4*)(b + (lrow + 128) * LDK + lkc) = rb2; *(uint4*)(b + (lrow + 192) * LDK + lkc) = rb3;
            }
        }
        __syncthreads();
    }
    int lane_e = lane;
    asm volatile("" : "+v"(lane_e));
    {
        float* park = (float*)smem;
#pragma unroll
        for (int i = 0; i < 4; ++i)
#pragma unroll
            for (int j = 0; j < 4; ++j)
#pragma unroll
                for (int r = 0; r < 4; ++r) park[((i * 4 + j) * 4 + r) * NTHREADS + tid] = acc[1][i][j][r];
        __builtin_amdgcn_sched_barrier(0);
        epilogue(P, E, m0 + (lane_e >> 6) * 0 + wm * 64, n0 + wn * 128, acc[0], lane_e);
        __builtin_amdgcn_sched_barrier(0);
#pragma unroll
        for (int i = 0; i < 4; ++i)
#pragma unroll
            for (int j = 0; j < 4; ++j)
#pragma unroll
                for (int r = 0; r < 4; ++r) acc[0][i][j][r] = park[((i * 4 + j) * 4 + r) * NTHREADS + tid];
        __builtin_amdgcn_sched_barrier(0);
        epilogue(P, E, m0 + wm * 64, n0 + wn * 128 + 64, acc[0], lane_e);
        __syncthreads();
    }
}

struct GJob { const u16* A; int lda; const u16* Bt; int K; const float* mu; Epi E; };

__device__ __forceinline__ void rw2_job(const Params& P, int ntile, GJob& g, int& nt) {
    const int j = ntile >> 2; nt = ntile & 3;
    if (j == 0) g = {P.hw, 128, P.lw2t, 64, nullptr, {E_E, 1, 0, P.slot[4], 1024}};
    else if (j == 1) g = {P.hw + 64, 128, P.lw2t + 1024 * 64, 64, nullptr, {E_E, 1, 1, P.slot[5], 1024}};
    else if (j == 2) g = {P.ha, 128, P.la2t, 64, nullptr, {E_A, 1, 0, nullptr, 0}};
    else g = {P.ha + 64, 128, P.la2t + 1024 * 64, 64, nullptr, {E_A, 1, 1, nullptr, 0}};
}
__device__ __forceinline__ void phase_rw1(const Params& P, char* smem) {
    const int total = 15 * (MA / BM);
    for (int u = blockIdx.x; u < total; u += gridDim.x) {
        const int ntile = u % 15;
        const int jid = ntile < 12 ? (ntile >> 2) : ntile - 9;
        const int nt = ntile < 12 ? (ntile & 3) : 0;
        const int muidx = (0x541320 >> (4 * jid)) & 15;
        const u16* Bt = jid == 0 ? P.rkvt : jid == 1 ? P.rkvt + (size_t)1024 * 1024 : jid == 2 ? P.rkvt + (size_t)2 * 1024 * 1024
                        : jid == 3 ? P.lw1t : jid == 4 ? P.la1t : P.lg1t;
        u16* o16 = jid == 0 ? P.slot[1] : jid == 1 ? P.slot[2] : jid == 2 ? P.slot[3] : jid == 3 ? P.hw : jid == 4 ? P.ha : P.hg;
        Epi E;
        E.mode = E_R + jid; E.layer = 1; E.z = 0; E.o16 = o16; E.ldo = jid < 3 ? 1024 : (jid < 5 ? 128 : 192);
        gemm_tile<1>(P, P.slot[0], 1024, Bt, 1024, (u / 15) * BM, nt * BN, P.in[13] + muidx * 1024, E, smem);
    }
}
__device__ __forceinline__ void phase_rw2(const Params& P, char* smem) {
    const int total = 16 * (MA / BM);
    for (int u = blockIdx.x; u < total; u += gridDim.x) {
        GJob g; int nt; rw2_job(P, u % 16, g, nt);
        gemm_tile<0>(P, g.A, g.lda, g.Bt, g.K, (u / 16) * BM, nt * BN, nullptr, g.E, smem);
    }
}

__device__ __forceinline__ void gemm_single(const Params& P, const u16* A, int lda, const u16* Bt, int K, int ntn, int m_tiles, Epi E, char* smem) {
    const int total = ntn * m_tiles;
    for (int u = blockIdx.x; u < total; u += gridDim.x) {
        const int nt = u % ntn, mt = u / ntn;
        gemm_tile<0>(P, A, lda, Bt, K, mt * BM, nt * BN, nullptr, E, smem);
    }
}

__device__ __forceinline__ void na_unit(const Params& P, int b, int h, int rp, bool ctxq, int half, char* smem) {
    const int tid = get_tid(), lane = tid & 63, wave = tid >> 6, quad = lane >> 4, l15 = lane & 15;
    u16* sK = (u16*)smem;
    u16* sVT = sK + 64 * 72;
    float* sBias = (float*)(sVT + 64 * 72);
    const u16* QA = P.slot[1]; const u16* KA = P.slot[1] + HALF; const u16* VAT = P.slot[2];
    u16* CAT = P.slot[0];
    int qrow = 0, c = 0, m, rs_q = 0, rsA = 0, nrows = 0, cs = 0;
    if (!ctxq) {
        const int r0 = 2 * rp;
        qrow = r0 + (wave >> 2); c = (wave & 3) * 16 + l15;
        m = b * 4096 + qrow * 64 + c;
        rs_q = min(max(qrow - 4, 0), 56);
        rsA = min(max(r0 - 4, 0), 56);
        const int rsB = min(max(r0 + 1 - 4, 0), 56);
        nrows = rsB - rsA + 8;
        cs = min(max(c - 8, 0), 48);
    } else {
        m = ML + b * 256 + (half * 8 + wave) * 16 + l15;
    }
    __syncthreads();
    if (!ctxq) for (int e = tid; e < 15 * 31; e += NTHREADS) sBias[e] = P.in[10][h * 465 + e];
    s16x8 qf[2];
#pragma unroll
    for (int ks = 0; ks < 2; ++ks) qf[ks] = as_frag(*(const uint4*)(QA + (size_t)m * 512 + h * 64 + ks * 32 + quad * 8));
    float m_run = -INFINITY, l_run = 0.f;
    f32x4 o[4];
#pragma unroll
    for (int dt = 0; dt < 4; ++dt) o[dt] = (f32x4){0.f, 0.f, 0.f, 0.f};
    const int nblk = nrows + 4;
    const int lrow = tid >> 3, lch = (tid & 7) * 8;
    for (int blk = 0; blk < nblk; ++blk) {
        const bool isctx = blk >= nrows;
        __syncthreads();
        {
            const u16 *kp, *vp;
            if (!isctx) {
                const int tk = (rsA + blk) * 64;
                kp = KA + (size_t)(b * 4096 + tk + lrow) * 512 + h * 64 + lch;
                vp = VAT + ((size_t)(b * 8 + h) * 64 + lrow) * 4096 + tk + lch;
            } else {
                const int nk0 = (blk - nrows) * 64;
                kp = KA + (size_t)(ML + b * 256 + nk0 + lrow) * 512 + h * 64 + lch;
                vp = VAT + (size_t)ML * 512 + ((size_t)(b * 8 + h) * 64 + lrow) * 256 + nk0 + lch;
            }
            *(uint4*)(sK + lrow * 72 + lch) = *(const uint4*)kp;
            *(uint4*)(sVT + lrow * 72 + lch) = *(const uint4*)vp;
        }
        __syncthreads();
        const int kr = rsA + blk;
        if (!isctx && (kr < rs_q || kr >= rs_q + 8)) continue;
        f32x4 s[4];
#pragma unroll
        for (int kt = 0; kt < 4; ++kt) {
            s[kt] = (f32x4){0.f, 0.f, 0.f, 0.f};
#pragma unroll
            for (int ks = 0; ks < 2; ++ks) {
                s16x8 a = as_frag(*(const uint4*)(sK + (kt * 16 + l15) * 72 + ks * 32 + quad * 8));
                s[kt] = mfma16(a, qf[ks], s[kt]);
            }
        }
        float mx = -INFINITY;
#pragma unroll
        for (int kt = 0; kt < 4; ++kt)
#pragma unroll
            for (int r = 0; r < 4; ++r) {
                float v = s[kt][r];
                if (!isctx) {
                    const int kc = kt * 16 + quad * 4 + r;
                    const bool valid = (kc >= cs) && (kc < cs + 16);
                    v = valid ? v + sBias[(kr - qrow + 7) * 31 + (kc - c + 15)] : -INFINITY;
                }
                s[kt][r] = v; mx = fmaxf(mx, v);
            }
        mx = fmaxf(mx, __shfl_xor(mx, 16)); mx = fmaxf(mx, __shfl_xor(mx, 32));
        const float m_new = fmaxf(m_run, mx);
        const float alpha = __expf(m_run - m_new);
        m_run = m_new;
        float ps = 0.f;
#pragma unroll
        for (int kt = 0; kt < 4; ++kt)
#pragma unroll
            for (int r = 0; r < 4; ++r) { float pv = __expf(s[kt][r] - m_new); s[kt][r] = pv; ps += pv; }
        l_run = l_run * alpha + ps;
#pragma unroll
        for (int dt = 0; dt < 4; ++dt) { o[dt][0] *= alpha; o[dt][1] *= alpha; o[dt][2] *= alpha; o[dt][3] *= alpha; }
#pragma unroll
        for (int sb = 0; sb < 2; ++sb) {
            uint4 pb;
            pb.x = pack2(s[2 * sb][0], s[2 * sb][1]); pb.y = pack2(s[2 * sb][2], s[2 * sb][3]);
            pb.z = pack2(s[2 * sb + 1][0], s[2 * sb + 1][1]); pb.w = pack2(s[2 * sb + 1][2], s[2 * sb + 1][3]);
            const s16x8 bfrag = as_frag(pb);
#pragma unroll
            for (int dt = 0; dt < 4; ++dt) {
                const u16* vr = sVT + (dt * 16 + l15) * 72 + sb * 32 + quad * 4;
                uint2 lo = *(const uint2*)vr, hi = *(const uint2*)(vr + 16);
                s16x8 a = as_frag(make_uint4(lo.x, lo.y, hi.x, hi.y));
                o[dt] = mfma16(a, bfrag, o[dt]);
            }
        }
    }
    l_run += __shfl_xor(l_run, 16); l_run += __shfl_xor(l_run, 32);
    const float inv = 1.f / l_run;
#pragma unroll
    for (int dt = 0; dt < 4; ++dt) {
        uint2 q; q.x = pack2(o[dt][0] * inv, o[dt][1] * inv); q.y = pack2(o[dt][2] * inv, o[dt][3] * inv);
        *(uint2*)(CAT + (size_t)m * 1024 + h * 64 + dt * 16 + quad * 4) = q;
    }
}

struct ChunkGeo { int m0; size_t tb; int len; };
__device__ __forceinline__ ChunkGeo chunk_geo(int b, int dir, int pc) {
    ChunkGeo g;
    if (pc < 2) { int oc = dir ? 1 - pc : pc; g.m0 = ML + b * 256 + oc * 128; g.tb = oc * 128; g.len = 256; }
    else { int pp = pc - 2; int oc = dir ? 31 - pp : pp; g.m0 = b * 4096 + oc * 128; g.tb = oc * 128; g.len = 4096; }
    return g;
}
__device__ __forceinline__ size_t tbase(int b, int h, int len) {
    return len == 4096 ? (size_t)(b * 4 + h) * 128 * 4096 : (size_t)ML * 512 + (size_t)(b * 4 + h) * 128 * 256;
}

__device__ __forceinline__ void ml_c1_unit(const Params& P, int chain, int pc, char* smem) {
    const int tid = get_tid(), lane = tid & 63, wave = tid >> 6, quad = lane >> 4, l15 = lane & 15;
    const int dir = chain & 1, h = (chain >> 1) & 3, b = chain >> 3;
    float* sS = (float*)smem;
    float* sW = sS + 128;
    float* sRed = sW + 128;
    const ChunkGeo g = chunk_geo(b, dir, pc);
    const u16* KBT = P.slot[3] + HALF + tbase(b, h, g.len) + g.tb;
    const u16* VBT = P.slot[4] + tbase(b, h, g.len) + g.tb;
    __syncthreads();
    float gi = 0.f;
    if (tid < 128) {
        gi = P.gates[(size_t)(g.m0 + tid) * 16 + dir * 8 + h];
        sS[tid] = P.gates[(size_t)(g.m0 + tid) * 16 + dir * 8 + 4 + h];
    }
    __syncthreads();
    for (int off = 1; off < 128; off <<= 1) {
        float v = 0.f;
        if (tid < 128) { int src = dir ? tid + off : tid - off; if (src >= 0 && src < 128) v = sS[src]; }
        __syncthreads();
        if (tid < 128) sS[tid] += v;
        __syncthreads();
    }
    const float Bc = sS[dir ? 0 : 127];
    float wl = -INFINITY;
    if (tid < 128) wl = Bc - sS[tid] + gi;
    float mx = wl;
#pragma unroll
    for (int o = 1; o < 64; o <<= 1) mx = fmaxf(mx, __shfl_xor(mx, o));
    if (lane == 0 && wave < 2) sRed[wave] = mx;
    __syncthreads();
    const float Mc = fmaxf(sRed[0], sRed[1]);
    if (tid < 128) sW[tid] = __expf(wl - Mc);
    __syncthreads();
    const int e0 = (wave >> 1) * 32, d0 = (wave & 1) * 64;
    f32x4 acc[2][4];
#pragma unroll
    for (int i = 0; i < 2; ++i)
#pragma unroll
        for (int j = 0; j < 4; ++j) acc[i][j] = (f32x4){0.f, 0.f, 0.f, 0.f};
#pragma unroll
    for (int ks = 0; ks < 4; ++ks) {
        const int s0 = ks * 32 + quad * 8;
        float wv[8];
#pragma unroll
        for (int q = 0; q < 8; ++q) wv[q] = sW[s0 + q];
        s16x8 af[2], bfr[4];
#pragma unroll
        for (int i = 0; i < 2; ++i) {
            uint4 raw = *(const uint4*)(VBT + (size_t)(e0 + i * 16 + l15) * g.len + s0);
            uint4 sc;
            sc.x = pack2(lo2f(raw.x) * wv[0], hi2f(raw.x) * wv[1]); sc.y = pack2(lo2f(raw.y) * wv[2], hi2f(raw.y) * wv[3]);
            sc.z = pack2(lo2f(raw.z) * wv[4], hi2f(raw.z) * wv[5]); sc.w = pack2(lo2f(raw.w) * wv[6], hi2f(raw.w) * wv[7]);
            af[i] = as_frag(sc);
        }
#pragma unroll
        for (int j = 0; j < 4; ++j) bfr[j] = as_frag(*(const uint4*)(KBT + (size_t)(d0 + j * 16 + l15) * g.len + s0));
#pragma unroll
        for (int i = 0; i < 2; ++i)
#pragma unroll
            for (int j = 0; j < 4; ++j) acc[i][j] = mfma16(af[i], bfr[j], acc[i][j]);
    }
    u16* ST = P.slot[5] + (size_t)(chain * 34 + pc) * 16384;
#pragma unroll
    for (int i = 0; i < 2; ++i)
#pragma unroll
        for (int j = 0; j < 4; ++j)
#pragma unroll
            for (int r = 0; r < 4; ++r)
                ST[(e0 + i * 16 + quad * 4 + r) * 128 + d0 + j * 16 + l15] = f2bf(acc[i][j][r]);
    if (tid < 128) {
        float nu = 0.f;
        const u16* kr = KBT + (size_t)tid * g.len;
        for (int s = 0; s < 128; s += 8) {
            uint4 raw = *(const uint4*)(kr + s);
            nu += lo2f(raw.x) * sW[s] + hi2f(raw.x) * sW[s + 1] + lo2f(raw.y) * sW[s + 2] + hi2f(raw.y) * sW[s + 3]
                + lo2f(raw.z) * sW[s + 4] + hi2f(raw.z) * sW[s + 5] + lo2f(raw.w) * sW[s + 6] + hi2f(raw.w) * sW[s + 7];
        }
        P.mnu[(size_t)(chain * 34 + pc) * 128 + tid] = nu;
    }
    if (tid == 0) { P.mbc[chain * 34 + pc] = Bc; P.mmc[chain * 34 + pc] = Mc; }
}

__device__ __forceinline__ void phase_mix0(const Params& P, char* smem) {
    const int n_c1 = 64 * 33, n_na = 8 * 8 * 32, n_cx = 8 * 8 * 2;
    for (int u = blockIdx.x; u < n_c1 + n_na + n_cx; u += gridDim.x) {
        if (u < n_c1) ml_c1_unit(P, u / 33, u % 33, smem);
        else if (u < n_c1 + n_na) { int v = u - n_c1; na_unit(P, v >> 8, (v >> 5) & 7, v & 31, false, 0, smem); }
        else { int v = u - n_c1 - n_na; na_unit(P, v >> 4, (v >> 1) & 7, 0, true, v & 1, smem); }
    }
}

__device__ __forceinline__ void phase_mlscan(const Params& P) {
    const int tid = get_tid();
    for (int u = blockIdx.x; u < 64 * 33; u += gridDim.x) {
        const int chain = u / 33, grp = u % 33;
        if (grp == 32 && tid >= 128) continue;
        const float* bc = P.mbc + chain * 34; const float* mc = P.mmc + chain * 34;
        float U[33];
        if (grp < 32) {
            u16* st = P.slot[5] + (size_t)chain * 34 * 16384 + grp * 512 + tid;
#pragma unroll
            for (int pc = 0; pc < 33; ++pc) U[pc] = bf2f(st[(size_t)pc * 16384]);
            float C = 0.f, mm = 0.f;
#pragma unroll
            for (int pc = 0; pc < 34; ++pc) {
                st[(size_t)pc * 16384] = f2bf(C);
                if (pc < 33) {
                    const float Bc = bc[pc], Mc = mc[pc];
                    const float mn = fmaxf(Bc + mm, Mc);
                    C = __expf(Bc + mm - mn) * C + __expf(Mc - mn) * U[pc];
                    mm = mn;
                }
            }
        } else {
            float* nu = P.mnu + (size_t)chain * 34 * 128 + tid;
#pragma unroll
            for (int pc = 0; pc < 33; ++pc) U[pc] = nu[pc * 128];
            float C = 0.f, mm = 0.f;
#pragma unroll
            for (int pc = 0; pc < 34; ++pc) {
                nu[pc * 128] = C;
                if (tid == 0) P.mst[chain * 34 + pc] = mm;
                if (pc < 33) {
                    const float Bc = bc[pc], Mc = mc[pc];
                    const float mn = fmaxf(Bc + mm, Mc);
                    C = __expf(Bc + mm - mn) * C + __expf(Mc - mn) * U[pc];
                    mm = mn;
                }
            }
        }
    }
}

__device__ __forceinline__ void ml_c3_unit(const Params& P, int b, int h, int cid, char* smem) {
    const int tid = get_tid(), lane = tid & 63, wave = tid >> 6, quad = lane >> 4, l15 = lane & 15;
    float* sB = (float*)smem;
    float* sI = sB + 256;
    float* sX = sI + 256;
    const bool isctx = cid < 2;
    const int oc = isctx ? cid : cid - 2;
    const int nseg = isctx ? 2 : 32, len = isctx ? 256 : 4096;
    const int m0 = isctx ? ML + b * 256 + oc * 128 : b * 4096 + oc * 128;
    const u16* QB = P.slot[2] + HALF; const u16* KB = P.slot[3];
    const u16* VBT = P.slot[4] + tbase(b, h, len) + oc * 128;
    const u16* OB = P.slot[4] + HALF;
    u16* CAT = P.slot[0];
    __syncthreads();
    const int sd = (tid >> 7) & 1, ss = tid & 127;
    if (tid < 256) {
        sI[tid] = P.gates[(size_t)(m0 + ss) * 16 + sd * 8 + h];
        sB[tid] = P.gates[(size_t)(m0 + ss) * 16 + sd * 8 + 4 + h];
    }
    __syncthreads();
    for (int off = 1; off < 128; off <<= 1) {
        float v = 0.f;
        if (tid < 256) { int src = sd ? ss + off : ss - off; if (src >= 0 && src < 128) v = sB[sd * 128 + src]; }
        __syncthreads();
        if (tid < 256) sB[tid] += v;
        __syncthreads();
    }
    if (tid < 256) sX[tid] = sI[tid] - sB[tid];
    __syncthreads();
    for (int off = 1; off < 128; off <<= 1) {
        float v = -INFINITY;
        if (tid < 256) { int src = sd ? ss + off : ss - off; if (src >= 0 && src < 128) v = sX[sd * 128 + src]; }
        __syncthreads();
        if (tid < 256) sX[tid] = fmaxf(sX[tid], v);
        __syncthreads();
    }
    const int t = wave * 16 + l15;
    s16x8 qf[4];
#pragma unroll
    for (int ks = 0; ks < 4; ++ks) qf[ks] = as_frag(*(const uint4*)(QB + (size_t)(m0 + t) * 512 + h * 128 + ks * 32 + quad * 8));
    float* sH = sX + 256;
    f32x4 hsum[8];
#pragma unroll 1
    for (int dir = 0; dir < 2; ++dir) {
        const int chain = (b * 4 + h) * 2 + dir;
        const int pc = (dir ? nseg - 1 - oc : oc) + (isctx ? 0 : 2);
        const float mst = P.mst[chain * 34 + pc];
        const float bt = sB[dir * 128 + t];
        const float mt = fmaxf(bt + mst, bt + sX[dir * 128 + t]);
        const float winter = __expf(bt + mst - mt);
        const u16* ST = P.slot[5] + (size_t)(chain * 34 + pc) * 16384;
        const float* NS = P.mnu + (size_t)(chain * 34 + pc) * 128;
        f32x4 acc[8];
#pragma unroll
        for (int et = 0; et < 8; ++et) {
            acc[et] = (f32x4){0.f, 0.f, 0.f, 0.f};
#pragma unroll
            for (int ks = 0; ks < 4; ++ks) {
                s16x8 a = as_frag(*(const uint4*)(ST + (et * 16 + l15) * 128 + ks * 32 + quad * 8));
                acc[et] = mfma16(a, qf[ks], acc[et]);
            }
            acc[et][0] *= winter; acc[et][1] *= winter; acc[et][2] *= winter; acc[et][3] *= winter;
        }
        float qn = 0.f;
#pragma unroll
        for (int ks = 0; ks < 4; ++ks) {
            const float* np = NS + ks * 32 + quad * 8;
#pragma unroll
            for (int q = 0; q < 8; ++q) qn += bf2f((u16)qf[ks][q]) * np[q];
        }
        qn += __shfl_xor(qn, 16); qn += __shfl_xor(qn, 32);
        float den = 0.f;
        for (int sb = 0; sb < 4; ++sb) {
            if (dir == 0 ? (2 * sb > wave) : (2 * sb + 1 < wave)) continue;
            float sv[2][4];
#pragma unroll
            for (int hh = 0; hh < 2; ++hh) {
                const int st = 2 * sb + hh;
                f32x4 a4 = (f32x4){0.f, 0.f, 0.f, 0.f};
#pragma unroll
                for (int ks = 0; ks < 4; ++ks) {
                    s16x8 a = as_frag(*(const uint4*)(KB + (size_t)(m0 + st * 16 + l15) * 512 + h * 128 + ks * 32 + quad * 8));
                    a4 = mfma16(a, qf[ks], a4);
                }
#pragma unroll
                for (int r = 0; r < 4; ++r) {
                    const int s = st * 16 + quad * 4 + r;
                    const bool valid = dir ? (s >= t) : (s <= t);
                    const float dv = valid ? __expf(bt - sB[dir * 128 + s] + sI[dir * 128 + s] - mt) : 0.f;
                    sv[hh][r] = a4[r] * dv; den += sv[hh][r];
                }
            }
            uint4 pb;
            pb.x = pack2(sv[0][0], sv[0][1]); pb.y = pack2(sv[0][2], sv[0][3]);
            pb.z = pack2(sv[1][0], sv[1][1]); pb.w = pack2(sv[1][2], sv[1][3]);
            const s16x8 bfrag = as_frag(pb);
#pragma unroll
            for (int et = 0; et < 8; ++et) {
                const u16* vr = VBT + (size_t)(et * 16 + l15) * len + sb * 32 + quad * 4;
                uint2 lo = *(const uint2*)vr, hi = *(const uint2*)(vr + 16);
                acc[et] = mfma16(as_frag(make_uint4(lo.x, lo.y, hi.x, hi.y)), bfrag, acc[et]);
            }
        }
        den += __shfl_xor(den, 16); den += __shfl_xor(den, 32);
        den += winter * qn;
        const float hs = 1.f / fmaxf(fabsf(den), __expf(-mt));
#pragma unroll
        for (int et = 0; et < 8; ++et) {
#pragma unroll
            for (int r = 0; r < 4; ++r) {
                if (dir == 0) sH[(et * 4 + r) * NTHREADS + tid] = acc[et][r] * hs;
                else hsum[et][r] = sH[(et * 4 + r) * NTHREADS + tid] + acc[et][r] * hs;
            }
        }
    }
    float sq = 0.f;
#pragma unroll
    for (int et = 0; et < 8; ++et) sq += hsum[et][0] * hsum[et][0] + hsum[et][1] * hsum[et][1] + hsum[et][2] * hsum[et][2] + hsum[et][3] * hsum[et][3];
    sq += __shfl_xor(sq, 16); sq += __shfl_xor(sq, 32);
    const float rinv = rsqrtf(sq * (1.f / 128.f) + 1e-6f);
    const float* hn = P.in[11] + h * 128;
#pragma unroll
    for (int et = 0; et < 8; ++et) {
        const int e = et * 16 + quad * 4;
        uint2 ob = *(const uint2*)(OB + (size_t)(m0 + t) * 512 + h * 128 + e);
        float o0 = hsum[et][0] * rinv * hn[e + 0] * sigmoidf_(lo2f(ob.x));
        float o1 = hsum[et][1] * rinv * hn[e + 1] * sigmoidf_(hi2f(ob.x));
        float o2 = hsum[et][2] * rinv * hn[e + 2] * sigmoidf_(lo2f(ob.y));
        float o3 = hsum[et][3] * rinv * hn[e + 3] * sigmoidf_(hi2f(ob.y));
        uint2 q; q.x = pack2(o0, o1); q.y = pack2(o2, o3);
        *(uint2*)(CAT + (size_t)(m0 + t) * 1024 + 512 + h * 128 + e) = q;
    }
}

constexpr int TB = 32;
__device__ __forceinline__ void phase_scan(const Params& P, char* smem) {
    const int tid = get_tid(), lane = tid & 63, wave = tid >> 6;
    float* sDec = (float*)smem;
    float* sA = sDec + TB * 64;
    float* sBb = sA + TB * 64;
    float* sKd = sBb + TB * 64;
    float* sWr = sKd + TB * 64;
    float* sV = sWr + TB * 64;
    float* sY = sV + TB * 64;
    float* sBr = sY + TB * 64;
    float* sKr = sBr + TB;
    const u16* R = P.slot[1]; const u16* K = P.slot[2]; const u16* V = P.slot[3];
    for (int chain = blockIdx.x; chain < 256; chain += gridDim.x) {
        const int z = chain & 1, hd = (chain >> 1) & 15, b = chain >> 5;
        u16* EY = P.slot[4 + z];
        const u8* AZ = (const u8*)P.slot[0] + (size_t)z * MA * 1024;
        const int sp = tid >> 4, scg = tid & 15, sn = hd * 64 + scg * 4;
        const float4 kk4 = *(const float4*)(P.in[23] + sn), ka4 = *(const float4*)(P.in[24] + sn), rk4 = *(const float4*)(P.in[25] + sn);
        const float kkv[4] = {kk4.x, kk4.y, kk4.z, kk4.w}, kav[4] = {ka4.x, ka4.y, ka4.z, ka4.w}, rkv[4] = {rk4.x, rk4.y, rk4.z, rk4.w};
        const int rg = lane >> 4, cgq = lane & 15, row0 = wave * 16 + rg * 4;
        float S[4][4];
#pragma unroll
        for (int i = 0; i < 4; ++i)
#pragma unroll
            for (int j = 0; j < 4; ++j) S[i][j] = 0.f;
        for (int blk = 0; blk < 8 + 128; ++blk) {
            const bool lat = blk >= 8;
            const int len = lat ? 4096 : 256;
            const int pos = (lat ? blk - 8 : blk) * TB + sp;
            const int tok = z ? len - 1 - pos : pos;
            const int m = lat ? b * 4096 + tok : ML + b * 256 + tok;
            __syncthreads();
            {
                const size_t o = (size_t)m * 1024 + sn;
                const uint2 r2 = *(const uint2*)(R + o), k2 = *(const uint2*)(K + o), v2 = *(const uint2*)(V + o), e2 = *(const uint2*)(EY + o);
                const unsigned a4 = *(const unsigned*)(AZ + o);
                const float kn = P.knorm[(size_t)m * 16 + hd];
                const float rv[4] = {lo2f(r2.x), hi2f(r2.x), lo2f(r2.y), hi2f(r2.y)};
                const float kv[4] = {lo2f(k2.x), hi2f(k2.x), lo2f(k2.y), hi2f(k2.y)};
                const float vv[4] = {lo2f(v2.x), hi2f(v2.x), lo2f(v2.y), hi2f(v2.y)};
                const float ev[4] = {lo2f(e2.x), hi2f(e2.x), lo2f(e2.y), hi2f(e2.y)};
                float dec[4], an[4], bb[4], kd[4], wr[4];
                float br = 0.f, kr = 0.f, cf = 0.f;
#pragma unroll
                for (int q = 0; q < 4; ++q) {
                    const float a = (float)((a4 >> (8 * q)) & 255u) * (1.f / 255.f);
                    const float kkn = kv[q] * kkv[q] * kn;
                    an[q] = -kkn; bb[q] = kkn * a;
                    kd[q] = kv[q] * (1.f + (a - 1.f) * kav[q]);
                    dec[q] = __expf(-ev[q]);
                    wr[q] = dec[q] * rv[q];
                    br += bb[q] * rv[q]; kr += kd[q] * rv[q]; cf += rv[q] * kd[q] * rkv[q];
                }
                br = sum16(br); kr = sum16(kr); cf = sum16(cf);
                const int lo = sp * 64 + scg * 4;
                *(float4*)(sDec + lo) = make_float4(dec[0], dec[1], dec[2], dec[3]);
                *(float4*)(sA + lo) = make_float4(an[0], an[1], an[2], an[3]);
                *(float4*)(sBb + lo) = make_float4(bb[0], bb[1], bb[2], bb[3]);
                *(float4*)(sKd + lo) = make_float4(kd[0], kd[1], kd[2], kd[3]);
                *(float4*)(sWr + lo) = make_float4(wr[0], wr[1], wr[2], wr[3]);
                *(float4*)(sV + lo) = make_float4(vv[0], vv[1], vv[2], vv[3]);
                if (scg == 0) {
                    sBr[sp] = br; sKr[sp] = kr;
                    if (lat) P.coef[(size_t)z * ML * 16 + (size_t)m * 16 + hd] = cf;
                }
            }
            __syncthreads();
            if (wave < 4) {
#pragma unroll 4
                for (int p = 0; p < TB; ++p) {
                    const float4 dc = *(const float4*)(sDec + p * 64 + cgq * 4);
                    const float4 a4 = *(const float4*)(sA + p * 64 + cgq * 4);
                    const float4 b4 = *(const float4*)(sBb + p * 64 + cgq * 4);
                    const float4 k4 = *(const float4*)(sKd + p * 64 + cgq * 4);
                    const float4 w4 = *(const float4*)(sWr + p * 64 + cgq * 4);
                    const float4 v4 = *(const float4*)(sV + p * 64 + row0);
                    const float br = sBr[p], kr = sKr[p];
                    const float vr[4] = {v4.x, v4.y, v4.z, v4.w};
                    float sa[4], sw[4];
#pragma unroll
                    for (int i = 0; i < 4; ++i) {
                        sa[i] = S[i][0] * a4.x + S[i][1] * a4.y + S[i][2] * a4.z + S[i][3] * a4.w;
                        sw[i] = S[i][0] * w4.x + S[i][1] * w4.y + S[i][2] * w4.z + S[i][3] * w4.w;
                    }
#pragma unroll
                    for (int i = 0; i < 4; ++i) { sa[i] = sum16(sa[i]); sw[i] = sum16(sw[i]); }
#pragma unroll
                    for (int i = 0; i < 4; ++i) {
                        S[i][0] = S[i][0] * dc.x + (sa[i] * b4.x + vr[i] * k4.x);
                        S[i][1] = S[i][1] * dc.y + (sa[i] * b4.y + vr[i] * k4.y);
                        S[i][2] = S[i][2] * dc.z + (sa[i] * b4.z + vr[i] * k4.z);
                        S[i][3] = S[i][3] * dc.w + (sa[i] * b4.w + vr[i] * k4.w);
                    }
                    if (lat && cgq == 0)
                        *(float4*)(sY + p * 64 + row0) = make_float4(sw[0] + sa[0] * br + vr[0] * kr, sw[1] + sa[1] * br + vr[1] * kr,
                                                                     sw[2] + sa[2] * br + vr[2] * kr, sw[3] + sa[3] * br + vr[3] * kr);
                }
            }
            __syncthreads();
            if (lat) {
                const float4 y4 = *(const float4*)(sY + sp * 64 + scg * 4);
                uint2 q; q.x = pack2(y4.x, y4.y); q.y = pack2(y4.z, y4.w);
                *(uint2*)(EY + (size_t)m * 1024 + sn) = q;
            }
        }
    }
}

__device__ __forceinline__ void phase_z(const Params& P) {
    const int lane = get_tid() & 63, wave = get_tid() >> 6;
    const int n0 = lane * 16, hd = lane >> 2;
    float lw[16], lb[16];
#pragma unroll
    for (int q = 0; q < 16; ++q) { lw[q] = P.in[26][n0 + q]; lb[q] = P.in[27][n0 + q]; }
    const u16* YF = P.slot[4]; const u16* YB = P.slot[5]; const u16* V = P.slot[3]; const u16* G = P.slot[2];
    u16* Z = P.slot[1];
    for (int m = blockIdx.x * 8 + wave; m < ML; m += gridDim.x * 8) {
        const size_t o = (size_t)m * 1024 + n0;
        const uint4 f0 = *(const uint4*)(YF + o), f1 = *(const uint4*)(YF + o + 8);
        const uint4 b0 = *(const uint4*)(YB + o), b1 = *(const uint4*)(YB + o + 8);
        const uint4 v0 = *(const uint4*)(V + o), v1 = *(const uint4*)(V + o + 8);
        const uint4 g0 = *(const uint4*)(G + o), g1 = *(const uint4*)(G + o + 8);
        const float cf = P.coef[(size_t)m * 16 + hd] + P.coef[(size_t)ML * 16 + (size_t)m * 16 + hd];
        const unsigned fw[8] = {f0.x, f0.y, f0.z, f0.w, f1.x, f1.y, f1.z, f1.w};
        const unsigned bw[8] = {b0.x, b0.y, b0.z, b0.w, b1.x, b1.y, b1.z, b1.w};
        const unsigned vw[8] = {v0.x, v0.y, v0.z, v0.w, v1.x, v1.y, v1.z, v1.w};
        const unsigned gw[8] = {g0.x, g0.y, g0.z, g0.w, g1.x, g1.y, g1.z, g1.w};
        float y[16], s = 0.f;
#pragma unroll
        for (int q = 0; q < 8; ++q) {
            y[2 * q] = lo2f(fw[q]) + lo2f(bw[q]); y[2 * q + 1] = hi2f(fw[q]) + hi2f(bw[q]);
            s += y[2 * q] + y[2 * q + 1];
        }
        s += dppf<0xB1>(s); s += dppf<0x4E>(s);
        const float mean = s * (1.f / 64.f);
        float vs = 0.f;
#pragma unroll
        for (int q = 0; q < 16; ++q) { const float d = y[q] - mean; vs += d * d; }
        vs += dppf<0xB1>(vs); vs += dppf<0x4E>(vs);
        const float rinv = rsqrtf(vs * (1.f / 64.f) + 64e-5f);
        unsigned ow[8];
#pragma unroll
        for (int q = 0; q < 8; ++q) {
            const float z0 = ((y[2 * q] - mean) * rinv * lw[2 * q] + lb[2 * q] + cf * lo2f(vw[q])) * lo2f(gw[q]);
            const float z1 = ((y[2 * q + 1] - mean) * rinv * lw[2 * q + 1] + lb[2 * q + 1] + cf * hi2f(vw[q])) * hi2f(gw[q]);
            ow[q] = pack2(z0, z1);
        }
        *(uint4*)(Z + o) = make_uint4(ow[0], ow[1], ow[2], ow[3]);
        *(uint4*)(Z + o + 8) = make_uint4(ow[4], ow[5], ow[6], ow[7]);
    }
}

__device__ __forceinline__ void do_phase(const Params& P, const int ph, char* smem) {
        switch (ph) {
        case 0: phase_prep(P, smem); break;
        case 1: phase_norm(P, 0, P.slot[0], MA); break;
        case 2: { Epi E{E_INPROJ, 0, 0, nullptr, 0}; gemm_single(P, P.slot[0], 1024, P.wint, 1024, 15, MA / BM, E, smem); } break;
        case 3: phase_mix0(P, smem); break;
        case 4: phase_mlscan(P); break;
        case 5: for (int u = blockIdx.x; u < 8 * 4 * 34; u += gridDim.x) ml_c3_unit(P, u / 136, (u / 34) & 3, u % 34, smem); break;
        case 6: { Epi E{E_OUT0, 0, 0, nullptr, 0}; gemm_single(P, P.slot[0], 1024, P.woutt, 1024, 4, MA / BM, E, smem); } break;
        case 7: phase_norm(P, 1, P.slot[0], MA); break;
        case 8: { Epi E{E_MLPUP, 0, 0, P.slot[1], 4096}; gemm_single(P, P.slot[0], 1024, P.w1t[0], 1024, 16, MA / BM, E, smem); } break;
        case 9: { Epi E{E_MLPDN, 0, 0, nullptr, 0}; gemm_single(P, P.slot[1], 4096, P.w2t[0], 4096, 4, MA / BM, E, smem); } break;
        case 10: phase_norm(P, 2, P.slot[0], MA); break;
        case 11: phase_rw1(P, smem); break;
        case 12: phase_rw2(P, smem); break;
        case 13: phase_scan(P, smem); break;
        case 14: { Epi E{E_HA, 1, 0, P.slot[2], 1024}; gemm_single(P, P.hg, 192, P.lg2t, 192, 4, ML / BM, E, smem); } break;
        case 19: phase_z(P); break;
        case 15: { Epi E{E_RWOUT, 1, 0, nullptr, 0}; gemm_single(P, P.slot[1], 1024, P.wot, 1024, 4, ML / BM, E, smem); } break;
        case 16: phase_norm(P, 3, P.slot[0], ML); break;
        case 17: { Epi E{E_MLPUP, 1, 0, P.slot[1], 4096}; gemm_single(P, P.slot[0], 1024, P.w1t[1], 1024, 16, ML / BM, E, smem); } break;
        case 18: { Epi E{E_MLPDN, 1, 0, nullptr, 0}; gemm_single(P, P.slot[1], 4096, P.w2t[1], 4096, 4, ML / BM, E, smem); } break;
        default: break;
        }
}

__global__ void __launch_bounds__(NTHREADS) mega(Params P) {
    extern __shared__ __align__(16) char smem[];
#if ONE_LAUNCH
    cg::grid_group grid = cg::this_grid();
#define PH(n) do_phase(P, n, smem); grid.sync();
    PH(0) PH(1) PH(2) PH(3) PH(4) PH(5) PH(6) PH(7) PH(8) PH(9) PH(10) PH(11) PH(12) PH(13) PH(14) PH(19) PH(15) PH(16) PH(17)
    do_phase(P, 18, smem);
#undef PH
#else
    do_phase(P, P.ph_lo, smem);
#endif
}

extern "C" void kernel_launch(void* const* d_in, const int* in_sizes, int n_in, void* d_out, int out_size, void* d_ws, size_t ws_size,
                              hipStream_t stream) {
    static int grid = 0;
    if (grid == 0) {
        int dev = 0, cus = 0, per_cu = 0;
        hipGetDevice(&dev);
        hipDeviceGetAttribute(&cus, hipDeviceAttributeMultiprocessorCount, dev);
        hipFuncSetAttribute((const void*)mega, hipFuncAttributeMaxDynamicSharedMemorySize, LDS_BYTES);
        hipOccupancyMaxActiveBlocksPerMultiprocessor(&per_cu, (const void*)mega, NTHREADS, LDS_BYTES);
        if (per_cu < 1) { fprintf(stderr, "occupancy query says %d blocks/CU\n", per_cu); per_cu = 1; }
        grid = cus;
        if (grid <= 0) grid = 256;
    }
    Params P{};
    for (int i = 0; i < 31; ++i) P.in[i] = (const float*)d_in[i];
    P.out = (float*)d_out;
    char* w = (char*)d_ws;
    size_t off = 0;
    auto take = [&](size_t bytes) { char* p = w + off; off += (bytes + 255) & ~(size_t)255; return p; };
    for (int i = 0; i < 6; ++i) P.slot[i] = (u16*)take(SLOT);
    P.w1t[1] = (u16*)take((size_t)4096 * 1024 * 2);
    P.w2t[1] = (u16*)take((size_t)4096 * 1024 * 2);
    P.rkvt = (u16*)take((size_t)3 * 1024 * 1024 * 2);
    P.wot = (u16*)take((size_t)1024 * 1024 * 2);
    P.lw1t = (u16*)take(256 * 1024 * 2);
    P.la1t = (u16*)take(256 * 1024 * 2);
    P.lg1t = (u16*)take(256 * 1024 * 2);
    P.lw2t = (u16*)take(2 * 1024 * 64 * 2);
    P.la2t = (u16*)take(2 * 1024 * 64 * 2);
    P.lg2t = (u16*)take(1024 * 192 * 2);
    P.mod = (float*)take(2 * 9 * 6144 * 4);
    P.ropec = (float*)take(64 * 32 * 4);
    P.ropes = (float*)take(64 * 32 * 4);
    const size_t ov = off;
    P.wint = (u16*)take((size_t)3840 * 1024 * 2);
    P.woutt = (u16*)take((size_t)1024 * 1024 * 2);
    P.w1t[0] = (u16*)take((size_t)4096 * 1024 * 2);
    P.w2t[0] = (u16*)take((size_t)4096 * 1024 * 2);
    P.gates = (float*)take((size_t)MA * 16 * 4);
    P.ctxres = (float*)take((size_t)MC * 1024 * 4);
    P.mbc = (float*)take(64 * 34 * 4);
    P.mmc = (float*)take(64 * 34 * 4);
    P.mst = (float*)take(64 * 34 * 4);
    P.mnu = (float*)take((size_t)64 * 34 * 128 * 4);
    const size_t end0 = off;
    off = ov;
    P.knorm = (float*)take((size_t)MA * 16 * 4);
    P.coef = (float*)take((size_t)2 * ML * 16 * 4);
    P.hw = (u16*)take((size_t)MA * 128 * 2);
    P.ha = (u16*)take((size_t)MA * 128 * 2);
    P.hg = (u16*)take((size_t)MA * 192 * 2);
    const size_t end1 = off;
    const size_t need = end0 > end1 ? end0 : end1;
    if (need > ws_size || n_in != 31) { fprintf(stderr, "kernel_launch: need %zu bytes of ws, have %zu (n_in %d)\n", need, ws_size, n_in); return; }
#if ONE_LAUNCH
    P.ph_lo = 0; P.ph_hi = NPHASES;
    void* args[] = {&P};
    hipError_t e = hipLaunchCooperativeKernel((const void*)mega, dim3(grid), dim3(NTHREADS), args, LDS_BYTES, stream);
    if (e != hipSuccess) fprintf(stderr, "cooperative launch failed: %s\n", hipGetErrorString(e));
#else
    for (int ph = 0; ph < NPHASES; ++ph) {
        P.ph_lo = ph; P.ph_hi = ph + 1;
        hipLaunchKernelGGL(mega, dim3(grid), dim3(NTHREADS), LDS_BYTES, stream, P);
    }
#endif
}
```

```cpp
#include <hip/hip_runtime.h>
#include <hip/hip_cooperative_groups.h>
#include <cstdio>
namespace cg = cooperative_groups;

#ifndef ONE_LAUNCH
#define ONE_LAUNCH 1
#endif

typedef unsigned short u16;
typedef unsigned char u8;
typedef __attribute__((ext_vector_type(8))) short s16x8;
typedef __attribute__((ext_vector_type(4))) float f32x4;

constexpr int D = 1024, NB = 8, T = 4096, CT = 256;
constexpr int ML = NB * T;
constexpr int MC = NB * CT;
constexpr int MA = ML + MC;
constexpr int NTHREADS = 512;
constexpr size_t SLOT = (size_t)MA * 1024 * 2;
constexpr size_t HALF = (size_t)MA * 512;
constexpr int LDS_BYTES = 147456;
constexpr int NPHASES = 19;

struct Params {
    const float* in[31];
    float* out;
    u16* slot[6];
    u16 *w1t[2], *w2t[2], *rkvt, *wot, *lw1t, *la1t, *lg1t, *lw2t, *la2t, *lg2t, *wint, *woutt;
    float *mod, *ropec, *ropes, *gates, *ctxres, *mbc, *mmc, *mst, *mnu, *knorm, *coef, *gb, *gx;
    u16 *hw, *ha, *hg;
    unsigned* bar;
    int ph_lo, ph_hi;
};

__device__ __forceinline__ int get_tid() { int t = (int)threadIdx.x; asm volatile("" : "+v"(t)); return t; }
__device__ __forceinline__ u16 f2bf(float f) { unsigned u = __float_as_uint(f); u += 0x7fffu + ((u >> 16) & 1u); return (u16)(u >> 16); }
__device__ __forceinline__ float bf2f(u16 h) { return __uint_as_float(((unsigned)h) << 16); }
typedef __bf16 hwbf16x2 __attribute__((ext_vector_type(2)));
typedef float hwf32x2 __attribute__((ext_vector_type(2)));
__device__ __forceinline__ unsigned pack2(float a, float b) {
    hwf32x2 v = {a, b};
    hwbf16x2 r = __builtin_convertvector(v, hwbf16x2);
    return __builtin_bit_cast(unsigned, r);
}
__device__ __forceinline__ float lo2f(unsigned u) { return __uint_as_float(u << 16); }
__device__ __forceinline__ float hi2f(unsigned u) { return __uint_as_float(u & 0xffff0000u); }
__device__ __forceinline__ s16x8 as_frag(uint4 v) { return __builtin_bit_cast(s16x8, v); }
__device__ __forceinline__ f32x4 mfma16(s16x8 a, s16x8 b, f32x4 c) { return __builtin_amdgcn_mfma_f32_16x16x32_bf16(a, b, c, 0, 0, 0); }
__device__ __forceinline__ float sigmoidf_(float x) { return 1.f / (1.f + __expf(-x)); }
__device__ __forceinline__ float wave_sum(float v) {
#pragma unroll
    for (int o = 1; o < 64; o <<= 1) v += __shfl_xor(v, o);
    return v;
}
template <int CTRL> __device__ __forceinline__ float dppf(float x) {
    return __int_as_float(__builtin_amdgcn_update_dpp(0, __float_as_int(x), CTRL, 0xf, 0xf, true));
}
__device__ __forceinline__ float sum16(float x) {
    x += dppf<0xB1>(x); x += dppf<0x4E>(x); x += dppf<0x141>(x); x += dppf<0x140>(x);
    return x;
}
__device__ __forceinline__ float* resptr(const Params& P, int m) {
    return m < ML ? P.out + (size_t)m * 1024 : P.ctxres + (size_t)(m - ML) * 1024;
}
__device__ __forceinline__ const float* modrow(const Params& P, int layer, int m) {
    return P.mod + (size_t)(layer * 9 + (m < ML ? (m >> 12) : 8)) * 6144;
}

#define XB_TMO      128
#define XB_XCNT(j)  (256  + 64 * (j))
#define XB_XSUB(j)  (1280 + 64 * (j))
#define XB_XGEN(j)  (2304 + 64 * (j))
#define XB_TOP      3328
#define XB_TOPGEN   3392
#define XCD_BAR_WORDS 3456
#define XB_SPIN_CAP (1u << 22)
#define LAS __attribute__((address_space(3)))

__device__ __forceinline__ unsigned xb_ld(unsigned* p)              { return __hip_atomic_load(p, __ATOMIC_RELAXED, __HIP_MEMORY_SCOPE_AGENT); }
__device__ __forceinline__ unsigned xb_add(unsigned* p, unsigned v) { return __hip_atomic_fetch_add(p, v, __ATOMIC_RELAXED, __HIP_MEMORY_SCOPE_AGENT); }
__device__ __forceinline__ unsigned xb_xcc_id() { return (unsigned)__builtin_amdgcn_s_getreg((3 << 11) | 20) & 0xFu; }
#define XB_SPIN(cond, bar) do { unsigned _sp = 0; while (cond) { __builtin_amdgcn_s_sleep(1); \
    if ((++_sp & 255u) == 0u) { if (xb_ld(&(bar)[XB_TMO])) break; if (_sp > XB_SPIN_CAP) { atomicAdd(&(bar)[XB_TMO], 1u); break; } } } } while (0)

struct XcdBarrier {
    unsigned* bar; unsigned x;
    volatile LAS unsigned* st;
};

__device__ __forceinline__ XcdBarrier xcd_barrier_post(unsigned* bar, volatile LAS unsigned* st) {
    XcdBarrier b; b.bar = bar; b.x = xb_xcc_id(); b.st = st;
    if (threadIdx.x == 0) (void)xb_add(&bar[XB_XCNT(b.x)], 1u);
    return b;
}
__device__ __forceinline__ void xcd_barrier_complete(unsigned* bar, unsigned x, unsigned& nloc, unsigned& nx) {
    const unsigned G = gridDim.x * gridDim.y * gridDim.z;
    unsigned sum, cnt, mine, sp = 0u;
    for (;;) {
        sum = 0u; cnt = 0u; mine = 0u;
#pragma unroll
        for (unsigned j = 0; j < 16; ++j) { const unsigned c = xb_ld(&bar[XB_XCNT(j)]); sum += c; cnt += (c > 0u) ? 1u : 0u; mine = (j == x) ? c : mine; }
        if (sum == G) break;
        __builtin_amdgcn_s_sleep(1);
        if ((++sp & 255u) == 0u) { if (xb_ld(&bar[XB_TMO])) break; if (sp > XB_SPIN_CAP) { atomicAdd(&bar[XB_TMO], 1u); break; } }
    }
    nloc = mine > 0u ? mine : 1u; nx = cnt > 0u ? cnt : 1u;
}

__device__ __forceinline__ void xcd_barrier(const XcdBarrier& b) {
    asm volatile("s_waitcnt vmcnt(0)" ::: "memory");
    __syncthreads();
    if (threadIdx.x == 0) {
        unsigned* bar = b.bar;
        __builtin_amdgcn_s_waitcnt(0);
        unsigned nloc = b.st[0], nx = b.st[1];
        if (nloc == 0u) { xcd_barrier_complete(bar, b.x, nloc, nx); b.st[0] = nloc; b.st[1] = nx; }
        const unsigned old = xb_add(&bar[XB_XSUB(b.x)], 1u);
        const unsigned gen = old / nloc;
        if (old + 1u == (gen + 1u) * nloc) {
            __builtin_amdgcn_fence(__ATOMIC_RELEASE, "agent");
            asm volatile("s_waitcnt vmcnt(0)" ::: "memory");
            const unsigned og = xb_add(&bar[XB_TOP], 1u);
            const unsigned tg = og / nx;
            if (og + 1u == (tg + 1u) * nx) xb_add(&bar[XB_TOPGEN], 1u);
            else XB_SPIN(xb_ld(&bar[XB_TOPGEN]) == tg, bar);
            __builtin_amdgcn_fence(__ATOMIC_ACQUIRE, "agent");
            xb_add(&bar[XB_XGEN(b.x)], 1u);
            asm volatile("s_waitcnt vmcnt(0)" ::: "memory");
        } else {
            XB_SPIN(xb_ld(&bar[XB_XGEN(b.x)]) == gen, bar);
            __builtin_amdgcn_fence(__ATOMIC_ACQUIRE, "agent");
            asm volatile("s_waitcnt vmcnt(0)" ::: "memory");
        }
    }
    __syncthreads();
}

struct TJob { const float* src; u16* dst; int K, N, Kpad, Npad; };
__device__ __forceinline__ bool get_tjob(const Params& P, int j, TJob& t) {
    switch (j) {
    case 0: t = {P.in[6], P.wint, 1024, 3600, 1024, 3840}; return true;
    case 1: t = {P.in[12], P.woutt, 1024, 1024, 1024, 1024}; return true;
    case 2: t = {P.in[29], P.w1t[0], 1024, 4096, 1024, 4096}; return true;
    case 3: t = {P.in[29] + (size_t)1024 * 4096, P.w1t[1], 1024, 4096, 1024, 4096}; return true;
    case 4: t = {P.in[30], P.w2t[0], 4096, 1024, 4096, 1024}; return true;
    case 5: t = {P.in[30] + (size_t)1024 * 4096, P.w2t[1], 4096, 1024, 4096, 1024}; return true;
    case 6: t = {P.in[14], P.rkvt, 1024, 1024, 1024, 1024}; return true;
    case 7: t = {P.in[14] + (size_t)1024 * 1024, P.rkvt + (size_t)1024 * 1024, 1024, 1024, 1024, 1024}; return true;
    case 8: t = {P.in[14] + (size_t)2 * 1024 * 1024, P.rkvt + (size_t)2 * 1024 * 1024, 1024, 1024, 1024, 1024}; return true;
    case 9: t = {P.in[28], P.wot, 1024, 1024, 1024, 1024}; return true;
    case 10: t = {P.in[16], P.lw1t, 1024, 64, 1024, 64}; return true;
    case 11: t = {P.in[16] + 1024 * 64, P.lw1t + 64 * 1024, 1024, 64, 1024, 64}; return true;
    case 12: t = {P.in[19], P.la1t, 1024, 64, 1024, 64}; return true;
    case 13: t = {P.in[19] + 1024 * 64, P.la1t + 64 * 1024, 1024, 64, 1024, 64}; return true;
    case 14: t = {P.in[21], P.lg1t, 1024, 160, 1024, 256}; return true;
    case 15: t = {P.in[17], P.lw2t, 64, 1024, 64, 1024}; return true;
    case 16: t = {P.in[17] + 64 * 1024, P.lw2t + 1024 * 64, 64, 1024, 64, 1024}; return true;
    case 17: t = {P.in[20], P.la2t, 64, 1024, 64, 1024}; return true;
    case 18: t = {P.in[20] + 64 * 1024, P.la2t + 1024 * 64, 64, 1024, 64, 1024}; return true;
    case 19: t = {P.in[22], P.lg2t, 160, 1024, 192, 1024}; return true;
    default: return false;
    }
}

__device__ __forceinline__ void phase_prep(const Params& P, char* smem) {
    const int tid = get_tid(), lane = tid & 63, wave = tid >> 6;
    float* tile = (float*)smem;
    int ubase = 0;
    for (int j = 0; j < 20; ++j) {
        TJob t; get_tjob(P, j, t);
        const int kt = t.Kpad / 64, nt = t.Npad / 64, nu = kt * nt;
        int first = ((int)blockIdx.x - (ubase % (int)gridDim.x) + (int)gridDim.x) % (int)gridDim.x;
        for (int lu = first; lu < nu; lu += gridDim.x) {
            const int k0 = (lu % kt) * 64, n0 = (lu / kt) * 64;
            __syncthreads();
#pragma unroll
            for (int i = 0; i < 2; ++i) {
                int kr = (tid >> 4) + 32 * i, nc = (tid & 15) * 4;
                int k = k0 + kr, n = n0 + nc;
                float4 v = make_float4(0.f, 0.f, 0.f, 0.f);
                if (k < t.K && n < t.N) v = *(const float4*)(t.src + (size_t)k * t.N + n);
                tile[kr * 65 + nc + 0] = v.x; tile[kr * 65 + nc + 1] = v.y; tile[kr * 65 + nc + 2] = v.z; tile[kr * 65 + nc + 3] = v.w;
            }
            __syncthreads();
            {
                int n = tid >> 3, kc = (tid & 7) * 8;
                uint4 o;
                o.x = pack2(tile[(kc + 0) * 65 + n], tile[(kc + 1) * 65 + n]);
                o.y = pack2(tile[(kc + 2) * 65 + n], tile[(kc + 3) * 65 + n]);
                o.z = pack2(tile[(kc + 4) * 65 + n], tile[(kc + 5) * 65 + n]);
                o.w = pack2(tile[(kc + 6) * 65 + n], tile[(kc + 7) * 65 + n]);
                *(uint4*)(t.dst + (size_t)(n0 + n) * t.Kpad + k0 + kc) = o;
            }
        }
        ubase += nu;
    }
    if (blockIdx.x == 0) {
        for (int e = tid; e < 64 * 32; e += NTHREADS) {
            int pos = e >> 5, f = e & 31;
            float inv = powf(10000.f, -(float)f / 32.f);
            float ang = (float)pos * inv;
            P.ropec[e] = cosf(ang); P.ropes[e] = sinf(ang);
        }
    }
    const float* c = P.in[1]; const float* cctx = P.in[3];
    float* sSilu = (float*)smem + 64 * 65 + 3;
    __syncthreads();
    for (int e = tid; e < 9 * 1024; e += NTHREADS) {
        const int r = e >> 10, k = e & 1023;
        const float cv = (r < 8) ? c[r * 1024 + k] : cctx[k];
        sSilu[e] = cv / (1.f + __expf(-cv));
    }
    __syncthreads();
    for (int u = blockIdx.x + gridDim.x * wave; u < 2 * 384; u += gridDim.x * 8) {
        const int l = u / 384, n0 = (u % 384) * 16;
        const int ksub = lane >> 2, nq = lane & 3;
        const float* W = P.in[4] + (size_t)l * 1024 * 6144 + n0 + nq * 4;
        float acc[9][4];
#pragma unroll
        for (int r = 0; r < 9; ++r) { acc[r][0] = acc[r][1] = acc[r][2] = acc[r][3] = 0.f; }
        for (int it0 = 0; it0 < 64; it0 += 16) {
            float4 w[16];
#pragma unroll
            for (int j = 0; j < 16; ++j) w[j] = *(const float4*)(W + (size_t)((it0 + j) * 16 + ksub) * 6144);
#pragma unroll
            for (int j = 0; j < 16; ++j) {
                const int k = (it0 + j) * 16 + ksub;
#pragma unroll
                for (int r = 0; r < 9; ++r) {
                    const float cv = sSilu[r * 1024 + k];
                    acc[r][0] += cv * w[j].x; acc[r][1] += cv * w[j].y; acc[r][2] += cv * w[j].z; acc[r][3] += cv * w[j].w;
                }
            }
        }
#pragma unroll
        for (int r = 0; r < 9; ++r)
#pragma unroll
            for (int q = 0; q < 4; ++q) {
                float v = acc[r][q];
                v += __shfl_xor(v, 4); v += __shfl_xor(v, 8); v += __shfl_xor(v, 16); v += __shfl_xor(v, 32);
                acc[r][q] = v;
            }
        if (ksub == 0) {
#pragma unroll
            for (int r = 0; r < 9; ++r)
#pragma unroll
                for (int q = 0; q < 4; ++q) {
                    int n = n0 + nq * 4 + q;
                    P.mod[(size_t)(l * 9 + r) * 6144 + n] = acc[r][q] + P.in[5][l * 6144 + n];
                }
        }
    }
}

__device__ __forceinline__ void phase_norm(const Params& P, int which, u16* dst, int nrows) {
    const int lane = get_tid() & 63, wave = get_tid() >> 6;
    const int layer = which >> 1, shc = (which & 1) ? 3 : 0;
    constexpr int RB = 4;
    const int nwaves = gridDim.x * 8;
    for (int mbase = (blockIdx.x * 8 + wave) * RB; mbase < nrows; mbase += nwaves * RB) {
        float4 v[RB][4];
        float ss[RB];
#pragma unroll
        for (int q = 0; q < RB; ++q) {
            const int m = mbase + q;
            const float* src;
            if (which == 0) src = (m < ML) ? P.in[0] + (size_t)m * 1024 : P.in[2] + (size_t)(m - ML) * 1024;
            else src = resptr(P, m);
#pragma unroll
            for (int i = 0; i < 4; ++i) v[q][i] = ((const float4*)src)[lane + 64 * i];
        }
#pragma unroll
        for (int q = 0; q < RB; ++q) {
            float s = 0.f;
#pragma unroll
            for (int i = 0; i < 4; ++i) s += v[q][i].x * v[q][i].x + v[q][i].y * v[q][i].y + v[q][i].z * v[q][i].z + v[q][i].w * v[q][i].w;
            s = sum16(s);
            s += __shfl_xor(s, 16); s += __shfl_xor(s, 32);
            ss[q] = rsqrtf(s * (1.f / 1024.f) + 1e-6f);
        }
#pragma unroll
        for (int q = 0; q < RB; ++q) {
            const int m = mbase + q;
            const float* mr = modrow(P, layer, m);
            const float rinv = ss[q];
#pragma unroll
            for (int i = 0; i < 4; ++i) {
                const int col = (lane + 64 * i) * 4;
                float4 sh = *(const float4*)(mr + shc * 1024 + col);
                float4 sc = *(const float4*)(mr + (shc + 1) * 1024 + col);
                uint2 o;
                o.x = pack2(v[q][i].x * rinv * (1.f + sc.x) + sh.x, v[q][i].y * rinv * (1.f + sc.y) + sh.y);
                o.y = pack2(v[q][i].z * rinv * (1.f + sc.z) + sh.z, v[q][i].w * rinv * (1.f + sc.w) + sh.w);
                *(uint2*)(dst + (size_t)m * 1024 + col) = o;
            }
        }
    }
}

constexpr int BM = 256, BN = 256, BK = 64, LDK = 72;
enum { E_MLPDN_AT = 100, E_INPROJ = 1, E_OUT0, E_MLPUP, E_MLPDN, E_R, E_K, E_V, E_HW, E_HA, E_HG, E_E, E_A, E_GZ, E_RWOUT };

struct Epi {
    int mode, layer, z;
    u16* o16;
    int ldo;
};

__device__ __forceinline__ void epilogue(const Params& P, const Epi& E, int mb, int nb, f32x4 (&acc)[4][4], int lane) {
    const int quad = lane >> 4, l15 = lane & 15;
    switch (E.mode) {
    case E_INPROJ: {
        const int region = nb >> 9;
        if (region <= 1) {
            const float* nw = P.in[region == 0 ? 8 : 9];
            const float scale = region == 0 ? 0.125f : 1.f;
            u16* dst = P.slot[1] + (region == 0 ? 0 : HALF);
            const int cb = nb & 511;
#pragma unroll
            for (int i = 0; i < 4; ++i)
#pragma unroll
                for (int r = 0; r < 4; ++r) { __builtin_amdgcn_sched_barrier(0);
                    float ss = 0.f;
#pragma unroll
                    for (int j = 0; j < 4; ++j) ss += acc[i][j][r] * acc[i][j][r];
                    ss = sum16(ss);
                    const float rinv = rsqrtf(ss * (1.f / 64.f) + 1e-6f) * scale;
                    const int m = mb + i * 16 + quad * 4 + r;
#pragma unroll
                    for (int j = 0; j < 4; ++j)
                        dst[(size_t)m * 512 + cb + j * 16 + l15] = f2bf(acc[i][j][r] * rinv * nw[j * 16 + l15]);
                }
        } else if (region == 2 || region == 5) {
            const int hd = region == 2 ? 64 : 128, nh = region == 2 ? 8 : 4;
            u16* dst = region == 2 ? P.slot[2] : P.slot[4];
            const int cb = nb & 511;
#pragma unroll
            for (int i = 0; i < 4; ++i) {
                const int m = mb + i * 16 + quad * 4;
#pragma unroll
                for (int j = 0; j < 4; ++j) {
                    const int col = cb + j * 16 + l15, h = col / hd, d = col % hd;
                    uint2 o; o.x = pack2(acc[i][j][0], acc[i][j][1]); o.y = pack2(acc[i][j][2], acc[i][j][3]);
                    size_t off;
                    if (m < ML) off = ((size_t)((m >> 12) * nh + h) * hd + d) * 4096 + (m & 4095);
                    else { int mc = m - ML; off = (size_t)ML * 512 + ((size_t)((mc >> 8) * nh + h) * hd + d) * 256 + (mc & 255); }
                    *(uint2*)(dst + off) = o;
                }
            }
        } else if (region == 3 || region == 4) {
            const int cb = nb & 511;
            const bool colhalf = (cb & 64) != 0;
            const float scale = region == 4 ? 0.08838834764831845f : 1.f;
            u16* dst = region == 3 ? P.slot[2] + HALF : P.slot[3];
            u16* dstT = P.slot[3] + HALF;
#pragma unroll
            for (int i = 0; i < 4; ++i) {
                const int m0 = mb + i * 16 + quad * 4;
#pragma unroll
                for (int j = 0; j < 2; ++j) {
                    __builtin_amdgcn_sched_barrier(0);
                    float o1[4], o2[4];
                    const int f = j * 16 + l15;
#pragma unroll
                    for (int r = 0; r < 4; ++r) {
                        const int m = m0 + r;
                        const float x1 = acc[i][j][r] * scale, x2 = acc[i][j + 2][r] * scale;
                        if (m < ML) {
                            const int t = m & 4095, pos = colhalf ? (t & 63) : (t >> 6);
                            const float c = P.ropec[pos * 32 + f], s = P.ropes[pos * 32 + f];
                            o1[r] = x1 * c - x2 * s; o2[r] = x1 * s + x2 * c;
                        } else { o1[r] = x1; o2[r] = x2; }
                    }
#pragma unroll
                    for (int hh = 0; hh < 2; ++hh) {
                        const int col = cb + (j + 2 * hh) * 16 + l15;
#pragma unroll
                        for (int r = 0; r < 4; ++r) dst[(size_t)(m0 + r) * 512 + col] = f2bf(hh ? o2[r] : o1[r]);
                        if (region == 4) {
                            const int h = col >> 7, d = col & 127;
                            uint2 q;
                            q.x = hh ? pack2(o2[0], o2[1]) : pack2(o1[0], o1[1]);
                            q.y = hh ? pack2(o2[2], o2[3]) : pack2(o1[2], o1[3]);
                            size_t off;
                            if (m0 < ML) off = ((size_t)((m0 >> 12) * 4 + h) * 128 + d) * 4096 + (m0 & 4095);
                            else { int mc = m0 - ML; off = (size_t)ML * 512 + ((size_t)((mc >> 8) * 4 + h) * 128 + d) * 256 + (mc & 255); }
                            *(uint2*)(dstT + off) = q;
                        }
                    }
                }
            }
        } else if (region == 6) {
            u16* dst = P.slot[4] + HALF;
            const int cb = nb & 511;
#pragma unroll
            for (int i = 0; i < 4; ++i)
#pragma unroll
                for (int r = 0; r < 4; ++r) { __builtin_amdgcn_sched_barrier(0);
                    const int m = mb + i * 16 + quad * 4 + r;
#pragma unroll
                    for (int j = 0; j < 4; ++j) dst[(size_t)m * 512 + cb + j * 16 + l15] = f2bf(acc[i][j][r]);
                }
        } else if (nb == 3584) {
            const float gb = P.in[7][l15];
            const bool isf = (l15 & 4) != 0;
#pragma unroll
            for (int i = 0; i < 4; ++i)
#pragma unroll
                for (int r = 0; r < 4; ++r) { __builtin_amdgcn_sched_barrier(0);
                    const int m = mb + i * 16 + quad * 4 + r;
                    float g = acc[i][0][r] + gb;
                    g = 15.f * tanhf(g * (1.f / 15.f));
                    if (isf) g = fminf(g, 0.f) - log1pf(__expf(-fabsf(g)));
                    P.gates[(size_t)m * 16 + l15] = g;
                }
        }
    } break;
    case E_MLPDN_AT: {
#pragma unroll
        for (int i = 0; i < 4; ++i)
#pragma unroll
            for (int r = 0; r < 4; ++r) {
                const int m = mb + i * 16 + quad * 4 + r;
                const float* mr = modrow(P, E.layer, m) + 5 * 1024;
                float* rp = resptr(P, m);
#pragma unroll
                for (int j = 0; j < 4; ++j) {
                    const int n = nb + j * 16 + l15;
                    atomicAdd(rp + n, mr[n] * acc[i][j][r]);
                }
            }
    } break;
    case E_OUT0: case E_MLPDN: case E_RWOUT: {
        const int gch = (E.mode == E_MLPDN) ? 5 : 2;
#pragma unroll
        for (int i = 0; i < 4; ++i)
#pragma unroll
            for (int r = 0; r < 4; ++r) { __builtin_amdgcn_sched_barrier(0);
                const int m = mb + i * 16 + quad * 4 + r;
                const float* mr = modrow(P, E.layer, m) + gch * 1024;
                float* rp = resptr(P, m);
                const float* xin = rp;
                if (E.mode == E_OUT0) xin = (m < ML) ? P.in[0] + (size_t)m * 1024 : P.in[2] + (size_t)(m - ML) * 1024;
#pragma unroll
                for (int j = 0; j < 4; ++j) {
                    const int n = nb + j * 16 + l15;
                    rp[n] = xin[n] + mr[n] * acc[i][j][r];
                }
            }
    } break;
    case E_MLPUP: case E_R: case E_V: case E_HW: case E_HA: case E_HG: {
#pragma unroll
        for (int i = 0; i < 4; ++i)
#pragma unroll
            for (int r = 0; r < 4; ++r) { __builtin_amdgcn_sched_barrier(0);
                const int m = mb + i * 16 + quad * 4 + r;
#pragma unroll
                for (int j = 0; j < 4; ++j) {
                    const int n = nb + j * 16 + l15;
                    float v = acc[i][j][r];
                    if (E.mode == E_MLPUP) { v = fmaxf(v, 0.f); v = v * v; }
                    else if (E.mode == E_HW) v = tanhf(v);
                    else if (E.mode == E_HG) v = sigmoidf_(v);
                    if (n < E.ldo) E.o16[(size_t)m * E.ldo + n] = f2bf(v);
                }
            }
    } break;
    case E_K: {
        const int hd = nb >> 6;
        const float* kk = P.in[23];
#pragma unroll
        for (int i = 0; i < 4; ++i)
#pragma unroll
            for (int r = 0; r < 4; ++r) { __builtin_amdgcn_sched_barrier(0);
                const int m = mb + i * 16 + quad * 4 + r;
                float ss = 0.f;
#pragma unroll
                for (int j = 0; j < 4; ++j) { float v = acc[i][j][r] * kk[nb + j * 16 + l15]; ss += v * v; }
                ss = sum16(ss);
                if (l15 == 0) P.knorm[(size_t)m * 16 + hd] = 1.f / fmaxf(sqrtf(ss), 1e-12f);
#pragma unroll
                for (int j = 0; j < 4; ++j) E.o16[(size_t)m * 1024 + nb + j * 16 + l15] = f2bf(acc[i][j][r]);
            }
    } break;
    case E_E: {
        const float* w0 = P.in[15] + E.z * 1024;
#pragma unroll
        for (int i = 0; i < 4; ++i)
#pragma unroll
            for (int r = 0; r < 4; ++r) { __builtin_amdgcn_sched_barrier(0);
                const int m = mb + i * 16 + quad * 4 + r;
#pragma unroll
                for (int j = 0; j < 4; ++j) {
                    const int n = nb + j * 16 + l15;
                    E.o16[(size_t)m * 1024 + n] = f2bf(sigmoidf_(w0[n] + acc[i][j][r]) * 0.6065306597126334f);
                }
            }
    } break;
    case E_A: {
        const float* a0 = P.in[18] + E.z * 1024;
        u8* dst = (u8*)P.slot[0] + (size_t)E.z * MA * 1024;
#pragma unroll
        for (int i = 0; i < 4; ++i)
#pragma unroll
            for (int r = 0; r < 4; ++r) { __builtin_amdgcn_sched_barrier(0);
                const int m = mb + i * 16 + quad * 4 + r;
#pragma unroll
                for (int j = 0; j < 4; ++j) {
                    const int n = nb + j * 16 + l15;
                    float a = sigmoidf_(a0[n] + acc[i][j][r]);
                    dst[(size_t)m * 1024 + n] = (u8)__float2int_rn(a * 255.f);
                }
            }
    } break;
    default: break;
    }
}

__device__ __forceinline__ void epilogue_t(const Params& P, const Epi& E, int mb, int nb, f32x4 (&acc)[4][4], int lane) {
    const int quad = lane >> 4, l15 = lane & 15;
#pragma unroll
    for (int i = 0; i < 4; ++i) {
        const int m = mb + i * 16 + l15;
#pragma unroll
        for (int j = 0; j < 4; ++j) {
            const int n = nb + j * 16 + quad * 4;
            const f32x4 v = acc[i][j];
            if (E.mode == E_E) {
                const float4 w0 = *(const float4*)(P.in[15] + E.z * 1024 + n);
                uint2 o;
                o.x = pack2(sigmoidf_(w0.x + v[0]) * 0.6065306597126334f, sigmoidf_(w0.y + v[1]) * 0.6065306597126334f);
                o.y = pack2(sigmoidf_(w0.z + v[2]) * 0.6065306597126334f, sigmoidf_(w0.w + v[3]) * 0.6065306597126334f);
                *(uint2*)(E.o16 + (size_t)m * 1024 + n) = o;
            } else if (E.mode == E_A) {
                const float4 a0 = *(const float4*)(P.in[18] + E.z * 1024 + n);
                u8* dst = (u8*)P.slot[0] + (size_t)E.z * MA * 1024;
                const unsigned b0 = (unsigned)__float2int_rn(sigmoidf_(a0.x + v[0]) * 255.f), b1 = (unsigned)__float2int_rn(sigmoidf_(a0.y + v[1]) * 255.f);
                const unsigned b2 = (unsigned)__float2int_rn(sigmoidf_(a0.z + v[2]) * 255.f), b3 = (unsigned)__float2int_rn(sigmoidf_(a0.w + v[3]) * 255.f);
                *(unsigned*)(dst + (size_t)m * 1024 + n) = b0 | (b1 << 8) | (b2 << 16) | (b3 << 24);
            } else {
                if (n < E.ldo) {
                    uint2 o; o.x = pack2(v[0], v[1]); o.y = pack2(v[2], v[3]);
                    *(uint2*)(E.o16 + (size_t)m * E.ldo + n) = o;
                }
            }
        }
    }
}

typedef float v2f_ __attribute__((ext_vector_type(2)));
__device__ __forceinline__ unsigned mixw(unsigned c, unsigned pm, unsigned pn, v2f_ mu) {
    const v2f_ c2 = {lo2f(c), hi2f(c)}, p2 = {lo2f(pm), hi2f(pm)}, n2 = {lo2f(pn), hi2f(pn)};
    const v2f_ half = {0.5f, 0.5f};
    const v2f_ x2 = __builtin_elementwise_fma(p2 + n2, half, -c2);
    const v2f_ o2 = __builtin_elementwise_fma(x2, mu, c2);
    return pack2(o2.x, o2.y);
}
__device__ __forceinline__ int g8_lds_byte(int r, int c);
__device__ __forceinline__ void g8_stage_rc(int b, int& R, int& C);
template <int AMODE>
__device__ __forceinline__ void gemm_tile(const Params& P, const u16* __restrict__ A, int lda, const u16* __restrict__ Bt, int K,
                                          int m0, int n0, const float* mu, const Epi& E, char* smem) {
    const int tid = get_tid(), lane = tid & 63, wave = tid >> 6;
    const int quad = lane >> 4, l15 = lane & 15;
    const int wm = wave >> 1, wn = wave & 1;
    u16* sA = (u16*)smem;
    u16* sB = sA + 2 * BM * LDK;
    const int lrow = tid >> 3, lkc = (tid & 7) * 8;
    f32x4 acc[2][4][4];
#pragma unroll
    for (int h = 0; h < 2; ++h)
#pragma unroll
        for (int i = 0; i < 4; ++i)
#pragma unroll
            for (int j = 0; j < 4; ++j) acc[h][i][j] = (f32x4){0.f, 0.f, 0.f, 0.f};

    uint4 ra0 = make_uint4(0, 0, 0, 0), ra1 = ra0, ra2 = ra0, ra3 = ra0;
    uint4 rb0 = ra0, rb1 = ra0, rb2 = ra0, rb3 = ra0;
    uint4 hm = ra0, hp = ra0;
    int offm = 0, offp = 0; float fm0 = 0.5f, fp3 = 0.5f;
    if (AMODE) {
        const int len = (m0 < ML) ? 4096 : 256;
        const int tb = (m0 < ML) ? (m0 & 4095) : ((m0 - ML) & 255);
        const bool hasprev = !(lrow == 0 && tb == 0), hasnext = !(lrow == 63 && tb + 256 == len);
        offm = hasprev ? lda : 0; offp = hasnext ? 4 * lda : 0;
        fm0 = hasprev ? 0.5f : 0.f; fp3 = hasnext ? 0.5f : 0.f;
    }
    unsigned gvoff0 = 0, gvoff1 = 0; int gfrag = 0;
    if (AMODE) {
        int r0, c0, r1, c1;
        g8_stage_rc(tid * 16, r0, c0); g8_stage_rc(tid * 16 + 8192, r1, c1);
        gvoff0 = (unsigned)(r0 * K + c0) * 2u; gvoff1 = (unsigned)(r1 * K + c1) * 2u;
        gfrag = g8_lds_byte(l15, quad * 8);
    }
    int nk = K / BK;
    asm volatile("" : "+s"(nk));
    for (int kt = -1; kt < nk; ++kt) {
        const bool more = kt + 1 < nk;
        if (more) {
            const int k0 = (kt + 1) * BK;
            if (!AMODE) {
                const u16* p = A + (size_t)(m0 + lrow) * lda + k0 + lkc;
                ra0 = *(const uint4*)p; ra1 = *(const uint4*)(p + (size_t)64 * lda);
                ra2 = *(const uint4*)(p + (size_t)128 * lda); ra3 = *(const uint4*)(p + (size_t)192 * lda);
            } else {
                const u16* p = A + (size_t)(m0 + 4 * lrow) * lda + k0 + lkc;
                ra0 = *(const uint4*)p; ra1 = *(const uint4*)(p + lda);
                ra2 = *(const uint4*)(p + 2 * lda); ra3 = *(const uint4*)(p + 3 * lda);
                hm = *(const uint4*)(p - offm); hp = *(const uint4*)(p + offp);
            }
            if (!AMODE) {
                const u16* q = Bt + (size_t)(n0 + lrow) * K + k0 + lkc;
                rb0 = *(const uint4*)q; rb1 = *(const uint4*)(q + (size_t)64 * K);
                rb2 = *(const uint4*)(q + (size_t)128 * K); rb3 = *(const uint4*)(q + (size_t)192 * K);
            } else {
                const int nbuf = (kt + 1) & 1;
#pragma unroll
                for (int hh = 0; hh < 2; ++hh) {
                    const char* gb = (const char*)Bt + ((long)(n0 + hh * 128) * K + k0) * 2;
                    char* dst = (char*)sB + (nbuf * 2 + hh) * 16384 + tid * 16;
                    __builtin_amdgcn_global_load_lds((const unsigned*)(gb + gvoff0), (LAS unsigned*)dst, 16, 0, 0);
                    __builtin_amdgcn_global_load_lds((const unsigned*)(gb + gvoff1), (LAS unsigned*)(dst + 8192), 16, 0, 0);
                }
            }
        }
        if (kt >= 0) {
            const u16* a = sA + (kt & 1) * BM * LDK + (wm * 64 + l15) * LDK + quad * 8;
            const u16* b = sB + (kt & 1) * BN * LDK + (wn * 128 + l15) * LDK + quad * 8;
            const char* bq = (const char*)sB + ((kt & 1) * 2 + wn) * 16384 + gfrag;
#pragma unroll
            for (int ks = 0; ks < 2; ++ks) {
                s16x8 af[4];
#pragma unroll
                for (int i = 0; i < 4; ++i) af[i] = as_frag(*(const uint4*)(a + i * 16 * LDK + ks * 32));
#pragma unroll
                for (int h = 0; h < 2; ++h) {
                    s16x8 bfr[4];
#pragma unroll
                    for (int j = 0; j < 4; ++j) {
                        if (AMODE) bfr[j] = as_frag(*(const uint4*)(bq + ((h * 4 + j) * 2 + ks) * 1024));
                        else bfr[j] = as_frag(*(const uint4*)(b + (h * 64 + j * 16) * LDK + ks * 32));
                    }
#pragma unroll
                    for (int i = 0; i < 4; ++i)
#pragma unroll
                        for (int j = 0; j < 4; ++j) acc[h][i][j] = AMODE ? mfma16(af[i], bfr[j], acc[h][i][j]) : mfma16(bfr[j], af[i], acc[h][i][j]);
                }
            }
        }
        if (more) {
            const int k0 = (kt + 1) * BK, buf = (kt + 1) & 1;
            u16* a = sA + buf * BM * LDK; u16* b = sB + buf * BN * LDK;
            if (AMODE) {
                const float4 mu0 = *(const float4*)(mu + k0 + lkc), mu1 = *(const float4*)(mu + k0 + lkc + 4);
#define MIXW(C, PM, PN, M2) mixw((C), (PM), (PN), (M2))
#define MIXROW(C, PM, PN) make_uint4(MIXW(C.x, PM.x, PN.x, muA), MIXW(C.y, PM.y, PN.y, muB), MIXW(C.z, PM.z, PN.z, muC), MIXW(C.w, PM.w, PN.w, muD))
                const v2f_ muA = {mu0.x, mu0.y}, muB = {mu0.z, mu0.w}, muC = {mu1.x, mu1.y}, muD = {mu1.z, mu1.w};
                uint4 hmz = hm, hpz = hp;
                if (fm0 == 0.f) hmz = make_uint4(0, 0, 0, 0);
                if (fp3 == 0.f) hpz = make_uint4(0, 0, 0, 0);
                *(uint4*)(a + (4 * lrow + 0) * LDK + lkc) = MIXROW(ra0, hmz, ra1);
                *(uint4*)(a + (4 * lrow + 1) * LDK + lkc) = MIXROW(ra1, ra0, ra2);
                *(uint4*)(a + (4 * lrow + 2) * LDK + lkc) = MIXROW(ra2, ra1, ra3);
                *(uint4*)(a + (4 * lrow + 3) * LDK + lkc) = MIXROW(ra3, ra2, hpz);
#undef MIXROW
#undef MIXW
            } else {
                *(uint4*)(a + lrow * LDK + lkc) = ra0; *(uint4*)(a + (lrow + 64) * LDK + lkc) = ra1;
                *(uint4*)(a + (lrow + 128) * LDK + lkc) = ra2; *(uint4*)(a + (lrow + 192) * LDK + lkc) = ra3;
            }
            if (!AMODE) {
                *(uint4*)(b + lrow * LDK + lkc) = rb0; *(uint4*)(b + (lrow + 64) * LDK + lkc) = rb1;
                *(uint4*)(b + (lrow + 128) * LDK + lkc) = rb2; *(uint4*)(b + (lrow + 192) * LDK + lkc) = rb3;
            }
        }
        if (AMODE) asm volatile("s_waitcnt vmcnt(0)" ::: "memory");
        __syncthreads();
    }
    int lane_e = lane;
    asm volatile("" : "+v"(lane_e));
    if (!AMODE) {
        epilogue_t(P, E, m0 + wm * 64, n0 + wn * 128, acc[0], lane_e);
        epilogue_t(P, E, m0 + wm * 64, n0 + wn * 128 + 64, acc[1], lane_e);
        return;
    }
    {
        float* park = (float*)smem;
#pragma unroll
        for (int i = 0; i < 4; ++i)
#pragma unroll
            for (int j = 0; j < 4; ++j)
#pragma unroll
                for (int r = 0; r < 4; ++r) park[((i * 4 + j) * 4 + r) * NTHREADS + tid] = acc[1][i][j][r];
        __builtin_amdgcn_sched_barrier(0);
        epilogue(P, E, m0 + (lane_e >> 6) * 0 + wm * 64, n0 + wn * 128, acc[0], lane_e);
        __builtin_amdgcn_sched_barrier(0);
#pragma unroll
        for (int i = 0; i < 4; ++i)
#pragma unroll
            for (int j = 0; j < 4; ++j)
#pragma unroll
                for (int r = 0; r < 4; ++r) acc[0][i][j][r] = park[((i * 4 + j) * 4 + r) * NTHREADS + tid];
        __builtin_amdgcn_sched_barrier(0);
        epilogue(P, E, m0 + wm * 64, n0 + wn * 128 + 64, acc[0], lane_e);
        __syncthreads();
    }
}


constexpr int G8_HT = 128 * 64;
__device__ __forceinline__ int g8_lds_byte(int r, int c) {
    int st = (r >> 4) * 2 + (c >> 5), rr = r & 15, cc = c & 31, ob = rr * 64 + cc * 2;
    return st * 1024 + (ob ^ (((ob >> 9) & 1) << 5));
}
__device__ __forceinline__ void g8_stage_rc(int b, int& R, int& C) {
    int st = b / 1024, sb = b % 1024, swz = sb ^ (((sb >> 9) & 1) << 5);
    R = (st >> 1) * 16 + swz / 64; C = (st & 1) * 32 + (swz % 64) / 2;
}
__device__ __forceinline__ void gemm8_tile(const Params& P, const u16* __restrict__ A, const u16* __restrict__ Bt, const int K,
                                           const int brow, const int bcol, const Epi& E, char* smem, const int kext = 0) {
    u16* shm = (u16*)smem;
#define G8_SA(b, h) (shm + ((b) * 2 + (h)) * G8_HT)
#define G8_SB(b, h) (shm + (4 + (b) * 2 + (h)) * G8_HT)
#define G8_STAGE_A(PTR, br, kt) do { const char* _gb = (const char*)A + ((long)(br) * K + (long)(kt) * 64) * 2; \
    __builtin_amdgcn_global_load_lds((const unsigned*)(_gb + voffA0), (LAS unsigned*)((char*)(PTR) + tidx * 16), 16, 0, 0); \
    __builtin_amdgcn_global_load_lds((const unsigned*)(_gb + voffA1), (LAS unsigned*)((char*)(PTR) + tidx * 16 + 8192), 16, 0, 0); } while (0)
#define G8_STAGE_B(PTR, hh, kt) do { const char* _gb = (const char*)Bt + ((long)(bcol + (hh) * 32) * K + (long)(kt) * 64) * 2; \
    __builtin_amdgcn_global_load_lds((const unsigned*)(_gb + voffB0), (LAS unsigned*)((char*)(PTR) + tidx * 16), 16, 0, 0); \
    __builtin_amdgcn_global_load_lds((const unsigned*)(_gb + voffB1), (LAS unsigned*)((char*)(PTR) + tidx * 16 + 8192), 16, 0, 0); } while (0)
#define G8_LDA(dst, b, h) for (int m = 0; m < 4; ++m) for (int k = 0; k < 2; ++k) \
    dst[m][k] = *reinterpret_cast<const s16x8*>(aBase + ((b) * 2 + (h)) * (G8_HT * 2) + (2 * m + k) * 1024)
#define G8_LDB(dst, b, h) for (int n = 0; n < 2; ++n) for (int k = 0; k < 2; ++k) \
    dst[n][k] = *reinterpret_cast<const s16x8*>(bBase + ((b) * 2 + (h)) * (G8_HT * 2) + (2 * n + k) * 1024)
#define G8_MMA(ai, bj, At_, Bt_) do { __builtin_amdgcn_s_setprio(1); \
    for (int m = 0; m < 4; ++m) for (int n = 0; n < 2; ++n) for (int k = 0; k < 2; ++k) \
        acc[ai][bj][m][n] = __builtin_amdgcn_mfma_f32_16x16x32_bf16(At_[m][k], Bt_[n][k], acc[ai][bj][m][n], 0, 0, 0); \
    __builtin_amdgcn_s_setprio(0); } while (0)
#define G8_WAIT_V(n) asm volatile("s_waitcnt vmcnt(" #n ")" ::: "memory")
#define G8_WAIT_L(n) asm volatile("s_waitcnt lgkmcnt(" #n ")" ::: "memory")
#define G8_BAR __builtin_amdgcn_s_barrier()
#define G8_SCHED __builtin_amdgcn_sched_barrier(0)
    const int tidx = get_tid();
    const int wid = tidx >> 6, lane = tidx & 63, wr = wid >> 2, wc = wid & 3, fr = lane & 15, fq = lane >> 4;
    const char* aBase = (const char*)shm + g8_lds_byte(wr * 64 + fr, fq * 8);
    const char* bBase = (const char*)shm + 4 * (G8_HT * 2) + g8_lds_byte(wc * 32 + fr, fq * 8);
    unsigned voffA0, voffA1, voffB0, voffB1;
    {
        int r0, c0, r1, c1;
        g8_stage_rc(tidx * 16, r0, c0); g8_stage_rc(tidx * 16 + 8192, r1, c1);
        voffA0 = (unsigned)(r0 * K + c0) * 2u; voffA1 = (unsigned)(r1 * K + c1) * 2u;
        voffB0 = (unsigned)((((r0 >> 5) << 6) + (r0 & 31)) * K + c0) * 2u; voffB1 = (unsigned)((((r1 >> 5) << 6) + (r1 & 31)) * K + c1) * 2u;
    }
    f32x4 acc[2][2][4][2];
#pragma unroll
    for (int a = 0; a < 2; ++a)
#pragma unroll
        for (int b = 0; b < 2; ++b)
#pragma unroll
            for (int m = 0; m < 4; ++m)
#pragma unroll
                for (int n = 0; n < 2; ++n) acc[a][b][m][n] = (f32x4){0.f, 0.f, 0.f, 0.f};
    s16x8 At[4][2], B0[2][2], B1[2][2];
    int nt = (kext ? kext : K) / 64;
    asm volatile("" : "+s"(nt));
    G8_STAGE_B(G8_SB(0, 0), 0, 0); G8_STAGE_A(G8_SA(0, 0), brow, 0);
    G8_STAGE_B(G8_SB(0, 1), 1, 0); G8_STAGE_A(G8_SA(0, 1), brow + 128, 0);
    if (wr == 1) G8_BAR;
    G8_WAIT_V(4); G8_BAR;
    G8_STAGE_B(G8_SB(1, 0), 0, 1); G8_STAGE_A(G8_SA(1, 0), brow, 1); G8_STAGE_B(G8_SB(1, 1), 1, 1);
    G8_WAIT_V(6); G8_BAR;
    for (int t = 0; t < nt - 2; t += 2) {
        G8_LDB(B0, 0, 0); G8_SCHED; G8_LDA(At, 0, 0); G8_STAGE_A(G8_SA(1, 1), brow + 128, t + 1);
        G8_WAIT_L(8); G8_BAR; G8_WAIT_L(0); G8_MMA(0, 0, At, B0); G8_BAR; G8_SCHED;
        G8_LDB(B1, 0, 1); G8_STAGE_B(G8_SB(0, 0), 0, t + 2);
        G8_BAR; G8_WAIT_L(0); G8_MMA(0, 1, At, B1); G8_BAR;
        G8_LDA(At, 0, 1); G8_STAGE_A(G8_SA(0, 0), brow, t + 2);
        G8_BAR; G8_WAIT_L(0); G8_MMA(1, 0, At, B0); G8_BAR; G8_SCHED;
        G8_STAGE_B(G8_SB(0, 1), 1, t + 2);
        G8_WAIT_V(6); G8_BAR; G8_MMA(1, 1, At, B1); G8_BAR;
        G8_LDB(B0, 1, 0); G8_SCHED; G8_LDA(At, 1, 0); G8_STAGE_A(G8_SA(0, 1), brow + 128, t + 2);
        G8_WAIT_L(8); G8_BAR; G8_WAIT_L(0); G8_MMA(0, 0, At, B0); G8_BAR; G8_SCHED;
        G8_LDB(B1, 1, 1); G8_STAGE_B(G8_SB(1, 0), 0, t + 3);
        G8_BAR; G8_WAIT_L(0); G8_MMA(0, 1, At, B1); G8_BAR;
        G8_LDA(At, 1, 1); G8_STAGE_A(G8_SA(1, 0), brow, t + 3);
        G8_BAR; G8_WAIT_L(0); G8_MMA(1, 0, At, B0); G8_BAR; G8_SCHED;
        G8_STAGE_B(G8_SB(1, 1), 1, t + 3);
        G8_WAIT_V(6); G8_BAR; G8_MMA(1, 1, At, B1); G8_BAR;
    }
    { G8_LDB(B0, 0, 0); G8_LDA(At, 0, 0); G8_STAGE_A(G8_SA(1, 1), brow + 128, nt - 1);
      G8_BAR; G8_WAIT_L(0); G8_MMA(0, 0, At, B0); G8_BAR;
      G8_LDB(B1, 0, 1); G8_BAR; G8_WAIT_L(0); G8_MMA(0, 1, At, B1); G8_BAR;
      G8_LDA(At, 0, 1); G8_WAIT_V(4); G8_BAR; G8_WAIT_L(0); G8_MMA(1, 0, At, B0); G8_MMA(1, 1, At, B1); G8_BAR; }
    { G8_LDB(B0, 1, 0); G8_LDA(At, 1, 0); G8_WAIT_V(2); G8_BAR; G8_WAIT_L(0); G8_MMA(0, 0, At, B0); G8_BAR;
      G8_LDB(B1, 1, 1); G8_WAIT_V(0); G8_BAR; G8_WAIT_L(0); G8_MMA(0, 1, At, B1); G8_BAR;
      G8_LDA(At, 1, 1); G8_BAR; G8_WAIT_L(0); G8_MMA(1, 0, At, B0); G8_MMA(1, 1, At, B1); G8_BAR; }
    if (wr == 0) G8_BAR;
    __syncthreads();
    const int tid_e = get_tid();
    const int lane_e = tid_e & 63, wr_e = tid_e >> 8, wc_e = (tid_e >> 6) & 3;
    {
        f32x4 blk[4][4];
#pragma unroll
        for (int i = 0; i < 4; ++i)
#pragma unroll
            for (int j = 0; j < 4; ++j) blk[i][j] = acc[0][j >> 1][i][j & 1];
        epilogue(P, E, brow + wr_e * 64, bcol + wc_e * 64, blk, lane_e);
        __builtin_amdgcn_sched_barrier(0);
#pragma unroll
        for (int i = 0; i < 4; ++i)
#pragma unroll
            for (int j = 0; j < 4; ++j) blk[i][j] = acc[1][j >> 1][i][j & 1];
        epilogue(P, E, brow + 128 + wr_e * 64, bcol + wc_e * 64, blk, lane_e);
    }
}

__device__ __forceinline__ int xcd_swz(int u0) {
    const int G = gridDim.x, per = G >> 3;
    const int rd = u0 / G, idx = u0 - rd * G;
    return rd * G + (idx & 7) * per + (idx >> 3);
}
struct GJob { const u16* A; int lda; const u16* Bt; int K; const float* mu; Epi E; };

__device__ __forceinline__ void rw2_job(const Params& P, int ntile, GJob& g, int& nt) {
    const int j = ntile >> 2; nt = ntile & 3;
    if (j == 0) g = {P.hw, 128, P.lw2t, 64, nullptr, {E_E, 1, 0, P.slot[4], 1024}};
    else if (j == 1) g = {P.hw + 64, 128, P.lw2t + 1024 * 64, 64, nullptr, {E_E, 1, 1, P.slot[5], 1024}};
    else if (j == 2) g = {P.ha, 128, P.la2t, 64, nullptr, {E_A, 1, 0, nullptr, 0}};
    else g = {P.ha + 64, 128, P.la2t + 1024 * 64, 64, nullptr, {E_A, 1, 1, nullptr, 0}};
}
__device__ __forceinline__ void phase_rw1(const Params& P, char* smem) {
    const int total = 15 * (MA / BM);
    const int totr = (total + gridDim.x - 1) / gridDim.x * gridDim.x;
    for (int u0 = blockIdx.x; u0 < totr; u0 += gridDim.x) {
        const int u = xcd_swz(u0);
        if (u >= total) continue;
        const int ntile = u % 15;
        const int jid = ntile < 12 ? (ntile >> 2) : ntile - 9;
        const int nt = ntile < 12 ? (ntile & 3) : 0;
        const int muidx = (0x541320 >> (4 * jid)) & 15;
        const u16* Bt = jid == 0 ? P.rkvt : jid == 1 ? P.rkvt + (size_t)1024 * 1024 : jid == 2 ? P.rkvt + (size_t)2 * 1024 * 1024
                        : jid == 3 ? P.lw1t : jid == 4 ? P.la1t : P.lg1t;
        u16* o16 = jid == 0 ? P.slot[1] : jid == 1 ? P.slot[2] : jid == 2 ? P.slot[3] : jid == 3 ? P.hw : jid == 4 ? P.ha : P.hg;
        Epi E;
        E.mode = E_R + jid; E.layer = 1; E.z = 0; E.o16 = o16; E.ldo = jid < 3 ? 1024 : (jid < 5 ? 128 : 192);
        gemm_tile<1>(P, P.slot[0], 1024, Bt, 1024, (u / 15) * BM, nt * BN, P.in[13] + muidx * 1024, E, smem);
    }
}
__device__ __forceinline__ void phase_rw2(const Params& P, char* smem) {
    const int total = 16 * (MA / BM);
    const int totr = (total + gridDim.x - 1) / gridDim.x * gridDim.x;
    for (int u0 = blockIdx.x; u0 < totr; u0 += gridDim.x) {
        const int u = xcd_swz(u0);
        if (u >= total) continue;
        GJob g; int nt; rw2_job(P, u % 16, g, nt);
        gemm_tile<0>(P, g.A, g.lda, g.Bt, g.K, (u / 16) * BM, nt * BN, nullptr, g.E, smem);
    }
}

__device__ __forceinline__ void phase_mlpdn0(const Params& P, char* smem) {
    const u16* A = P.slot[1]; const u16* Bt = P.w2t[0];
    const int total = 512 + 256;
    for (int u0 = blockIdx.x; u0 < total; u0 += gridDim.x) {
        const int u = xcd_swz(u0);
        if (u < 512) {
            Epi E{E_MLPDN, 0, 0, nullptr, 0};
            gemm8_tile(P, A, Bt, 4096, (u >> 2) * BM, (u & 3) * BN, E, smem);
        } else {
            const int v = u - 512, ks = v & 7, t = v >> 3;
            Epi E{E_MLPDN_AT, 0, 0, nullptr, 0};
            gemm8_tile(P, A + ks * 512, Bt + ks * 512, 4096, (128 + (t >> 2)) * BM, (t & 3) * BN, E, smem, 512);
        }
    }
}

__device__ __forceinline__ void gemm_single(const Params& P, const u16* A, int lda, const u16* Bt, int K, int ntn, int m_tiles, Epi E, char* smem) {
    const int total = ntn * m_tiles;
    const int totr = (total + gridDim.x - 1) / gridDim.x * gridDim.x;
    for (int u0 = blockIdx.x; u0 < totr; u0 += gridDim.x) {
        const int u = xcd_swz(u0);
        if (u >= total) continue;
        const int nt = u % ntn, mt = u / ntn;
        if (K >= 256 && lda == K) gemm8_tile(P, A, Bt, K, mt * BM, nt * BN, E, smem);
        else gemm_tile<0>(P, A, lda, Bt, K, mt * BM, nt * BN, nullptr, E, smem);
    }
}

__device__ __forceinline__ void na_unit(const Params& P, int b, int h, int rp, bool ctxq, int half, char* smem) {
    const int tid = get_tid(), lane = tid & 63, wave = tid >> 6, quad = lane >> 4, l15 = lane & 15;
    u16* sK = (u16*)smem;
    u16* sVT = sK + 64 * 72;
    float* sBias = (float*)(sK + 4 * 64 * 72);
    const u16* QA = P.slot[1]; const u16* KA = P.slot[1] + HALF; const u16* VAT = P.slot[2];
    u16* CAT = P.slot[0];
    int qrow = 0, c = 0, m, rs_q = 0, rsA = 0, nrows = 0, cs = 0;
    if (!ctxq) {
        const int r0 = 2 * rp;
        qrow = r0 + (wave >> 2); c = (wave & 3) * 16 + l15;
        m = b * 4096 + qrow * 64 + c;
        rs_q = min(max(qrow - 4, 0), 56);
        rsA = min(max(r0 - 4, 0), 56);
        const int rsB = min(max(r0 + 1 - 4, 0), 56);
        nrows = rsB - rsA + 8;
        cs = min(max(c - 8, 0), 48);
    } else {
        m = ML + b * 256 + (half * 8 + wave) * 16 + l15;
    }
    __syncthreads();
    if (!ctxq) for (int e = tid; e < 15 * 31; e += NTHREADS) sBias[e] = P.in[10][h * 465 + e];
    s16x8 qf[2];
#pragma unroll
    for (int ks = 0; ks < 2; ++ks) qf[ks] = as_frag(*(const uint4*)(QA + (size_t)m * 512 + h * 64 + ks * 32 + quad * 8));
    float m_run = -INFINITY, l_run = 0.f;
    f32x4 o[4];
#pragma unroll
    for (int dt = 0; dt < 4; ++dt) o[dt] = (f32x4){0.f, 0.f, 0.f, 0.f};
    const int nblk = nrows + 4;
    const int lrow = tid >> 3, lch = (tid & 7) * 8;
    int ktmask = 15;
    if (!ctxq) {
        const int cq0 = (wave & 3) * 16;
        const int lo = min(max(cq0 - 8, 0), 48), hi = min(max(cq0 + 15 - 8, 0), 48) + 15;
        ktmask = 0;
#pragma unroll
        for (int kt = 0; kt < 4; ++kt) if (kt * 16 + 15 >= lo && kt * 16 <= hi) ktmask |= 1 << kt;
    }
    uint4 pk_, pv_;
    auto gload = [&](int blk) {
        const bool isctx = blk >= nrows;
        const u16 *kp, *vp;
        if (!isctx) {
            const int tk = (rsA + blk) * 64;
            kp = KA + (size_t)(b * 4096 + tk + lrow) * 512 + h * 64 + lch;
            vp = VAT + ((size_t)(b * 8 + h) * 64 + lrow) * 4096 + tk + lch;
        } else {
            const int nk0 = (blk - nrows) * 64;
            kp = KA + (size_t)(ML + b * 256 + nk0 + lrow) * 512 + h * 64 + lch;
            vp = VAT + (size_t)ML * 512 + ((size_t)(b * 8 + h) * 64 + lrow) * 256 + nk0 + lch;
        }
        pk_ = *(const uint4*)kp; pv_ = *(const uint4*)vp;
    };
    gload(0);
    __syncthreads();
    *(uint4*)(sK + lrow * 72 + lch) = pk_; *(uint4*)(sVT + lrow * 72 + lch) = pv_;
    __syncthreads();
    for (int blk = 0; blk < nblk; ++blk) {
        const bool isctx = blk >= nrows;
        const u16* cK = sK + (blk & 1) * 2 * 64 * 72;
        const u16* cVT = cK + 64 * 72;
        if (blk + 1 < nblk) gload(blk + 1);
        const int kr = rsA + blk;
        const int kmask = isctx ? 15 : ktmask;
        if (isctx || (kr >= rs_q && kr < rs_q + 8)) {
            f32x4 s[4];
#pragma unroll
            for (int kt = 0; kt < 4; ++kt) {
                s[kt] = (f32x4){0.f, 0.f, 0.f, 0.f};
                if (kmask & (1 << kt)) {
#pragma unroll
                    for (int ks = 0; ks < 2; ++ks) {
                        s16x8 a = as_frag(*(const uint4*)(cK + (kt * 16 + l15) * 72 + ks * 32 + quad * 8));
                        s[kt] = mfma16(a, qf[ks], s[kt]);
                    }
                }
            }
            float mx = -INFINITY;
#pragma unroll
            for (int kt = 0; kt < 4; ++kt)
#pragma unroll
                for (int r = 0; r < 4; ++r) {
                    float v = s[kt][r];
                    if (!isctx) {
                        const int kc = kt * 16 + quad * 4 + r;
                        const bool valid = (kc >= cs) && (kc < cs + 16);
                        v = valid ? v + sBias[(kr - qrow + 7) * 31 + (kc - c + 15)] : -INFINITY;
                    }
                    s[kt][r] = v; mx = fmaxf(mx, v);
                }
            mx = fmaxf(mx, __shfl_xor(mx, 16)); mx = fmaxf(mx, __shfl_xor(mx, 32));
            const float m_new = fmaxf(m_run, mx);
            const float alpha = __expf(m_run - m_new);
            m_run = m_new;
            float ps = 0.f;
#pragma unroll
            for (int kt = 0; kt < 4; ++kt)
#pragma unroll
                for (int r = 0; r < 4; ++r) { float pv = __expf(s[kt][r] - m_new); s[kt][r] = pv; ps += pv; }
            l_run = l_run * alpha + ps;
#pragma unroll
            for (int dt = 0; dt < 4; ++dt) { o[dt][0] *= alpha; o[dt][1] *= alpha; o[dt][2] *= alpha; o[dt][3] *= alpha; }
#pragma unroll
            for (int sb = 0; sb < 2; ++sb) {
                if (kmask & (3 << (2 * sb))) {
                    uint4 pb;
                    pb.x = pack2(s[2 * sb][0], s[2 * sb][1]); pb.y = pack2(s[2 * sb][2], s[2 * sb][3]);
                    pb.z = pack2(s[2 * sb + 1][0], s[2 * sb + 1][1]); pb.w = pack2(s[2 * sb + 1][2], s[2 * sb + 1][3]);
                    const s16x8 bfrag = as_frag(pb);
#pragma unroll
                    for (int dt = 0; dt < 4; ++dt) {
                        const u16* vr = cVT + (dt * 16 + l15) * 72 + sb * 32 + quad * 4;
                        uint2 lo = *(const uint2*)vr, hi = *(const uint2*)(vr + 16);
                        s16x8 a = as_frag(make_uint4(lo.x, lo.y, hi.x, hi.y));
                        o[dt] = mfma16(a, bfrag, o[dt]);
                    }
                }
            }
        }
        if (blk + 1 < nblk) {
            u16* nK = sK + ((blk + 1) & 1) * 2 * 64 * 72;
            *(uint4*)(nK + lrow * 72 + lch) = pk_; *(uint4*)(nK + 64 * 72 + lrow * 72 + lch) = pv_;
        }
        __syncthreads();
    }
    l_run += __shfl_xor(l_run, 16); l_run += __shfl_xor(l_run, 32);
    const float inv = 1.f / l_run;
#pragma unroll
    for (int dt = 0; dt < 4; ++dt) {
        uint2 q; q.x = pack2(o[dt][0] * inv, o[dt][1] * inv); q.y = pack2(o[dt][2] * inv, o[dt][3] * inv);
        *(uint2*)(CAT + (size_t)m * 1024 + h * 64 + dt * 16 + quad * 4) = q;
    }
}

struct ChunkGeo { int m0; size_t tb; int len; };
__device__ __forceinline__ ChunkGeo chunk_geo(int b, int dir, int pc) {
    ChunkGeo g;
    if (pc < 2) { int oc = dir ? 1 - pc : pc; g.m0 = ML + b * 256 + oc * 128; g.tb = oc * 128; g.len = 256; }
    else { int pp = pc - 2; int oc = dir ? 31 - pp : pp; g.m0 = b * 4096 + oc * 128; g.tb = oc * 128; g.len = 4096; }
    return g;
}
__device__ __forceinline__ size_t tbase(int b, int h, int len) {
    return len == 4096 ? (size_t)(b * 4 + h) * 128 * 4096 : (size_t)ML * 512 + (size_t)(b * 4 + h) * 128 * 256;
}

__device__ __forceinline__ void ml_c1_unit(const Params& P, int chain, int pc, char* smem) {
    const int tid = get_tid(), lane = tid & 63, wave = tid >> 6, quad = lane >> 4, l15 = lane & 15;
    const int dir = chain & 1, h = (chain >> 1) & 3, b = chain >> 3;
    float* sS = (float*)smem;
    float* sW = sS + 128;
    float* sRed = sW + 128;
    const ChunkGeo g = chunk_geo(b, dir, pc);
    const u16* KBT = P.slot[3] + HALF + tbase(b, h, g.len) + g.tb;
    const u16* VBT = P.slot[4] + tbase(b, h, g.len) + g.tb;
    const int e0 = (wave >> 1) * 32, d0 = (wave & 1) * 64;
    uint4 araw[4][2], braw[4][4];
    if (pc < 33) {
#pragma unroll
        for (int ks = 0; ks < 4; ++ks) {
            const int s0 = ks * 32 + quad * 8;
#pragma unroll
            for (int i = 0; i < 2; ++i) araw[ks][i] = *(const uint4*)(VBT + (size_t)(e0 + i * 16 + l15) * g.len + s0);
#pragma unroll
            for (int j = 0; j < 4; ++j) braw[ks][j] = *(const uint4*)(KBT + (size_t)(d0 + j * 16 + l15) * g.len + s0);
        }
    }
    __syncthreads();
    float gi = 0.f, x = 0.f;
    const int s = dir ? 127 - (tid & 127) : (tid & 127);
    if (tid < 128) {
        gi = P.gates[(size_t)(g.m0 + s) * 16 + dir * 8 + h];
        x = P.gates[(size_t)(g.m0 + s) * 16 + dir * 8 + 4 + h];
    }
#pragma unroll
    for (int o = 1; o < 64; o <<= 1) { const float y = __shfl_up(x, o); if (lane >= o) x += y; }
    if (tid == 63) sRed[0] = x;
    __syncthreads();
    if (tid >= 64 && tid < 128) x += sRed[0];
    if (tid == 127) sRed[1] = x;
    __syncthreads();
    const float Bc = sRed[1];
    float wl = -INFINITY, xm = -INFINITY;
    if (tid < 128) { wl = Bc - x + gi; xm = gi - x; }
#pragma unroll
    for (int o = 1; o < 64; o <<= 1) { const float y = __shfl_up(xm, o); if (lane >= o) xm = fmaxf(xm, y); }
    if (tid == 63) sRed[2] = xm;
    float mx = wl;
#pragma unroll
    for (int o = 1; o < 64; o <<= 1) mx = fmaxf(mx, __shfl_xor(mx, o));
    if (lane == 0 && wave < 2) sRed[4 + wave] = mx;
    __syncthreads();
    if (tid >= 64 && tid < 128) xm = fmaxf(xm, sRed[2]);
    const float Mc = fmaxf(sRed[4], sRed[5]);
    if (tid < 128) {
        sW[s] = __expf(wl - Mc);
        P.gb[(size_t)(chain * 34 + pc) * 128 + s] = x;
        P.gx[(size_t)(chain * 34 + pc) * 128 + s] = xm;
    }
    if (pc == 33) return;
    __syncthreads();
    f32x4 acc[2][4];
#pragma unroll
    for (int i = 0; i < 2; ++i)
#pragma unroll
        for (int j = 0; j < 4; ++j) acc[i][j] = (f32x4){0.f, 0.f, 0.f, 0.f};
#pragma unroll
    for (int ks = 0; ks < 4; ++ks) {
        const int s0 = ks * 32 + quad * 8;
        float wv[8];
#pragma unroll
        for (int q = 0; q < 8; ++q) wv[q] = sW[s0 + q];
        s16x8 af[2], bfr[4];
#pragma unroll
        for (int i = 0; i < 2; ++i) {
            const uint4 raw = araw[ks][i];
            uint4 sc;
            sc.x = pack2(lo2f(raw.x) * wv[0], hi2f(raw.x) * wv[1]); sc.y = pack2(lo2f(raw.y) * wv[2], hi2f(raw.y) * wv[3]);
            sc.z = pack2(lo2f(raw.z) * wv[4], hi2f(raw.z) * wv[5]); sc.w = pack2(lo2f(raw.w) * wv[6], hi2f(raw.w) * wv[7]);
            af[i] = as_frag(sc);
        }
#pragma unroll
        for (int j = 0; j < 4; ++j) bfr[j] = as_frag(braw[ks][j]);
#pragma unroll
        for (int i = 0; i < 2; ++i)
#pragma unroll
            for (int j = 0; j < 4; ++j) acc[i][j] = mfma16(af[i], bfr[j], acc[i][j]);
    }
    u16* ST = P.slot[5] + (size_t)(chain * 34 + pc) * 16384;
#pragma unroll
    for (int i = 0; i < 2; ++i)
#pragma unroll
        for (int j = 0; j < 4; ++j)
#pragma unroll
            for (int r = 0; r < 4; ++r)
                ST[(e0 + i * 16 + quad * 4 + r) * 128 + d0 + j * 16 + l15] = f2bf(acc[i][j][r]);
    if (tid < 128) {
        float nu = 0.f;
        const u16* kr = KBT + (size_t)tid * g.len;
        for (int s = 0; s < 128; s += 8) {
            uint4 raw = *(const uint4*)(kr + s);
            nu += lo2f(raw.x) * sW[s] + hi2f(raw.x) * sW[s + 1] + lo2f(raw.y) * sW[s + 2] + hi2f(raw.y) * sW[s + 3]
                + lo2f(raw.z) * sW[s + 4] + hi2f(raw.z) * sW[s + 5] + lo2f(raw.w) * sW[s + 6] + hi2f(raw.w) * sW[s + 7];
        }
        P.mnu[(size_t)(chain * 34 + pc) * 128 + tid] = nu;
    }
    if (tid == 0) { P.mbc[chain * 34 + pc] = Bc; P.mmc[chain * 34 + pc] = Mc; }
}

__device__ __forceinline__ void phase_mix0(const Params& P, char* smem) {
    const int n_c1 = 64 * 34, n_na = 8 * 8 * 32, n_cx = 8 * 8 * 2;
    for (int u = blockIdx.x; u < n_c1 + n_na + n_cx; u += gridDim.x) {
        if (u < n_c1) ml_c1_unit(P, u / 34, u % 34, smem);
        else if (u < n_c1 + n_na) { int v = u - n_c1; na_unit(P, v >> 8, (v >> 5) & 7, v & 31, false, 0, smem); }
        else { int v = u - n_c1 - n_na; na_unit(P, v >> 4, (v >> 1) & 7, 0, true, v & 1, smem); }
    }
}

__device__ __forceinline__ void phase_mlscan(const Params& P) {
    const int tid = get_tid();
    for (int u = blockIdx.x; u < 64 * 33; u += gridDim.x) {
        const int chain = u / 33, grp = u % 33;
        if (grp == 32 && tid >= 128) continue;
        const float* bc = P.mbc + chain * 34; const float* mc = P.mmc + chain * 34;
        float U[33];
        if (grp < 32) {
            u16* st = P.slot[5] + (size_t)chain * 34 * 16384 + grp * 512 + tid;
#pragma unroll
            for (int pc = 0; pc < 33; ++pc) U[pc] = bf2f(st[(size_t)pc * 16384]);
            float C = 0.f, mm = 0.f;
#pragma unroll
            for (int pc = 0; pc < 34; ++pc) {
                st[(size_t)pc * 16384] = f2bf(C);
                if (pc < 33) {
                    const float Bc = bc[pc], Mc = mc[pc];
                    const float mn = fmaxf(Bc + mm, Mc);
                    C = __expf(Bc + mm - mn) * C + __expf(Mc - mn) * U[pc];
                    mm = mn;
                }
            }
        } else {
            float* nu = P.mnu + (size_t)chain * 34 * 128 + tid;
#pragma unroll
            for (int pc = 0; pc < 33; ++pc) U[pc] = nu[pc * 128];
            float C = 0.f, mm = 0.f;
#pragma unroll
            for (int pc = 0; pc < 34; ++pc) {
                nu[pc * 128] = C;
                if (tid == 0) P.mst[chain * 34 + pc] = mm;
                if (pc < 33) {
                    const float Bc = bc[pc], Mc = mc[pc];
                    const float mn = fmaxf(Bc + mm, Mc);
                    C = __expf(Bc + mm - mn) * C + __expf(Mc - mn) * U[pc];
                    mm = mn;
                }
            }
        }
    }
}

__device__ __forceinline__ void ml_c3_unit(const Params& P, int b, int h, int cid, char* smem) {
    const int tid = get_tid(), lane = tid & 63, wave = tid >> 6, quad = lane >> 4, l15 = lane & 15;
    float* sB = (float*)smem;
    float* sI = sB + 256;
    float* sX = sI + 256;
    const bool isctx = cid < 2;
    const int oc = isctx ? cid : cid - 2;
    const int nseg = isctx ? 2 : 32, len = isctx ? 256 : 4096;
    const int m0 = isctx ? ML + b * 256 + oc * 128 : b * 4096 + oc * 128;
    const u16* QB = P.slot[2] + HALF; const u16* KB = P.slot[3];
    const u16* VBT = P.slot[4] + tbase(b, h, len) + oc * 128;
    const u16* OB = P.slot[4] + HALF;
    u16* CAT = P.slot[0];
    __syncthreads();
    u16* sKt = (u16*)(smem + 3072 + 65536);
    u16* sVt = sKt + 128 * 136;
    {
        uint4 kq[4], vq[4];
#pragma unroll
        for (int i = 0; i < 4; ++i) {
            const int cidx = tid + NTHREADS * i, row = cidx >> 4, ch = cidx & 15;
            kq[i] = *(const uint4*)(KB + (size_t)(m0 + row) * 512 + h * 128 + ch * 8);
            vq[i] = *(const uint4*)(VBT + (size_t)row * len + ch * 8);
        }
#pragma unroll
        for (int i = 0; i < 4; ++i) {
            const int cidx = tid + NTHREADS * i, row = cidx >> 4, ch = cidx & 15;
            *(uint4*)(sKt + row * 136 + ch * 8) = kq[i];
            *(uint4*)(sVt + row * 136 + ch * 8) = vq[i];
        }
    }
    const int sd = (tid >> 7) & 1, ss = tid & 127;
    if (tid < 256) {
        const int chain_d = (b * 4 + h) * 2 + sd;
        const int pc_d = (sd ? nseg - 1 - oc : oc) + (isctx ? 0 : 2);
        sI[tid] = P.gates[(size_t)(m0 + ss) * 16 + sd * 8 + h];
        sB[tid] = P.gb[(size_t)(chain_d * 34 + pc_d) * 128 + ss];
        sX[tid] = P.gx[(size_t)(chain_d * 34 + pc_d) * 128 + ss];
    }
    __syncthreads();
    const int t = wave * 16 + l15;
    s16x8 qf[4];
#pragma unroll
    for (int ks = 0; ks < 4; ++ks) qf[ks] = as_frag(*(const uint4*)(QB + (size_t)(m0 + t) * 512 + h * 128 + ks * 32 + quad * 8));
    float* sH = sX + 256;
    f32x4 hsum[8];
#pragma unroll 1
    for (int dir = 0; dir < 2; ++dir) {
        const int chain = (b * 4 + h) * 2 + dir;
        const int pc = (dir ? nseg - 1 - oc : oc) + (isctx ? 0 : 2);
        const float mst = P.mst[chain * 34 + pc];
        const float bt = sB[dir * 128 + t];
        const float mt = fmaxf(bt + mst, bt + sX[dir * 128 + t]);
        const float winter = __expf(bt + mst - mt);
        const u16* ST = P.slot[5] + (size_t)(chain * 34 + pc) * 16384;
        const float* NS = P.mnu + (size_t)(chain * 34 + pc) * 128;
        f32x4 acc[8];
#pragma unroll
        for (int et = 0; et < 8; ++et) {
            acc[et] = (f32x4){0.f, 0.f, 0.f, 0.f};
#pragma unroll
            for (int ks = 0; ks < 4; ++ks) {
                s16x8 a = as_frag(*(const uint4*)(ST + (et * 16 + l15) * 128 + ks * 32 + quad * 8));
                acc[et] = mfma16(a, qf[ks], acc[et]);
            }
            acc[et][0] *= winter; acc[et][1] *= winter; acc[et][2] *= winter; acc[et][3] *= winter;
        }
        float qn = 0.f;
#pragma unroll
        for (int ks = 0; ks < 4; ++ks) {
            const float* np = NS + ks * 32 + quad * 8;
#pragma unroll
            for (int q = 0; q < 8; ++q) qn += bf2f((u16)qf[ks][q]) * np[q];
        }
        qn += __shfl_xor(qn, 16); qn += __shfl_xor(qn, 32);
        float den = 0.f;
        for (int sb = 0; sb < 4; ++sb) {
            if (dir == 0 ? (2 * sb > wave) : (2 * sb + 1 < wave)) continue;
            float sv[2][4];
#pragma unroll
            for (int hh = 0; hh < 2; ++hh) {
                const int st = 2 * sb + hh;
                f32x4 a4 = (f32x4){0.f, 0.f, 0.f, 0.f};
#pragma unroll
                for (int ks = 0; ks < 4; ++ks) {
                    s16x8 a = as_frag(*(const uint4*)(sKt + (st * 16 + l15) * 136 + ks * 32 + quad * 8));
                    a4 = mfma16(a, qf[ks], a4);
                }
#pragma unroll
                for (int r = 0; r < 4; ++r) {
                    const int s = st * 16 + quad * 4 + r;
                    const bool valid = dir ? (s >= t) : (s <= t);
                    const float dv = valid ? __expf(bt - sB[dir * 128 + s] + sI[dir * 128 + s] - mt) : 0.f;
                    sv[hh][r] = a4[r] * dv; den += sv[hh][r];
                }
            }
            uint4 pb;
            pb.x = pack2(sv[0][0], sv[0][1]); pb.y = pack2(sv[0][2], sv[0][3]);
            pb.z = pack2(sv[1][0], sv[1][1]); pb.w = pack2(sv[1][2], sv[1][3]);
            const s16x8 bfrag = as_frag(pb);
#pragma unroll
            for (int et = 0; et < 8; ++et) {
                const u16* vr = sVt + (et * 16 + l15) * 136 + sb * 32 + quad * 4;
                uint2 lo = *(const uint2*)vr, hi = *(const uint2*)(vr + 16);
                acc[et] = mfma16(as_frag(make_uint4(lo.x, lo.y, hi.x, hi.y)), bfrag, acc[et]);
            }
        }
        den += __shfl_xor(den, 16); den += __shfl_xor(den, 32);
        den += winter * qn;
        const float hs = 1.f / fmaxf(fabsf(den), __expf(-mt));
#pragma unroll
        for (int et = 0; et < 8; ++et) {
#pragma unroll
            for (int r = 0; r < 4; ++r) {
                if (dir == 0) sH[(et * 4 + r) * NTHREADS + tid] = acc[et][r] * hs;
                else hsum[et][r] = sH[(et * 4 + r) * NTHREADS + tid] + acc[et][r] * hs;
            }
        }
    }
    float sq = 0.f;
#pragma unroll
    for (int et = 0; et < 8; ++et) sq += hsum[et][0] * hsum[et][0] + hsum[et][1] * hsum[et][1] + hsum[et][2] * hsum[et][2] + hsum[et][3] * hsum[et][3];
    sq += __shfl_xor(sq, 16); sq += __shfl_xor(sq, 32);
    const float rinv = rsqrtf(sq * (1.f / 128.f) + 1e-6f);
    const float* hn = P.in[11] + h * 128;
#pragma unroll
    for (int et = 0; et < 8; ++et) {
        const int e = et * 16 + quad * 4;
        uint2 ob = *(const uint2*)(OB + (size_t)(m0 + t) * 512 + h * 128 + e);
        float o0 = hsum[et][0] * rinv * hn[e + 0] * sigmoidf_(lo2f(ob.x));
        float o1 = hsum[et][1] * rinv * hn[e + 1] * sigmoidf_(hi2f(ob.x));
        float o2 = hsum[et][2] * rinv * hn[e + 2] * sigmoidf_(lo2f(ob.y));
        float o3 = hsum[et][3] * rinv * hn[e + 3] * sigmoidf_(hi2f(ob.y));
        uint2 q; q.x = pack2(o0, o1); q.y = pack2(o2, o3);
        *(uint2*)(CAT + (size_t)(m0 + t) * 1024 + 512 + h * 128 + e) = q;
    }
}

constexpr int TB = 32;
constexpr int SBUF = 6 * TB * 64 + 2 * TB;
#define DPP4(ctrl) asm volatile( \
    "v_add_f32_dpp %0, %0, %0 " ctrl " row_mask:0xf bank_mask:0xf bound_ctrl:1\n" \
    "v_add_f32_dpp %1, %1, %1 " ctrl " row_mask:0xf bank_mask:0xf bound_ctrl:1\n" \
    "v_add_f32_dpp %2, %2, %2 " ctrl " row_mask:0xf bank_mask:0xf bound_ctrl:1\n" \
    "v_add_f32_dpp %3, %3, %3 " ctrl " row_mask:0xf bank_mask:0xf bound_ctrl:1\n" \
    : "+v"(sa0), "+v"(sa1), "+v"(sw0), "+v"(sw1))
typedef float v2f __attribute__((ext_vector_type(2)));
__device__ __forceinline__ v2f pkfma(v2f a, v2f b, v2f c) { return __builtin_elementwise_fma(a, b, c); }

__device__ __forceinline__ void phase_scan(const Params& P, char* smem) {
    const int tid = get_tid(), lane = tid & 63, wave = tid >> 6;
    float* sBuf = (float*)smem;
    float* sYb = sBuf + 2 * SBUF;
    const u16* R = P.slot[1]; const u16* K = P.slot[2]; const u16* V = P.slot[3];
    constexpr int NBLK = 8 + 128;
    for (int chain = blockIdx.x; chain < 256; chain += gridDim.x) {
        const int z = chain & 1, hd = (chain >> 1) & 15, b = chain >> 5;
        u16* EY = z ? P.slot[5] : P.slot[4];
        const u8* AZ = (const u8*)P.slot[0] + (size_t)z * MA * 1024;
        const int ptid = tid & 255;
        const int scg = ptid & 15, sn = hd * 64 + scg * 4;
        const float4 kk4 = *(const float4*)(P.in[23] + sn), ka4 = *(const float4*)(P.in[24] + sn), rk4 = *(const float4*)(P.in[25] + sn);
        const float kkv[4] = {kk4.x, kk4.y, kk4.z, kk4.w}, kav[4] = {ka4.x, ka4.y, ka4.z, ka4.w}, rkv[4] = {rk4.x, rk4.y, rk4.z, rk4.w};
        const int rg = lane >> 3, cgq = lane & 7, row0 = (wave & 3) * 16 + rg * 2;
        v2f S[2][4];
#pragma unroll
        for (int i = 0; i < 2; ++i)
#pragma unroll
            for (int j = 0; j < 4; ++j) S[i][j] = (v2f){0.f, 0.f};
        __syncthreads();
        for (int it = 0; it < NBLK + 2; ++it) {
            if (wave >= 4) {
                if (it < NBLK) {
                    const bool lat = it >= 8;
                    const int len = lat ? 4096 : 256;
                    float* sb = sBuf + (it & 1) * SBUF;
#pragma unroll
                    for (int half = 0; half < 2; ++half) {
                        const int sp = (ptid >> 4) + 16 * half;
                        const int pos = (lat ? it - 8 : it) * TB + sp;
                        const int tok = z ? len - 1 - pos : pos;
                        const int m = lat ? b * 4096 + tok : ML + b * 256 + tok;
                        const size_t o = (size_t)m * 1024 + sn;
                        const uint2 r2 = *(const uint2*)(R + o), k2 = *(const uint2*)(K + o), v2 = *(const uint2*)(V + o), e2 = *(const uint2*)(EY + o);
                        const unsigned a4 = *(const unsigned*)(AZ + o);
                        const float kn = P.knorm[(size_t)m * 16 + hd];
                        const float rv[4] = {lo2f(r2.x), hi2f(r2.x), lo2f(r2.y), hi2f(r2.y)};
                        const float kv[4] = {lo2f(k2.x), hi2f(k2.x), lo2f(k2.y), hi2f(k2.y)};
                        const float vv[4] = {lo2f(v2.x), hi2f(v2.x), lo2f(v2.y), hi2f(v2.y)};
                        const float ev[4] = {lo2f(e2.x), hi2f(e2.x), lo2f(e2.y), hi2f(e2.y)};
                        float dec[4], an[4], bb[4], kd[4], wr[4];
                        float br = 0.f, kr = 0.f, cf = 0.f;
#pragma unroll
                        for (int q = 0; q < 4; ++q) {
                            const float a = (float)((a4 >> (8 * q)) & 255u) * (1.f / 255.f);
                            const float kkn = kv[q] * kkv[q] * kn;
                            an[q] = -kkn; bb[q] = kkn * a;
                            kd[q] = kv[q] * (1.f + (a - 1.f) * kav[q]);
                            dec[q] = __expf(-ev[q]);
                            wr[q] = dec[q] * rv[q];
                            br += bb[q] * rv[q]; kr += kd[q] * rv[q]; cf += rv[q] * kd[q] * rkv[q];
                        }
                        br = sum16(br); kr = sum16(kr); cf = sum16(cf);
                        const int lo = sp * 64 + scg * 4;
                        *(float4*)(sb + 0 * TB * 64 + lo) = make_float4(dec[0], dec[1], dec[2], dec[3]);
                        *(float4*)(sb + 1 * TB * 64 + lo) = make_float4(an[0], an[1], an[2], an[3]);
                        *(float4*)(sb + 2 * TB * 64 + lo) = make_float4(bb[0], bb[1], bb[2], bb[3]);
                        *(float4*)(sb + 3 * TB * 64 + lo) = make_float4(kd[0], kd[1], kd[2], kd[3]);
                        *(float4*)(sb + 4 * TB * 64 + lo) = make_float4(wr[0], wr[1], wr[2], wr[3]);
                        *(float4*)(sb + 5 * TB * 64 + lo) = make_float4(vv[0], vv[1], vv[2], vv[3]);
                        if (scg == 0) {
                            sb[6 * TB * 64 + sp] = br; sb[6 * TB * 64 + TB + sp] = kr;
                            if (lat) P.coef[(size_t)z * ML * 16 + (size_t)m * 16 + hd] = cf;
                        }
                    }
                }
                if (it >= 10) {
                    const int jb = it - 2;
                    const int sp = ptid >> 3, c8 = (ptid & 7) * 8;
                    const int pos = (jb - 8) * TB + sp;
                    const int tok = z ? 4095 - pos : pos;
                    const float* yb = sYb + (jb & 1) * TB * 64 + sp * 64 + c8;
                    const float4 y0 = *(const float4*)yb, y1 = *(const float4*)(yb + 4);
                    uint4 q; q.x = pack2(y0.x, y0.y); q.y = pack2(y0.z, y0.w); q.z = pack2(y1.x, y1.y); q.w = pack2(y1.z, y1.w);
                    *(uint4*)(EY + (size_t)(b * 4096 + tok) * 1024 + hd * 64 + c8) = q;
                }
            } else if (it >= 1 && it <= NBLK) {
                const int jb = it - 1;
                const bool lat = jb >= 8;
                const float* sb = sBuf + (jb & 1) * SBUF;
                float* sy = sYb + (jb & 1) * TB * 64;
                struct StepP { float4 dA, dB, aA, aB, bA, bB, kA, kB, wA, wB; float2 v2; float br, kr; };
#define LOADP(X, p_) do { const float* pp = sb + (p_) * 64 + cgq * 8; \
                    X.dA = *(const float4*)(pp + 0 * TB * 64); X.dB = *(const float4*)(pp + 0 * TB * 64 + 4); \
                    X.aA = *(const float4*)(pp + 1 * TB * 64); X.aB = *(const float4*)(pp + 1 * TB * 64 + 4); \
                    X.bA = *(const float4*)(pp + 2 * TB * 64); X.bB = *(const float4*)(pp + 2 * TB * 64 + 4); \
                    X.kA = *(const float4*)(pp + 3 * TB * 64); X.kB = *(const float4*)(pp + 3 * TB * 64 + 4); \
                    X.wA = *(const float4*)(pp + 4 * TB * 64); X.wB = *(const float4*)(pp + 4 * TB * 64 + 4); \
                    X.v2 = *(const float2*)(sb + 5 * TB * 64 + (p_) * 64 + row0); \
                    X.br = sb[6 * TB * 64 + (p_)]; X.kr = sb[6 * TB * 64 + TB + (p_)]; } while (0)
                __builtin_amdgcn_s_setprio(3);
                StepP cur, nxt;
                LOADP(cur, 0);
                nxt = cur;
#pragma unroll 8
                for (int p = 0; p < TB; ++p) {
                    LOADP(nxt, p + 1);
                    const float4 dA = cur.dA, dB = cur.dB, aA = cur.aA, aB = cur.aB, bA = cur.bA, bB = cur.bB, kA = cur.kA, kB = cur.kB, wA = cur.wA, wB = cur.wB;
                    const float2 v2 = cur.v2; const float br = cur.br, kr = cur.kr;
                    const v2f d2[4] = {{dA.x, dA.y}, {dA.z, dA.w}, {dB.x, dB.y}, {dB.z, dB.w}};
                    const v2f a2[4] = {{aA.x, aA.y}, {aA.z, aA.w}, {aB.x, aB.y}, {aB.z, aB.w}};
                    const v2f b2[4] = {{bA.x, bA.y}, {bA.z, bA.w}, {bB.x, bB.y}, {bB.z, bB.w}};
                    const v2f k2[4] = {{kA.x, kA.y}, {kA.z, kA.w}, {kB.x, kB.y}, {kB.z, kB.w}};
                    const v2f w2[4] = {{wA.x, wA.y}, {wA.z, wA.w}, {wB.x, wB.y}, {wB.z, wB.w}};
                    v2f t0 = S[0][0] * a2[0], t1 = S[1][0] * a2[0], u0 = S[0][0] * w2[0], u1 = S[1][0] * w2[0];
#pragma unroll
                    for (int q = 1; q < 4; ++q) {
                        t0 = pkfma(S[0][q], a2[q], t0); t1 = pkfma(S[1][q], a2[q], t1);
                        u0 = pkfma(S[0][q], w2[q], u0); u1 = pkfma(S[1][q], w2[q], u1);
                    }
                    float sa0 = t0.x + t0.y, sa1 = t1.x + t1.y, sw0 = u0.x + u0.y, sw1 = u1.x + u1.y;
                    asm volatile("s_nop 1" ::: );
                    DPP4("quad_perm:[1,0,3,2]");
                    DPP4("quad_perm:[2,3,0,1]");
                    DPP4("row_half_mirror");
                    const v2f va = {v2.x, v2.x}, vb = {v2.y, v2.y}, s0 = {sa0, sa0}, s1 = {sa1, sa1};
#pragma unroll
                    for (int q = 0; q < 4; ++q) {
                        S[0][q] = pkfma(S[0][q], d2[q], pkfma(s0, b2[q], va * k2[q]));
                        S[1][q] = pkfma(S[1][q], d2[q], pkfma(s1, b2[q], vb * k2[q]));
                    }
                    *(float2*)(sy + p * 64 + row0) = make_float2(sw0 + sa0 * br + v2.x * kr, sw1 + sa1 * br + v2.y * kr);
                    cur = nxt;
                }
#undef LOADP
                __builtin_amdgcn_s_setprio(0);
            }
            __syncthreads();
        }
    }
}

__device__ __forceinline__ void phase_z(const Params& P) {
    const int lane = get_tid() & 63, wave = get_tid() >> 6;
    const int n0 = lane * 16, hd = lane >> 2;
    float lw[16], lb[16];
#pragma unroll
    for (int q = 0; q < 16; ++q) { lw[q] = P.in[26][n0 + q]; lb[q] = P.in[27][n0 + q]; }
    const u16* __restrict__ YF = P.slot[4]; const u16* __restrict__ YB = P.slot[5]; const u16* __restrict__ V = P.slot[3]; const u16* __restrict__ G = P.slot[2];
    u16* __restrict__ Z = P.slot[1];
    const float* __restrict__ coefp = P.coef;
#pragma unroll 4
    for (int m = blockIdx.x * 8 + wave; m < ML; m += gridDim.x * 8) {
        const size_t o = (size_t)m * 1024 + n0;
        const uint4 f0 = *(const uint4*)(YF + o), f1 = *(const uint4*)(YF + o + 8);
        const uint4 b0 = *(const uint4*)(YB + o), b1 = *(const uint4*)(YB + o + 8);
        const uint4 v0 = *(const uint4*)(V + o), v1 = *(const uint4*)(V + o + 8);
        const uint4 g0 = *(const uint4*)(G + o), g1 = *(const uint4*)(G + o + 8);
        const float cf = coefp[(size_t)m * 16 + hd] + coefp[(size_t)ML * 16 + (size_t)m * 16 + hd];
        const unsigned fw[8] = {f0.x, f0.y, f0.z, f0.w, f1.x, f1.y, f1.z, f1.w};
        const unsigned bw[8] = {b0.x, b0.y, b0.z, b0.w, b1.x, b1.y, b1.z, b1.w};
        const unsigned vw[8] = {v0.x, v0.y, v0.z, v0.w, v1.x, v1.y, v1.z, v1.w};
        const unsigned gw[8] = {g0.x, g0.y, g0.z, g0.w, g1.x, g1.y, g1.z, g1.w};
        float y[16], s = 0.f;
#pragma unroll
        for (int q = 0; q < 8; ++q) {
            y[2 * q] = lo2f(fw[q]) + lo2f(bw[q]); y[2 * q + 1] = hi2f(fw[q]) + hi2f(bw[q]);
            s += y[2 * q] + y[2 * q + 1];
        }
        s += dppf<0xB1>(s); s += dppf<0x4E>(s);
        const float mean = s * (1.f / 64.f);
        float vs = 0.f;
#pragma unroll
        for (int q = 0; q < 16; ++q) { const float d = y[q] - mean; vs += d * d; }
        vs += dppf<0xB1>(vs); vs += dppf<0x4E>(vs);
        const float rinv = rsqrtf(vs * (1.f / 64.f) + 64e-5f);
        unsigned ow[8];
#pragma unroll
        for (int q = 0; q < 8; ++q) {
            const float z0 = ((y[2 * q] - mean) * rinv * lw[2 * q] + lb[2 * q] + cf * lo2f(vw[q])) * lo2f(gw[q]);
            const float z1 = ((y[2 * q + 1] - mean) * rinv * lw[2 * q + 1] + lb[2 * q + 1] + cf * hi2f(vw[q])) * hi2f(gw[q]);
            ow[q] = pack2(z0, z1);
        }
        *(uint4*)(Z + o) = make_uint4(ow[0], ow[1], ow[2], ow[3]);
        *(uint4*)(Z + o + 8) = make_uint4(ow[4], ow[5], ow[6], ow[7]);
    }
}

__device__ __forceinline__ void do_phase(const Params& P, const int ph, char* smem) {
        switch (ph) {
        case 0: phase_prep(P, smem); break;
        case 1: phase_norm(P, 0, P.slot[0], MA); break;
        case 2: { Epi E{E_INPROJ, 0, 0, nullptr, 0}; gemm_single(P, P.slot[0], 1024, P.wint, 1024, 15, MA / BM, E, smem); } break;
        case 3: phase_mix0(P, smem); break;
        case 4: phase_mlscan(P); break;
        case 5: for (int u = blockIdx.x; u < 8 * 4 * 34; u += gridDim.x) ml_c3_unit(P, u / 136, (u / 34) & 3, u % 34, smem); break;
        case 6: { Epi E{E_OUT0, 0, 0, nullptr, 0}; gemm_single(P, P.slot[0], 1024, P.woutt, 1024, 4, MA / BM, E, smem); } break;
        case 7: phase_norm(P, 1, P.slot[0], MA); break;
        case 8: { Epi E{E_MLPUP, 0, 0, P.slot[1], 4096}; gemm_single(P, P.slot[0], 1024, P.w1t[0], 1024, 16, MA / BM, E, smem); } break;
        case 9: phase_mlpdn0(P, smem); break;
        case 10: phase_norm(P, 2, P.slot[0], MA); break;
        case 11: phase_rw1(P, smem); break;
        case 12: phase_rw2(P, smem); break;
        case 13: phase_scan(P, smem); break;
        case 14: { Epi E{E_HA, 1, 0, P.slot[2], 1024}; gemm_single(P, P.hg, 192, P.lg2t, 192, 4, ML / BM, E, smem); } break;
        case 19: phase_z(P); break;
        case 15: { Epi E{E_RWOUT, 1, 0, nullptr, 0}; gemm_single(P, P.slot[1], 1024, P.wot, 1024, 4, ML / BM, E, smem); } break;
        case 16: phase_norm(P, 3, P.slot[0], ML); break;
        case 17: { Epi E{E_MLPUP, 1, 0, P.slot[1], 4096}; gemm_single(P, P.slot[0], 1024, P.w1t[1], 1024, 16, ML / BM, E, smem); } break;
        case 18: { Epi E{E_MLPDN, 1, 0, nullptr, 0}; gemm_single(P, P.slot[1], 4096, P.w2t[1], 4096, 4, ML / BM, E, smem); } break;
        default: break;
        }
}

__global__ void __launch_bounds__(NTHREADS) mega(Params P) {
    extern __shared__ __align__(16) char smem[];
#if ONE_LAUNCH
    cg::grid_group grid = cg::this_grid();
    __shared__ unsigned xb_words[4];
    if (threadIdx.x == 0) { xb_words[0] = 0u; xb_words[1] = 0u; }
    if (blockIdx.x == 0) {
        for (int i = threadIdx.x; i < XCD_BAR_WORDS; i += NTHREADS) P.bar[i] = 0u;
        __threadfence();
    }
    __syncthreads();
#define PH(n) do_phase(P, n, smem); xcd_barrier(xb);
    do_phase(P, 0, smem); grid.sync();
    const XcdBarrier xb = xcd_barrier_post(P.bar, (volatile LAS unsigned*)&xb_words);
    PH(1) PH(2) PH(3) PH(4) PH(5) PH(6) PH(7) PH(8) PH(9) PH(10) PH(11) PH(12) PH(13) PH(14) PH(19) PH(15) PH(16) PH(17)
    do_phase(P, 18, smem);
#undef PH
#else
    do_phase(P, P.ph_lo, smem);
#endif
}

extern "C" void kernel_launch(void* const* d_in, const int* in_sizes, int n_in, void* d_out, int out_size, void* d_ws, size_t ws_size,
                              hipStream_t stream) {
    static int grid = 0;
    if (grid == 0) {
        int dev = 0, cus = 0, per_cu = 0;
        hipGetDevice(&dev);
        hipDeviceGetAttribute(&cus, hipDeviceAttributeMultiprocessorCount, dev);
        hipFuncSetAttribute((const void*)mega, hipFuncAttributeMaxDynamicSharedMemorySize, LDS_BYTES);
        hipOccupancyMaxActiveBlocksPerMultiprocessor(&per_cu, (const void*)mega, NTHREADS, LDS_BYTES);
        if (per_cu < 1) { fprintf(stderr, "occupancy query says %d blocks/CU\n", per_cu); per_cu = 1; }
        grid = cus;
        if (grid <= 0) grid = 256;
    }
    Params P{};
    for (int i = 0; i < 31; ++i) P.in[i] = (const float*)d_in[i];
    P.out = (float*)d_out;
    char* w = (char*)d_ws;
    size_t off = 0;
    auto take = [&](size_t bytes) { char* p = w + off; off += (bytes + 255) & ~(size_t)255; return p; };
    for (int i = 0; i < 6; ++i) P.slot[i] = (u16*)take(SLOT);
    P.w1t[1] = (u16*)take((size_t)4096 * 1024 * 2);
    P.w2t[1] = (u16*)take((size_t)4096 * 1024 * 2);
    P.rkvt = (u16*)take((size_t)3 * 1024 * 1024 * 2);
    P.wot = (u16*)take((size_t)1024 * 1024 * 2);
    P.lw1t = (u16*)take(256 * 1024 * 2);
    P.la1t = (u16*)take(256 * 1024 * 2);
    P.lg1t = (u16*)take(256 * 1024 * 2);
    P.lw2t = (u16*)take(2 * 1024 * 64 * 2);
    P.la2t = (u16*)take(2 * 1024 * 64 * 2);
    P.lg2t = (u16*)take(1024 * 192 * 2);
    P.bar = (unsigned*)take(XCD_BAR_WORDS * 4);
    P.mod = (float*)take(2 * 9 * 6144 * 4);
    P.ropec = (float*)take(64 * 32 * 4);
    P.ropes = (float*)take(64 * 32 * 4);
    const size_t ov = off;
    P.wint = (u16*)take((size_t)3840 * 1024 * 2);
    P.woutt = (u16*)take((size_t)1024 * 1024 * 2);
    P.w1t[0] = (u16*)take((size_t)4096 * 1024 * 2);
    P.w2t[0] = (u16*)take((size_t)4096 * 1024 * 2);
    P.gates = (float*)take((size_t)MA * 16 * 4);
    P.ctxres = (float*)take((size_t)MC * 1024 * 4);
    P.mbc = (float*)take(64 * 34 * 4);
    P.mmc = (float*)take(64 * 34 * 4);
    P.mst = (float*)take(64 * 34 * 4);
    P.mnu = (float*)take((size_t)64 * 34 * 128 * 4);
    P.gb = (float*)take((size_t)64 * 34 * 128 * 4);
    P.gx = (float*)take((size_t)64 * 34 * 128 * 4);
    const size_t end0 = off;
    off = ov;
    P.knorm = (float*)take((size_t)MA * 16 * 4);
    P.coef = (float*)take((size_t)2 * ML * 16 * 4);
    P.hw = (u16*)take((size_t)MA * 128 * 2);
    P.ha = (u16*)take((size_t)MA * 128 * 2);
    P.hg = (u16*)take((size_t)MA * 192 * 2);
    const size_t end1 = off;
    const size_t need = end0 > end1 ? end0 : end1;
    if (need > ws_size || n_in != 31) { fprintf(stderr, "kernel_launch: need %zu bytes of ws, have %zu (n_in %d)\n", need, ws_size, n_in); return; }
#if ONE_LAUNCH
    P.ph_lo = 0; P.ph_hi = NPHASES;
    void* args[] = {&P};
    hipError_t e = hipLaunchCooperativeKernel((const void*)mega, dim3(grid), dim3(NTHREADS), args, LDS_BYTES, stream);
    if (e != hipSuccess) fprintf(stderr, "cooperative launch failed: %s\n", hipGetErrorString(e));
#else
    for (int ph = 0; ph < NPHASES; ++ph) {
        P.ph_lo = ph; P.ph_hi = ph + 1;
        hipLaunchKernelGGL(mega, dim3(grid), dim3(NTHREADS), LDS_BYTES, stream, P);
    }
#endif
}
```

```cpp
#include <hip/hip_runtime.h>
#include <hip/hip_cooperative_groups.h>
#include <cstdio>
namespace cg = cooperative_groups;

#ifndef ONE_LAUNCH
#define ONE_LAUNCH 1
#endif

typedef unsigned short u16;
typedef unsigned char u8;
typedef __attribute__((ext_vector_type(8))) short s16x8;
typedef __attribute__((ext_vector_type(4))) float f32x4;

constexpr int D = 1024, NB = 8, T = 4096, CT = 256;
constexpr int ML = NB * T;
constexpr int MC = NB * CT;
constexpr int MA = ML + MC;
constexpr int NTHREADS = 512;
constexpr size_t SLOT = (size_t)MA * 1024 * 2;
constexpr size_t HALF = (size_t)MA * 512;
constexpr int LDS_BYTES = 147456;
constexpr int NPHASES = 19;

struct Params {
    const float* in[31];
    float* out;
    u16* slot[6];
    u16 *w1t[2], *w2t[2], *rkvt, *wot, *lw1t, *la1t, *lg1t, *lw2t, *la2t, *lg2t, *wint, *woutt;
    float *mod, *ropec, *ropes, *gates, *ctxres, *mbc, *mmc, *mst, *mnu, *knorm, *coef, *gb, *gx;
    u16 *hw, *ha, *hg;
    unsigned* bar;
    int ph_lo, ph_hi;
};

__device__ __forceinline__ int get_tid() { int t = (int)threadIdx.x; asm volatile("" : "+v"(t)); return t; }
__device__ __forceinline__ u16 f2bf(float f) { unsigned u = __float_as_uint(f); u += 0x7fffu + ((u >> 16) & 1u); return (u16)(u >> 16); }
__device__ __forceinline__ float bf2f(u16 h) { return __uint_as_float(((unsigned)h) << 16); }
typedef __bf16 hwbf16x2 __attribute__((ext_vector_type(2)));
typedef float hwf32x2 __attribute__((ext_vector_type(2)));
__device__ __forceinline__ unsigned pack2(float a, float b) {
    hwf32x2 v = {a, b};
    hwbf16x2 r = __builtin_convertvector(v, hwbf16x2);
    return __builtin_bit_cast(unsigned, r);
}
__device__ __forceinline__ float lo2f(unsigned u) { return __uint_as_float(u << 16); }
__device__ __forceinline__ float hi2f(unsigned u) { return __uint_as_float(u & 0xffff0000u); }
__device__ __forceinline__ s16x8 as_frag(uint4 v) { return __builtin_bit_cast(s16x8, v); }
__device__ __forceinline__ f32x4 mfma16(s16x8 a, s16x8 b, f32x4 c) { return __builtin_amdgcn_mfma_f32_16x16x32_bf16(a, b, c, 0, 0, 0); }
__device__ __forceinline__ float sigmoidf_(float x) { return 1.f / (1.f + __expf(-x)); }
__device__ __forceinline__ float wave_sum(float v) {
#pragma unroll
    for (int o = 1; o < 64; o <<= 1) v += __shfl_xor(v, o);
    return v;
}
template <int CTRL> __device__ __forceinline__ float dppf(float x) {
    return __int_as_float(__builtin_amdgcn_update_dpp(0, __float_as_int(x), CTRL, 0xf, 0xf, true));
}
__device__ __forceinline__ float sum16(float x) {
    x += dppf<0xB1>(x); x += dppf<0x4E>(x); x += dppf<0x141>(x); x += dppf<0x140>(x);
    return x;
}
__device__ __forceinline__ float* resptr(const Params& P, int m) {
    return m < ML ? P.out + (size_t)m * 1024 : P.ctxres + (size_t)(m - ML) * 1024;
}
__device__ __forceinline__ const float* modrow(const Params& P, int layer, int m) {
    return P.mod + (size_t)(layer * 9 + (m < ML ? (m >> 12) : 8)) * 6144;
}

#define XB_TMO      128
#define XB_XCNT(j)  (256  + 64 * (j))
#define XB_XSUB(j)  (1280 + 64 * (j))
#define XB_XGEN(j)  (2304 + 64 * (j))
#define XB_TOP      3328
#define XB_TOPGEN   3392
#define XCD_BAR_WORDS 3456
#define XB_SPIN_CAP (1u << 22)
#define LAS __attribute__((address_space(3)))

__device__ __forceinline__ unsigned xb_ld(unsigned* p)              { return __hip_atomic_load(p, __ATOMIC_RELAXED, __HIP_MEMORY_SCOPE_AGENT); }
__device__ __forceinline__ unsigned xb_add(unsigned* p, unsigned v) { return __hip_atomic_fetch_add(p, v, __ATOMIC_RELAXED, __HIP_MEMORY_SCOPE_AGENT); }
__device__ __forceinline__ unsigned xb_xcc_id() { return (unsigned)__builtin_amdgcn_s_getreg((3 << 11) | 20) & 0xFu; }
#define XB_SPIN(cond, bar) do { unsigned _sp = 0; while (cond) { __builtin_amdgcn_s_sleep(1); \
    if ((++_sp & 255u) == 0u) { if (xb_ld(&(bar)[XB_TMO])) break; if (_sp > XB_SPIN_CAP) { atomicAdd(&(bar)[XB_TMO], 1u); break; } } } } while (0)

struct XcdBarrier {
    unsigned* bar; unsigned x;
    volatile LAS unsigned* st;
};

__device__ __forceinline__ XcdBarrier xcd_barrier_post(unsigned* bar, volatile LAS unsigned* st) {
    XcdBarrier b; b.bar = bar; b.x = xb_xcc_id(); b.st = st;
    if (threadIdx.x == 0) (void)xb_add(&bar[XB_XCNT(b.x)], 1u);
    return b;
}
__device__ __forceinline__ void xcd_barrier_complete(unsigned* bar, unsigned x, unsigned& nloc, unsigned& nx) {
    const unsigned G = gridDim.x * gridDim.y * gridDim.z;
    unsigned sum, cnt, mine, sp = 0u;
    for (;;) {
        sum = 0u; cnt = 0u; mine = 0u;
#pragma unroll
        for (unsigned j = 0; j < 16; ++j) { const unsigned c = xb_ld(&bar[XB_XCNT(j)]); sum += c; cnt += (c > 0u) ? 1u : 0u; mine = (j == x) ? c : mine; }
        if (sum == G) break;
        __builtin_amdgcn_s_sleep(1);
        if ((++sp & 255u) == 0u) { if (xb_ld(&bar[XB_TMO])) break; if (sp > XB_SPIN_CAP) { atomicAdd(&bar[XB_TMO], 1u); break; } }
    }
    nloc = mine > 0u ? mine : 1u; nx = cnt > 0u ? cnt : 1u;
}

__device__ __forceinline__ void xcd_barrier(const XcdBarrier& b) {
    asm volatile("s_waitcnt vmcnt(0)" ::: "memory");
    __syncthreads();
    if (threadIdx.x == 0) {
        unsigned* bar = b.bar;
        __builtin_amdgcn_s_waitcnt(0);
        unsigned nloc = b.st[0], nx = b.st[1];
        if (nloc == 0u) { xcd_barrier_complete(bar, b.x, nloc, nx); b.st[0] = nloc; b.st[1] = nx; }
        const unsigned old = xb_add(&bar[XB_XSUB(b.x)], 1u);
        const unsigned gen = old / nloc;
        if (old + 1u == (gen + 1u) * nloc) {
            __builtin_amdgcn_fence(__ATOMIC_RELEASE, "agent");
            asm volatile("s_waitcnt vmcnt(0)" ::: "memory");
            const unsigned og = xb_add(&bar[XB_TOP], 1u);
            const unsigned tg = og / nx;
            if (og + 1u == (tg + 1u) * nx) xb_add(&bar[XB_TOPGEN], 1u);
            else XB_SPIN(xb_ld(&bar[XB_TOPGEN]) == tg, bar);
            __builtin_amdgcn_fence(__ATOMIC_ACQUIRE, "agent");
            xb_add(&bar[XB_XGEN(b.x)], 1u);
            asm volatile("s_waitcnt vmcnt(0)" ::: "memory");
        } else {
            XB_SPIN(xb_ld(&bar[XB_XGEN(b.x)]) == gen, bar);
            __builtin_amdgcn_fence(__ATOMIC_ACQUIRE, "agent");
            asm volatile("s_waitcnt vmcnt(0)" ::: "memory");
        }
    }
    __syncthreads();
}

struct TJob { const float* src; u16* dst; int K, N, Kpad, Npad; };
__device__ __forceinline__ bool get_tjob(const Params& P, int j, TJob& t) {
    switch (j) {
    case 0: t = {P.in[6], P.wint, 1024, 3600, 1024, 3840}; return true;
    case 1: t = {P.in[12], P.woutt, 1024, 1024, 1024, 1024}; return true;
    case 2: t = {P.in[29], P.w1t[0], 1024, 4096, 1024, 4096}; return true;
    case 3: t = {P.in[29] + (size_t)1024 * 4096, P.w1t[1], 1024, 4096, 1024, 4096}; return true;
    case 4: t = {P.in[30], P.w2t[0], 4096, 1024, 4096, 1024}; return true;
    case 5: t = {P.in[30] + (size_t)1024 * 4096, P.w2t[1], 4096, 1024, 4096, 1024}; return true;
    case 6: t = {P.in[14], P.rkvt, 1024, 1024, 1024, 1024}; return true;
    case 7: t = {P.in[14] + (size_t)1024 * 1024, P.rkvt + (size_t)1024 * 1024, 1024, 1024, 1024, 1024}; return true;
    case 8: t = {P.in[14] + (size_t)2 * 1024 * 1024, P.rkvt + (size_t)2 * 1024 * 1024, 1024, 1024, 1024, 1024}; return true;
    case 9: t = {P.in[28], P.wot, 1024, 1024, 1024, 1024}; return true;
    case 10: t = {P.in[16], P.lw1t, 1024, 64, 1024, 64}; return true;
    case 11: t = {P.in[16] + 1024 * 64, P.lw1t + 64 * 1024, 1024, 64, 1024, 64}; return true;
    case 12: t = {P.in[19], P.la1t, 1024, 64, 1024, 64}; return true;
    case 13: t = {P.in[19] + 1024 * 64, P.la1t + 64 * 1024, 1024, 64, 1024, 64}; return true;
    case 14: t = {P.in[21], P.lg1t, 1024, 160, 1024, 256}; return true;
    case 15: t = {P.in[17], P.lw2t, 64, 1024, 64, 1024}; return true;
    case 16: t = {P.in[17] + 64 * 1024, P.lw2t + 1024 * 64, 64, 1024, 64, 1024}; return true;
    case 17: t = {P.in[20], P.la2t, 64, 1024, 64, 1024}; return true;
    case 18: t = {P.in[20] + 64 * 1024, P.la2t + 1024 * 64, 64, 1024, 64, 1024}; return true;
    case 19: t = {P.in[22], P.lg2t, 160, 1024, 192, 1024}; return true;
    default: return false;
    }
}

__device__ __forceinline__ void phase_prep(const Params& P, char* smem) {
    const int tid = get_tid(), lane = tid & 63, wave = tid >> 6;
    float* tile = (float*)smem;
    int ubase = 0;
    for (int j = 0; j < 20; ++j) {
        TJob t; get_tjob(P, j, t);
        const int kt = t.Kpad / 64, nt = t.Npad / 64, nu = kt * nt;
        int first = ((int)blockIdx.x - (ubase % (int)gridDim.x) + (int)gridDim.x) % (int)gridDim.x;
        for (int lu = first; lu < nu; lu += gridDim.x) {
            const int k0 = (lu % kt) * 64, n0 = (lu / kt) * 64;
            __syncthreads();
#pragma unroll
            for (int i = 0; i < 2; ++i) {
                int kr = (tid >> 4) + 32 * i, nc = (tid & 15) * 4;
                int k = k0 + kr, n = n0 + nc;
                float4 v = make_float4(0.f, 0.f, 0.f, 0.f);
                if (k < t.K && n < t.N) v = *(const float4*)(t.src + (size_t)k * t.N + n);
                tile[kr * 65 + nc + 0] = v.x; tile[kr * 65 + nc + 1] = v.y; tile[kr * 65 + nc + 2] = v.z; tile[kr * 65 + nc + 3] = v.w;
            }
            __syncthreads();
            {
                int n = tid >> 3, kc = (tid & 7) * 8;
                uint4 o;
                o.x = pack2(tile[(kc + 0) * 65 + n], tile[(kc + 1) * 65 + n]);
                o.y = pack2(tile[(kc + 2) * 65 + n], tile[(kc + 3) * 65 + n]);
                o.z = pack2(tile[(kc + 4) * 65 + n], tile[(kc + 5) * 65 + n]);
                o.w = pack2(tile[(kc + 6) * 65 + n], tile[(kc + 7) * 65 + n]);
                *(uint4*)(t.dst + (size_t)(n0 + n) * t.Kpad + k0 + kc) = o;
            }
        }
        ubase += nu;
    }
    if (blockIdx.x == 0) {
        for (int e = tid; e < 64 * 32; e += NTHREADS) {
            int pos = e >> 5, f = e & 31;
            float inv = powf(10000.f, -(float)f / 32.f);
            float ang = (float)pos * inv;
            P.ropec[e] = cosf(ang); P.ropes[e] = sinf(ang);
        }
    }
    const float* c = P.in[1]; const float* cctx = P.in[3];
    float* sSilu = (float*)smem + 64 * 65 + 3;
    __syncthreads();
    for (int e = tid; e < 9 * 1024; e += NTHREADS) {
        const int r = e >> 10, k = e & 1023;
        const float cv = (r < 8) ? c[r * 1024 + k] : cctx[k];
        sSilu[e] = cv / (1.f + __expf(-cv));
    }
    __syncthreads();
    for (int u = blockIdx.x + gridDim.x * wave; u < 2 * 384; u += gridDim.x * 8) {
        const int l = u / 384, n0 = (u % 384) * 16;
        const int ksub = lane >> 2, nq = lane & 3;
        const float* W = P.in[4] + (size_t)l * 1024 * 6144 + n0 + nq * 4;
        float acc[9][4];
#pragma unroll
        for (int r = 0; r < 9; ++r) { acc[r][0] = acc[r][1] = acc[r][2] = acc[r][3] = 0.f; }
        for (int it0 = 0; it0 < 64; it0 += 16) {
            float4 w[16];
#pragma unroll
            for (int j = 0; j < 16; ++j) w[j] = *(const float4*)(W + (size_t)((it0 + j) * 16 + ksub) * 6144);
#pragma unroll
            for (int j = 0; j < 16; ++j) {
                const int k = (it0 + j) * 16 + ksub;
#pragma unroll
                for (int r = 0; r < 9; ++r) {
                    const float cv = sSilu[r * 1024 + k];
                    acc[r][0] += cv * w[j].x; acc[r][1] += cv * w[j].y; acc[r][2] += cv * w[j].z; acc[r][3] += cv * w[j].w;
                }
            }
        }
#pragma unroll
        for (int r = 0; r < 9; ++r)
#pragma unroll
            for (int q = 0; q < 4; ++q) {
                float v = acc[r][q];
                v += __shfl_xor(v, 4); v += __shfl_xor(v, 8); v += __shfl_xor(v, 16); v += __shfl_xor(v, 32);
                acc[r][q] = v;
            }
        if (ksub == 0) {
#pragma unroll
            for (int r = 0; r < 9; ++r)
#pragma unroll
                for (int q = 0; q < 4; ++q) {
                    int n = n0 + nq * 4 + q;
                    P.mod[(size_t)(l * 9 + r) * 6144 + n] = acc[r][q] + P.in[5][l * 6144 + n];
                }
        }
    }
}

__device__ __forceinline__ void phase_norm(const Params& P, int which, u16* dst, int nrows) {
    const int lane = get_tid() & 63, wave = get_tid() >> 6;
    const int layer = which >> 1, shc = (which & 1) ? 3 : 0;
    constexpr int RB = 4;
    const int nwaves = gridDim.x * 8;
    for (int mbase = (blockIdx.x * 8 + wave) * RB; mbase < nrows; mbase += nwaves * RB) {
        float4 v[RB][4];
        float ss[RB];
#pragma unroll
        for (int q = 0; q < RB; ++q) {
            const int m = mbase + q;
            const float* src;
            if (which == 0) src = (m < ML) ? P.in[0] + (size_t)m * 1024 : P.in[2] + (size_t)(m - ML) * 1024;
            else src = resptr(P, m);
#pragma unroll
            for (int i = 0; i < 4; ++i) v[q][i] = ((const float4*)src)[lane + 64 * i];
        }
#pragma unroll
        for (int q = 0; q < RB; ++q) {
            float s = 0.f;
#pragma unroll
            for (int i = 0; i < 4; ++i) s += v[q][i].x * v[q][i].x + v[q][i].y * v[q][i].y + v[q][i].z * v[q][i].z + v[q][i].w * v[q][i].w;
            s = sum16(s);
            s += __shfl_xor(s, 16); s += __shfl_xor(s, 32);
            ss[q] = rsqrtf(s * (1.f / 1024.f) + 1e-6f);
        }
#pragma unroll
        for (int q = 0; q < RB; ++q) {
            const int m = mbase + q;
            const float* mr = modrow(P, layer, m);
            const float rinv = ss[q];
#pragma unroll
            for (int i = 0; i < 4; ++i) {
                const int col = (lane + 64 * i) * 4;
                float4 sh = *(const float4*)(mr + shc * 1024 + col);
                float4 sc = *(const float4*)(mr + (shc + 1) * 1024 + col);
                uint2 o;
                o.x = pack2(v[q][i].x * rinv * (1.f + sc.x) + sh.x, v[q][i].y * rinv * (1.f + sc.y) + sh.y);
                o.y = pack2(v[q][i].z * rinv * (1.f + sc.z) + sh.z, v[q][i].w * rinv * (1.f + sc.w) + sh.w);
                *(uint2*)(dst + (size_t)m * 1024 + col) = o;
            }
        }
    }
}

constexpr int BM = 256, BN = 256, BK = 64, LDK = 72;
enum { E_MLPDN_AT = 100, E_INPROJ = 1, E_OUT0, E_MLPUP, E_MLPDN, E_R, E_K, E_V, E_HW, E_HA, E_HG, E_E, E_A, E_GZ, E_RWOUT };

struct Epi {
    int mode, layer, z;
    u16* o16;
    int ldo;
};

__device__ __forceinline__ void epilogue(const Params& P, const Epi& E, int mb, int nb, f32x4 (&acc)[4][4], int lane) {
    const int quad = lane >> 4, l15 = lane & 15;
    switch (E.mode) {
    case E_INPROJ: {
        const int region = nb >> 9;
        if (region <= 1) {
            const float* nw = P.in[region == 0 ? 8 : 9];
            const float scale = region == 0 ? 0.125f : 1.f;
            u16* dst = P.slot[1] + (region == 0 ? 0 : HALF);
            const int cb = nb & 511;
#pragma unroll
            for (int i = 0; i < 4; ++i)
#pragma unroll
                for (int r = 0; r < 4; ++r) { __builtin_amdgcn_sched_barrier(0);
                    float ss = 0.f;
#pragma unroll
                    for (int j = 0; j < 4; ++j) ss += acc[i][j][r] * acc[i][j][r];
                    ss = sum16(ss);
                    const float rinv = rsqrtf(ss * (1.f / 64.f) + 1e-6f) * scale;
                    const int m = mb + i * 16 + quad * 4 + r;
#pragma unroll
                    for (int j = 0; j < 4; ++j)
                        dst[(size_t)m * 512 + cb + j * 16 + l15] = f2bf(acc[i][j][r] * rinv * nw[j * 16 + l15]);
                }
        } else if (region == 2 || region == 5) {
            const int hd = region == 2 ? 64 : 128, nh = region == 2 ? 8 : 4;
            u16* dst = region == 2 ? P.slot[2] : P.slot[4];
            const int cb = nb & 511;
#pragma unroll
            for (int i = 0; i < 4; ++i) {
                const int m = mb + i * 16 + quad * 4;
#pragma unroll
                for (int j = 0; j < 4; ++j) {
                    const int col = cb + j * 16 + l15, h = col / hd, d = col % hd;
                    uint2 o; o.x = pack2(acc[i][j][0], acc[i][j][1]); o.y = pack2(acc[i][j][2], acc[i][j][3]);
                    size_t off;
                    if (m < ML) off = ((size_t)((m >> 12) * nh + h) * hd + d) * 4096 + (m & 4095);
                    else { int mc = m - ML; off = (size_t)ML * 512 + ((size_t)((mc >> 8) * nh + h) * hd + d) * 256 + (mc & 255); }
                    *(uint2*)(dst + off) = o;
                }
            }
        } else if (region == 3 || region == 4) {
            const int cb = nb & 511;
            const bool colhalf = (cb & 64) != 0;
            const float scale = region == 4 ? 0.08838834764831845f : 1.f;
            u16* dst = region == 3 ? P.slot[2] + HALF : P.slot[3];
            u16* dstT = P.slot[3] + HALF;
#pragma unroll
            for (int i = 0; i < 4; ++i) {
                const int m0 = mb + i * 16 + quad * 4;
#pragma unroll
                for (int j = 0; j < 2; ++j) {
                    __builtin_amdgcn_sched_barrier(0);
                    float o1[4], o2[4];
                    const int f = j * 16 + l15;
#pragma unroll
                    for (int r = 0; r < 4; ++r) {
                        const int m = m0 + r;
                        const float x1 = acc[i][j][r] * scale, x2 = acc[i][j + 2][r] * scale;
                        if (m < ML) {
                            const int t = m & 4095, pos = colhalf ? (t & 63) : (t >> 6);
                            const float c = P.ropec[pos * 32 + f], s = P.ropes[pos * 32 + f];
                            o1[r] = x1 * c - x2 * s; o2[r] = x1 * s + x2 * c;
                        } else { o1[r] = x1; o2[r] = x2; }
                    }
#pragma unroll
                    for (int hh = 0; hh < 2; ++hh) {
                        const int col = cb + (j + 2 * hh) * 16 + l15;
#pragma unroll
                        for (int r = 0; r < 4; ++r) dst[(size_t)(m0 + r) * 512 + col] = f2bf(hh ? o2[r] : o1[r]);
                        if (region == 4) {
                            const int h = col >> 7, d = col & 127;
                            uint2 q;
                            q.x = hh ? pack2(o2[0], o2[1]) : pack2(o1[0], o1[1]);
                            q.y = hh ? pack2(o2[2], o2[3]) : pack2(o1[2], o1[3]);
                            size_t off;
                            if (m0 < ML) off = ((size_t)((m0 >> 12) * 4 + h) * 128 + d) * 4096 + (m0 & 4095);
                            else { int mc = m0 - ML; off = (size_t)ML * 512 + ((size_t)((mc >> 8) * 4 + h) * 128 + d) * 256 + (mc & 255); }
                            *(uint2*)(dstT + off) = q;
                        }
                    }
                }
            }
        } else if (region == 6) {
            u16* dst = P.slot[4] + HALF;
            const int cb = nb & 511;
#pragma unroll
            for (int i = 0; i < 4; ++i)
#pragma unroll
                for (int r = 0; r < 4; ++r) { __builtin_amdgcn_sched_barrier(0);
                    const int m = mb + i * 16 + quad * 4 + r;
#pragma unroll
                    for (int j = 0; j < 4; ++j) dst[(size_t)m * 512 + cb + j * 16 + l15] = f2bf(acc[i][j][r]);
                }
        } else if (nb == 3584) {
            const float gb = P.in[7][l15];
            const bool isf = (l15 & 4) != 0;
#pragma unroll
            for (int i = 0; i < 4; ++i)
#pragma unroll
                for (int r = 0; r < 4; ++r) { __builtin_amdgcn_sched_barrier(0);
                    const int m = mb + i * 16 + quad * 4 + r;
                    float g = acc[i][0][r] + gb;
                    g = 15.f * tanhf(g * (1.f / 15.f));
                    if (isf) g = fminf(g, 0.f) - log1pf(__expf(-fabsf(g)));
                    P.gates[(size_t)m * 16 + l15] = g;
                }
        }
    } break;
    case E_MLPDN_AT: {
#pragma unroll
        for (int i = 0; i < 4; ++i)
#pragma unroll
            for (int r = 0; r < 4; ++r) {
                const int m = mb + i * 16 + quad * 4 + r;
                const float* mr = modrow(P, E.layer, m) + 5 * 1024;
                float* rp = resptr(P, m);
#pragma unroll
                for (int j = 0; j < 4; ++j) {
                    const int n = nb + j * 16 + l15;
                    atomicAdd(rp + n, mr[n] * acc[i][j][r]);
                }
            }
    } break;
    case E_OUT0: case E_MLPDN: case E_RWOUT: {
        const int gch = (E.mode == E_MLPDN) ? 5 : 2;
#pragma unroll
        for (int i = 0; i < 4; ++i)
#pragma unroll
            for (int r = 0; r < 4; ++r) { __builtin_amdgcn_sched_barrier(0);
                const int m = mb + i * 16 + quad * 4 + r;
                const float* mr = modrow(P, E.layer, m) + gch * 1024;
                float* rp = resptr(P, m);
                const float* xin = rp;
                if (E.mode == E_OUT0) xin = (m < ML) ? P.in[0] + (size_t)m * 1024 : P.in[2] + (size_t)(m - ML) * 1024;
#pragma unroll
                for (int j = 0; j < 4; ++j) {
                    const int n = nb + j * 16 + l15;
                    rp[n] = xin[n] + mr[n] * acc[i][j][r];
                }
            }
    } break;
    case E_MLPUP: case E_R: case E_V: case E_HW: case E_HA: case E_HG: {
#pragma unroll
        for (int i = 0; i < 4; ++i)
#pragma unroll
            for (int r = 0; r < 4; ++r) { __builtin_amdgcn_sched_barrier(0);
                const int m = mb + i * 16 + quad * 4 + r;
#pragma unroll
                for (int j = 0; j < 4; ++j) {
                    const int n = nb + j * 16 + l15;
                    float v = acc[i][j][r];
                    if (E.mode == E_MLPUP) { v = fmaxf(v, 0.f); v = v * v; }
                    else if (E.mode == E_HW) v = tanhf(v);
                    else if (E.mode == E_HG) v = sigmoidf_(v);
                    if (n < E.ldo) E.o16[(size_t)m * E.ldo + n] = f2bf(v);
                }
            }
    } break;
    case E_K: {
        const int hd = nb >> 6;
        const float* kk = P.in[23];
#pragma unroll
        for (int i = 0; i < 4; ++i)
#pragma unroll
            for (int r = 0; r < 4; ++r) { __builtin_amdgcn_sched_barrier(0);
                const int m = mb + i * 16 + quad * 4 + r;
                float ss = 0.f;
#pragma unroll
                for (int j = 0; j < 4; ++j) { float v = acc[i][j][r] * kk[nb + j * 16 + l15]; ss += v * v; }
                ss = sum16(ss);
                if (l15 == 0) P.knorm[(size_t)m * 16 + hd] = 1.f / fmaxf(sqrtf(ss), 1e-12f);
#pragma unroll
                for (int j = 0; j < 4; ++j) E.o16[(size_t)m * 1024 + nb + j * 16 + l15] = f2bf(acc[i][j][r]);
            }
    } break;
    case E_E: {
        const float* w0 = P.in[15] + E.z * 1024;
#pragma unroll
        for (int i = 0; i < 4; ++i)
#pragma unroll
            for (int r = 0; r < 4; ++r) { __builtin_amdgcn_sched_barrier(0);
                const int m = mb + i * 16 + quad * 4 + r;
#pragma unroll
                for (int j = 0; j < 4; ++j) {
                    const int n = nb + j * 16 + l15;
                    E.o16[(size_t)m * 1024 + n] = f2bf(sigmoidf_(w0[n] + acc[i][j][r]) * 0.6065306597126334f);
                }
            }
    } break;
    case E_A: {
        const float* a0 = P.in[18] + E.z * 1024;
        u8* dst = (u8*)P.slot[0] + (size_t)E.z * MA * 1024;
#pragma unroll
        for (int i = 0; i < 4; ++i)
#pragma unroll
            for (int r = 0; r < 4; ++r) { __builtin_amdgcn_sched_barrier(0);
                const int m = mb + i * 16 + quad * 4 + r;
#pragma unroll
                for (int j = 0; j < 4; ++j) {
                    const int n = nb + j * 16 + l15;
                    float a = sigmoidf_(a0[n] + acc[i][j][r]);
                    dst[(size_t)m * 1024 + n] = (u8)__float2int_rn(a * 255.f);
                }
            }
    } break;
    default: break;
    }
}

__device__ __forceinline__ void epilogue_t(const Params& P, const Epi& E, int mb, int nb, f32x4 (&acc)[4][4], int lane) {
    const int quad = lane >> 4, l15 = lane & 15;
#pragma unroll
    for (int i = 0; i < 4; ++i) {
        const int m = mb + i * 16 + l15;
#pragma unroll
        for (int j = 0; j < 4; ++j) {
            const int n = nb + j * 16 + quad * 4;
            const f32x4 v = acc[i][j];
            if (E.mode == E_E) {
                const float4 w0 = *(const float4*)(P.in[15] + E.z * 1024 + n);
                uint2 o;
                o.x = pack2(sigmoidf_(w0.x + v[0]) * 0.6065306597126334f, sigmoidf_(w0.y + v[1]) * 0.6065306597126334f);
                o.y = pack2(sigmoidf_(w0.z + v[2]) * 0.6065306597126334f, sigmoidf_(w0.w + v[3]) * 0.6065306597126334f);
                *(uint2*)(E.o16 + (size_t)m * 1024 + n) = o;
            } else if (E.mode == E_A) {
                const float4 a0 = *(const float4*)(P.in[18] + E.z * 1024 + n);
                u8* dst = (u8*)P.slot[0] + (size_t)E.z * MA * 1024;
                const unsigned b0 = (unsigned)__float2int_rn(sigmoidf_(a0.x + v[0]) * 255.f), b1 = (unsigned)__float2int_rn(sigmoidf_(a0.y + v[1]) * 255.f);
                const unsigned b2 = (unsigned)__float2int_rn(sigmoidf_(a0.z + v[2]) * 255.f), b3 = (unsigned)__float2int_rn(sigmoidf_(a0.w + v[3]) * 255.f);
                *(unsigned*)(dst + (size_t)m * 1024 + n) = b0 | (b1 << 8) | (b2 << 16) | (b3 << 24);
            } else {
                if (n < E.ldo) {
                    uint2 o; o.x = pack2(v[0], v[1]); o.y = pack2(v[2], v[3]);
                    *(uint2*)(E.o16 + (size_t)m * E.ldo + n) = o;
                }
            }
        }
    }
}

typedef float v2f_ __attribute__((ext_vector_type(2)));
__device__ __forceinline__ unsigned mixw(unsigned c, unsigned pm, unsigned pn, v2f_ mu) {
    const v2f_ c2 = {lo2f(c), hi2f(c)}, p2 = {lo2f(pm), hi2f(pm)}, n2 = {lo2f(pn), hi2f(pn)};
    const v2f_ half = {0.5f, 0.5f};
    const v2f_ x2 = __builtin_elementwise_fma(p2 + n2, half, -c2);
    const v2f_ o2 = __builtin_elementwise_fma(x2, mu, c2);
    return pack2(o2.x, o2.y);
}
__device__ __forceinline__ int g8_lds_byte(int r, int c);
__device__ __forceinline__ void g8_stage_rc(int b, int& R, int& C);
template <int AMODE>
__device__ __forceinline__ void gemm_tile(const Params& P, const u16* __restrict__ A, int lda, const u16* __restrict__ Bt, int K,
                                          int m0, int n0, const float* mu, const Epi& E, char* smem) {
    const int tid = get_tid(), lane = tid & 63, wave = tid >> 6;
    const int quad = lane >> 4, l15 = lane & 15;
    const int wm = wave >> 1, wn = wave & 1;
    u16* sA = (u16*)smem;
    u16* sB = sA + 2 * BM * LDK;
    const int lrow = tid >> 3, lkc = (tid & 7) * 8;
    f32x4 acc[2][4][4];
#pragma unroll
    for (int h = 0; h < 2; ++h)
#pragma unroll
        for (int i = 0; i < 4; ++i)
#pragma unroll
            for (int j = 0; j < 4; ++j) acc[h][i][j] = (f32x4){0.f, 0.f, 0.f, 0.f};

    uint4 ra0 = make_uint4(0, 0, 0, 0), ra1 = ra0, ra2 = ra0, ra3 = ra0;
    uint4 rb0 = ra0, rb1 = ra0, rb2 = ra0, rb3 = ra0;
    uint4 hm = ra0, hp = ra0;
    int offm = 0, offp = 0; float fm0 = 0.5f, fp3 = 0.5f;
    if (AMODE) {
        const int len = (m0 < ML) ? 4096 : 256;
        const int tb = (m0 < ML) ? (m0 & 4095) : ((m0 - ML) & 255);
        const bool hasprev = !(lrow == 0 && tb == 0), hasnext = !(lrow == 63 && tb + 256 == len);
        offm = hasprev ? lda : 0; offp = hasnext ? 4 * lda : 0;
        fm0 = hasprev ? 0.5f : 0.f; fp3 = hasnext ? 0.5f : 0.f;
    }
    unsigned gvoff0 = 0, gvoff1 = 0; int gfrag = 0;
    if (AMODE) {
        int r0, c0, r1, c1;
        g8_stage_rc(tid * 16, r0, c0); g8_stage_rc(tid * 16 + 8192, r1, c1);
        gvoff0 = (unsigned)(r0 * K + c0) * 2u; gvoff1 = (unsigned)(r1 * K + c1) * 2u;
        gfrag = g8_lds_byte(l15, quad * 8);
    }
    int nk = K / BK;
    asm volatile("" : "+s"(nk));
    for (int kt = -1; kt < nk; ++kt) {
        const bool more = kt + 1 < nk;
        if (more) {
            const int k0 = (kt + 1) * BK;
            if (!AMODE) {
                const u16* p = A + (size_t)(m0 + lrow) * lda + k0 + lkc;
                ra0 = *(const uint4*)p; ra1 = *(const uint4*)(p + (size_t)64 * lda);
                ra2 = *(const uint4*)(p + (size_t)128 * lda); ra3 = *(const uint4*)(p + (size_t)192 * lda);
            } else {
                const u16* p = A + (size_t)(m0 + 4 * lrow) * lda + k0 + lkc;
                ra0 = *(const uint4*)p; ra1 = *(const uint4*)(p + lda);
                ra2 = *(const uint4*)(p + 2 * lda); ra3 = *(const uint4*)(p + 3 * lda);
                hm = *(const uint4*)(p - offm); hp = *(const uint4*)(p + offp);
            }
            if (!AMODE) {
                const u16* q = Bt + (size_t)(n0 + lrow) * K + k0 + lkc;
                rb0 = *(const uint4*)q; rb1 = *(const uint4*)(q + (size_t)64 * K);
                rb2 = *(const uint4*)(q + (size_t)128 * K); rb3 = *(const uint4*)(q + (size_t)192 * K);
            } else {
                const int nbuf = (kt + 1) & 1;
#pragma unroll
                for (int hh = 0; hh < 2; ++hh) {
                    const char* gb = (const char*)Bt + ((long)(n0 + hh * 128) * K + k0) * 2;
                    char* dst = (char*)sB + (nbuf * 2 + hh) * 16384 + tid * 16;
                    __builtin_amdgcn_global_load_lds((const unsigned*)(gb + gvoff0), (LAS unsigned*)dst, 16, 0, 0);
                    __builtin_amdgcn_global_load_lds((const unsigned*)(gb + gvoff1), (LAS unsigned*)(dst + 8192), 16, 0, 0);
                }
            }
        }
        if (kt >= 0) {
            const u16* a = sA + (kt & 1) * BM * LDK + (wm * 64 + l15) * LDK + quad * 8;
            const u16* b = sB + (kt & 1) * BN * LDK + (wn * 128 + l15) * LDK + quad * 8;
            const char* bq = (const char*)sB + ((kt & 1) * 2 + wn) * 16384 + gfrag;
#pragma unroll
            for (int ks = 0; ks < 2; ++ks) {
                s16x8 af[4];
#pragma unroll
                for (int i = 0; i < 4; ++i) af[i] = as_frag(*(const uint4*)(a + i * 16 * LDK + ks * 32));
#pragma unroll
                for (int h = 0; h < 2; ++h) {
                    s16x8 bfr[4];
#pragma unroll
                    for (int j = 0; j < 4; ++j) {
                        if (AMODE) bfr[j] = as_frag(*(const uint4*)(bq + ((h * 4 + j) * 2 + ks) * 1024));
                        else bfr[j] = as_frag(*(const uint4*)(b + (h * 64 + j * 16) * LDK + ks * 32));
                    }
#pragma unroll
                    for (int i = 0; i < 4; ++i)
#pragma unroll
                        for (int j = 0; j < 4; ++j) acc[h][i][j] = AMODE ? mfma16(af[i], bfr[j], acc[h][i][j]) : mfma16(bfr[j], af[i], acc[h][i][j]);
                }
            }
        }
        if (more) {
            const int k0 = (kt + 1) * BK, buf = (kt + 1) & 1;
            u16* a = sA + buf * BM * LDK; u16* b = sB + buf * BN * LDK;
            if (AMODE) {
                const float4 mu0 = *(const float4*)(mu + k0 + lkc), mu1 = *(const float4*)(mu + k0 + lkc + 4);
#define MIXW(C, PM, PN, M2) mixw((C), (PM), (PN), (M2))
#define MIXROW(C, PM, PN) make_uint4(MIXW(C.x, PM.x, PN.x, muA), MIXW(C.y, PM.y, PN.y, muB), MIXW(C.z, PM.z, PN.z, muC), MIXW(C.w, PM.w, PN.w, muD))
                const v2f_ muA = {mu0.x, mu0.y}, muB = {mu0.z, mu0.w}, muC = {mu1.x, mu1.y}, muD = {mu1.z, mu1.w};
                uint4 hmz = hm, hpz = hp;
                if (fm0 == 0.f) hmz = make_uint4(0, 0, 0, 0);
                if (fp3 == 0.f) hpz = make_uint4(0, 0, 0, 0);
                *(uint4*)(a + (4 * lrow + 0) * LDK + lkc) = MIXROW(ra0, hmz, ra1);
                *(uint4*)(a + (4 * lrow + 1) * LDK + lkc) = MIXROW(ra1, ra0, ra2);
                *(uint4*)(a + (4 * lrow + 2) * LDK + lkc) = MIXROW(ra2, ra1, ra3);
                *(uint4*)(a + (4 * lrow + 3) * LDK + lkc) = MIXROW(ra3, ra2, hpz);
#undef MIXROW
#undef MIXW
            } else {
                *(uint4*)(a + lrow * LDK + lkc) = ra0; *(uint4*)(a + (lrow + 64) * LDK + lkc) = ra1;
                *(uint4*)(a + (lrow + 128) * LDK + lkc) = ra2; *(uint4*)(a + (lrow + 192) * LDK + lkc) = ra3;
            }
            if (!AMODE) {
                *(uint4*)(b + lrow * LDK + lkc) = rb0; *(uint4*)(b + (lrow + 64) * LDK + lkc) = rb1;
                *(uint4*)(b + (lrow + 128) * LDK + lkc) = rb2; *(uint4*)(b + (lrow + 192) * LDK + lkc) = rb3;
            }
        }
        if (AMODE) asm volatile("s_waitcnt vmcnt(0)" ::: "memory");
        __syncthreads();
    }
    int lane_e = lane;
    asm volatile("" : "+v"(lane_e));
    if (!AMODE) {
        epilogue_t(P, E, m0 + wm * 64, n0 + wn * 128, acc[0], lane_e);
        epilogue_t(P, E, m0 + wm * 64, n0 + wn * 128 + 64, acc[1], lane_e);
        return;
    }
    {
        float* park = (float*)smem;
#pragma unroll
        for (int i = 0; i < 4; ++i)
#pragma unroll
            for (int j = 0; j < 4; ++j)
#pragma unroll
                for (int r = 0; r < 4; ++r) park[((i * 4 + j) * 4 + r) * NTHREADS + tid] = acc[1][i][j][r];
        __builtin_amdgcn_sched_barrier(0);
        epilogue(P, E, m0 + (lane_e >> 6) * 0 + wm * 64, n0 + wn * 128, acc[0], lane_e);
        __builtin_amdgcn_sched_barrier(0);
#pragma unroll
        for (int i = 0; i < 4; ++i)
#pragma unroll
            for (int j = 0; j < 4; ++j)
#pragma unroll
                for (int r = 0; r < 4; ++r) acc[0][i][j][r] = park[((i * 4 + j) * 4 + r) * NTHREADS + tid];
        __builtin_amdgcn_sched_barrier(0);
        epilogue(P, E, m0 + wm * 64, n0 + wn * 128 + 64, acc[0], lane_e);
        __syncthreads();
    }
}


constexpr int G8_HT = 128 * 64;
__device__ __forceinline__ int g8_lds_byte(int r, int c) {
    int st = (r >> 4) * 2 + (c >> 5), rr = r & 15, cc = c & 31, ob = rr * 64 + cc * 2;
    return st * 1024 + (ob ^ (((ob >> 9) & 1) << 5));
}
__device__ __forceinline__ void g8_stage_rc(int b, int& R, int& C) {
    int st = b / 1024, sb = b % 1024, swz = sb ^ (((sb >> 9) & 1) << 5);
    R = (st >> 1) * 16 + swz / 64; C = (st & 1) * 32 + (swz % 64) / 2;
}
__device__ __forceinline__ void gemm8_tile(const Params& P, const u16* __restrict__ A, const u16* __restrict__ Bt, const int K,
                                           const int brow, const int bcol, const Epi& E, char* smem, const int kext = 0) {
    u16* shm = (u16*)smem;
#define G8_SA(b, h) (shm + ((b) * 2 + (h)) * G8_HT)
#define G8_SB(b, h) (shm + (4 + (b) * 2 + (h)) * G8_HT)
#define G8_STAGE_A(PTR, br, kt) do { const char* _gb = (const char*)A + ((long)(br) * K + (long)(kt) * 64) * 2; \
    __builtin_amdgcn_global_load_lds((const unsigned*)(_gb + voffA0), (LAS unsigned*)((char*)(PTR) + tidx * 16), 16, 0, 0); \
    __builtin_amdgcn_global_load_lds((const unsigned*)(_gb + voffA1), (LAS unsigned*)((char*)(PTR) + tidx * 16 + 8192), 16, 0, 0); } while (0)
#define G8_STAGE_B(PTR, hh, kt) do { const char* _gb = (const char*)Bt + ((long)(bcol + (hh) * 32) * K + (long)(kt) * 64) * 2; \
    __builtin_amdgcn_global_load_lds((const unsigned*)(_gb + voffB0), (LAS unsigned*)((char*)(PTR) + tidx * 16), 16, 0, 0); \
    __builtin_amdgcn_global_load_lds((const unsigned*)(_gb + voffB1), (LAS unsigned*)((char*)(PTR) + tidx * 16 + 8192), 16, 0, 0); } while (0)
#define G8_LDA(dst, b, h) for (int m = 0; m < 4; ++m) for (int k = 0; k < 2; ++k) \
    dst[m][k] = *reinterpret_cast<const s16x8*>(aBase + ((b) * 2 + (h)) * (G8_HT * 2) + (2 * m + k) * 1024)
#define G8_LDB(dst, b, h) for (int n = 0; n < 2; ++n) for (int k = 0; k < 2; ++k) \
    dst[n][k] = *reinterpret_cast<const s16x8*>(bBase + ((b) * 2 + (h)) * (G8_HT * 2) + (2 * n + k) * 1024)
#define G8_MMA(ai, bj, At_, Bt_) do { __builtin_amdgcn_s_setprio(1); \
    for (int m = 0; m < 4; ++m) for (int n = 0; n < 2; ++n) for (int k = 0; k < 2; ++k) \
        acc[ai][bj][m][n] = __builtin_amdgcn_mfma_f32_16x16x32_bf16(At_[m][k], Bt_[n][k], acc[ai][bj][m][n], 0, 0, 0); \
    __builtin_amdgcn_s_setprio(0); } while (0)
#define G8_WAIT_V(n) asm volatile("s_waitcnt vmcnt(" #n ")" ::: "memory")
#define G8_WAIT_L(n) asm volatile("s_waitcnt lgkmcnt(" #n ")" ::: "memory")
#define G8_BAR __builtin_amdgcn_s_barrier()
#define G8_SCHED __builtin_amdgcn_sched_barrier(0)
    const int tidx = get_tid();
    const int wid = tidx >> 6, lane = tidx & 63, wr = wid >> 2, wc = wid & 3, fr = lane & 15, fq = lane >> 4;
    const char* aBase = (const char*)shm + g8_lds_byte(wr * 64 + fr, fq * 8);
    const char* bBase = (const char*)shm + 4 * (G8_HT * 2) + g8_lds_byte(wc * 32 + fr, fq * 8);
    unsigned voffA0, voffA1, voffB0, voffB1;
    {
        int r0, c0, r1, c1;
        g8_stage_rc(tidx * 16, r0, c0); g8_stage_rc(tidx * 16 + 8192, r1, c1);
        voffA0 = (unsigned)(r0 * K + c0) * 2u; voffA1 = (unsigned)(r1 * K + c1) * 2u;
        voffB0 = (unsigned)((((r0 >> 5) << 6) + (r0 & 31)) * K + c0) * 2u; voffB1 = (unsigned)((((r1 >> 5) << 6) + (r1 & 31)) * K + c1) * 2u;
    }
    f32x4 acc[2][2][4][2];
#pragma unroll
    for (int a = 0; a < 2; ++a)
#pragma unroll
        for (int b = 0; b < 2; ++b)
#pragma unroll
            for (int m = 0; m < 4; ++m)
#pragma unroll
                for (int n = 0; n < 2; ++n) acc[a][b][m][n] = (f32x4){0.f, 0.f, 0.f, 0.f};
    s16x8 At[4][2], B0[2][2], B1[2][2];
    int nt = (kext ? kext : K) / 64;
    asm volatile("" : "+s"(nt));
    G8_STAGE_B(G8_SB(0, 0), 0, 0); G8_STAGE_A(G8_SA(0, 0), brow, 0);
    G8_STAGE_B(G8_SB(0, 1), 1, 0); G8_STAGE_A(G8_SA(0, 1), brow + 128, 0);
    if (wr == 1) G8_BAR;
    G8_WAIT_V(4); G8_BAR;
    G8_STAGE_B(G8_SB(1, 0), 0, 1); G8_STAGE_A(G8_SA(1, 0), brow, 1); G8_STAGE_B(G8_SB(1, 1), 1, 1);
    G8_WAIT_V(6); G8_BAR;
    for (int t = 0; t < nt - 2; t += 2) {
        G8_LDB(B0, 0, 0); G8_SCHED; G8_LDA(At, 0, 0); G8_STAGE_A(G8_SA(1, 1), brow + 128, t + 1);
        G8_WAIT_L(8); G8_BAR; G8_WAIT_L(0); G8_MMA(0, 0, At, B0); G8_BAR; G8_SCHED;
        G8_LDB(B1, 0, 1); G8_STAGE_B(G8_SB(0, 0), 0, t + 2);
        G8_BAR; G8_WAIT_L(0); G8_MMA(0, 1, At, B1); G8_BAR;
        G8_LDA(At, 0, 1); G8_STAGE_A(G8_SA(0, 0), brow, t + 2);
        G8_BAR; G8_WAIT_L(0); G8_MMA(1, 0, At, B0); G8_BAR; G8_SCHED;
        G8_STAGE_B(G8_SB(0, 1), 1, t + 2);
        G8_WAIT_V(6); G8_BAR; G8_MMA(1, 1, At, B1); G8_BAR;
        G8_LDB(B0, 1, 0); G8_SCHED; G8_LDA(At, 1, 0); G8_STAGE_A(G8_SA(0, 1), brow + 128, t + 2);
        G8_WAIT_L(8); G8_BAR; G8_WAIT_L(0); G8_MMA(0, 0, At, B0); G8_BAR; G8_SCHED;
        G8_LDB(B1, 1, 1); G8_STAGE_B(G8_SB(1, 0), 0, t + 3);
        G8_BAR; G8_WAIT_L(0); G8_MMA(0, 1, At, B1); G8_BAR;
        G8_LDA(At, 1, 1); G8_STAGE_A(G8_SA(1, 0), brow, t + 3);
        G8_BAR; G8_WAIT_L(0); G8_MMA(1, 0, At, B0); G8_BAR; G8_SCHED;
        G8_STAGE_B(G8_SB(1, 1), 1, t + 3);
        G8_WAIT_V(6); G8_BAR; G8_MMA(1, 1, At, B1); G8_BAR;
    }
    { G8_LDB(B0, 0, 0); G8_LDA(At, 0, 0); G8_STAGE_A(G8_SA(1, 1), brow + 128, nt - 1);
      G8_BAR; G8_WAIT_L(0); G8_MMA(0, 0, At, B0); G8_BAR;
      G8_LDB(B1, 0, 1); G8_BAR; G8_WAIT_L(0); G8_MMA(0, 1, At, B1); G8_BAR;
      G8_LDA(At, 0, 1); G8_WAIT_V(4); G8_BAR; G8_WAIT_L(0); G8_MMA(1, 0, At, B0); G8_MMA(1, 1, At, B1); G8_BAR; }
    { G8_LDB(B0, 1, 0); G8_LDA(At, 1, 0); G8_WAIT_V(2); G8_BAR; G8_WAIT_L(0); G8_MMA(0, 0, At, B0); G8_BAR;
      G8_LDB(B1, 1, 1); G8_WAIT_V(0); G8_BAR; G8_WAIT_L(0); G8_MMA(0, 1, At, B1); G8_BAR;
      G8_LDA(At, 1, 1); G8_BAR; G8_WAIT_L(0); G8_MMA(1, 0, At, B0); G8_MMA(1, 1, At, B1); G8_BAR; }
    if (wr == 0) G8_BAR;
    __syncthreads();
    const int tid_e = get_tid();
    const int lane_e = tid_e & 63, wr_e = tid_e >> 8, wc_e = (tid_e >> 6) & 3;
    {
        f32x4 blk[4][4];
#pragma unroll
        for (int i = 0; i < 4; ++i)
#pragma unroll
            for (int j = 0; j < 4; ++j) blk[i][j] = acc[0][j >> 1][i][j & 1];
        epilogue(P, E, brow + wr_e * 64, bcol + wc_e * 64, blk, lane_e);
        __builtin_amdgcn_sched_barrier(0);
#pragma unroll
        for (int i = 0; i < 4; ++i)
#pragma unroll
            for (int j = 0; j < 4; ++j) blk[i][j] = acc[1][j >> 1][i][j & 1];
        epilogue(P, E, brow + 128 + wr_e * 64, bcol + wc_e * 64, blk, lane_e);
    }
}

__device__ __forceinline__ int xcd_swz(int u0) {
    const int G = gridDim.x, per = G >> 3;
    const int rd = u0 / G, idx = u0 - rd * G;
    return rd * G + (idx & 7) * per + (idx >> 3);
}
struct GJob { const u16* A; int lda; const u16* Bt; int K; const float* mu; Epi E; };

__device__ __forceinline__ void rw2_job(const Params& P, int ntile, GJob& g, int& nt) {
    const int j = ntile >> 2; nt = ntile & 3;
    if (j == 0) g = {P.hw, 128, P.lw2t, 64, nullptr, {E_E, 1, 0, P.slot[4], 1024}};
    else if (j == 1) g = {P.hw + 64, 128, P.lw2t + 1024 * 64, 64, nullptr, {E_E, 1, 1, P.slot[5], 1024}};
    else if (j == 2) g = {P.ha, 128, P.la2t, 64, nullptr, {E_A, 1, 0, nullptr, 0}};
    else g = {P.ha + 64, 128, P.la2t + 1024 * 64, 64, nullptr, {E_A, 1, 1, nullptr, 0}};
}
__device__ __forceinline__ void phase_rw1(const Params& P, char* smem) {
    const int total = 15 * (MA / BM);
    const int totr = (total + gridDim.x - 1) / gridDim.x * gridDim.x;
    for (int u0 = blockIdx.x; u0 < totr; u0 += gridDim.x) {
        const int u = xcd_swz(u0);
        if (u >= total) continue;
        const int ntile = u % 15;
        const int jid = ntile < 12 ? (ntile >> 2) : ntile - 9;
        const int nt = ntile < 12 ? (ntile & 3) : 0;
        const int muidx = (0x541320 >> (4 * jid)) & 15;
        const u16* Bt = jid == 0 ? P.rkvt : jid == 1 ? P.rkvt + (size_t)1024 * 1024 : jid == 2 ? P.rkvt + (size_t)2 * 1024 * 1024
                        : jid == 3 ? P.lw1t : jid == 4 ? P.la1t : P.lg1t;
        u16* o16 = jid == 0 ? P.slot[1] : jid == 1 ? P.slot[2] : jid == 2 ? P.slot[3] : jid == 3 ? P.hw : jid == 4 ? P.ha : P.hg;
        Epi E;
        E.mode = E_R + jid; E.layer = 1; E.z = 0; E.o16 = o16; E.ldo = jid < 3 ? 1024 : (jid < 5 ? 128 : 192);
        gemm_tile<1>(P, P.slot[0], 1024, Bt, 1024, (u / 15) * BM, nt * BN, P.in[13] + muidx * 1024, E, smem);
    }
}
__device__ __forceinline__ void phase_rw2(const Params& P, char* smem) {
    const int total = 16 * (MA / BM);
    const int totr = (total + gridDim.x - 1) / gridDim.x * gridDim.x;
    for (int u0 = blockIdx.x; u0 < totr; u0 += gridDim.x) {
        const int u = xcd_swz(u0);
        if (u >= total) continue;
        GJob g; int nt; rw2_job(P, u % 16, g, nt);
        gemm_tile<0>(P, g.A, g.lda, g.Bt, g.K, (u / 16) * BM, nt * BN, nullptr, g.E, smem);
    }
}

__device__ __forceinline__ void phase_mlpdn0(const Params& P, char* smem) {
    const u16* A = P.slot[1]; const u16* Bt = P.w2t[0];
    const int total = 512 + 256;
    for (int u0 = blockIdx.x; u0 < total; u0 += gridDim.x) {
        const int u = xcd_swz(u0);
        if (u < 512) {
            Epi E{E_MLPDN, 0, 0, nullptr, 0};
            gemm8_tile(P, A, Bt, 4096, (u >> 2) * BM, (u & 3) * BN, E, smem);
        } else {
            const int v = u - 512, ks = v & 7, t = v >> 3;
            Epi E{E_MLPDN_AT, 0, 0, nullptr, 0};
            gemm8_tile(P, A + ks * 512, Bt + ks * 512, 4096, (128 + (t >> 2)) * BM, (t & 3) * BN, E, smem, 512);
        }
    }
}

__device__ __forceinline__ void gemm_single(const Params& P, const u16* A, int lda, const u16* Bt, int K, int ntn, int m_tiles, Epi E, char* smem) {
    const int total = ntn * m_tiles;
    const int totr = (total + gridDim.x - 1) / gridDim.x * gridDim.x;
    for (int u0 = blockIdx.x; u0 < totr; u0 += gridDim.x) {
        const int u = xcd_swz(u0);
        if (u >= total) continue;
        const int nt = u % ntn, mt = u / ntn;
        if (K >= 256 && lda == K) gemm8_tile(P, A, Bt, K, mt * BM, nt * BN, E, smem);
        else gemm_tile<0>(P, A, lda, Bt, K, mt * BM, nt * BN, nullptr, E, smem);
    }
}

__device__ __forceinline__ void na_unit(const Params& P, int b, int h, int rp, bool ctxq, int half, char* smem) {
    const int tid = get_tid(), lane = tid & 63, wave = tid >> 6, quad = lane >> 4, l15 = lane & 15;
    u16* sK = (u16*)smem;
    u16* sVT = sK + 64 * 72;
    float* sBias = (float*)(sK + 4 * 64 * 72);
    const u16* QA = P.slot[1]; const u16* KA = P.slot[1] + HALF; const u16* VAT = P.slot[2];
    u16* CAT = P.slot[0];
    int qrow = 0, c = 0, m, rs_q = 0, rsA = 0, nrows = 0, cs = 0;
    if (!ctxq) {
        const int r0 = 2 * rp;
        qrow = r0 + (wave >> 2); c = (wave & 3) * 16 + l15;
        m = b * 4096 + qrow * 64 + c;
        rs_q = min(max(qrow - 4, 0), 56);
        rsA = min(max(r0 - 4, 0), 56);
        const int rsB = min(max(r0 + 1 - 4, 0), 56);
        nrows = rsB - rsA + 8;
        cs = min(max(c - 8, 0), 48);
    } else {
        m = ML + b * 256 + (half * 8 + wave) * 16 + l15;
    }
    __syncthreads();
    if (!ctxq) for (int e = tid; e < 15 * 31; e += NTHREADS) sBias[e] = P.in[10][h * 465 + e];
    s16x8 qf[2];
#pragma unroll
    for (int ks = 0; ks < 2; ++ks) qf[ks] = as_frag(*(const uint4*)(QA + (size_t)m * 512 + h * 64 + ks * 32 + quad * 8));
    float m_run = -INFINITY, l_run = 0.f;
    f32x4 o[4];
#pragma unroll
    for (int dt = 0; dt < 4; ++dt) o[dt] = (f32x4){0.f, 0.f, 0.f, 0.f};
    const int nblk = nrows + 4;
    const int lrow = tid >> 3, lch = (tid & 7) * 8;
    int ktmask = 15;
    if (!ctxq) {
        const int cq0 = (wave & 3) * 16;
        const int lo = min(max(cq0 - 8, 0), 48), hi = min(max(cq0 + 15 - 8, 0), 48) + 15;
        ktmask = 0;
#pragma unroll
        for (int kt = 0; kt < 4; ++kt) if (kt * 16 + 15 >= lo && kt * 16 <= hi) ktmask |= 1 << kt;
    }
    uint4 pk_, pv_;
    auto gload = [&](int blk) {
        const bool isctx = blk >= nrows;
        const u16 *kp, *vp;
        if (!isctx) {
            const int tk = (rsA + blk) * 64;
            kp = KA + (size_t)(b * 4096 + tk + lrow) * 512 + h * 64 + lch;
            vp = VAT + ((size_t)(b * 8 + h) * 64 + lrow) * 4096 + tk + lch;
        } else {
            const int nk0 = (blk - nrows) * 64;
            kp = KA + (size_t)(ML + b * 256 + nk0 + lrow) * 512 + h * 64 + lch;
            vp = VAT + (size_t)ML * 512 + ((size_t)(b * 8 + h) * 64 + lrow) * 256 + nk0 + lch;
        }
        pk_ = *(const uint4*)kp; pv_ = *(const uint4*)vp;
    };
    gload(0);
    __syncthreads();
    *(uint4*)(sK + lrow * 72 + lch) = pk_; *(uint4*)(sVT + lrow * 72 + lch) = pv_;
    __syncthreads();
    for (int blk = 0; blk < nblk; ++blk) {
        const bool isctx = blk >= nrows;
        const u16* cK = sK + (blk & 1) * 2 * 64 * 72;
        const u16* cVT = cK + 64 * 72;
        if (blk + 1 < nblk) gload(blk + 1);
        const int kr = rsA + blk;
        const int kmask = isctx ? 15 : ktmask;
        if (isctx || (kr >= rs_q && kr < rs_q + 8)) {
            f32x4 s[4];
#pragma unroll
            for (int kt = 0; kt < 4; ++kt) {
                s[kt] = (f32x4){0.f, 0.f, 0.f, 0.f};
                if (kmask & (1 << kt)) {
#pragma unroll
                    for (int ks = 0; ks < 2; ++ks) {
                        s16x8 a = as_frag(*(const uint4*)(cK + (kt * 16 + l15) * 72 + ks * 32 + quad * 8));
                        s[kt] = mfma16(a, qf[ks], s[kt]);
                    }
                }
            }
            float mx = -INFINITY;
#pragma unroll
            for (int kt = 0; kt < 4; ++kt)
#pragma unroll
                for (int r = 0; r < 4; ++r) {
                    float v = s[kt][r];
                    if (!isctx) {
                        const int kc = kt * 16 + quad * 4 + r;
                        const bool valid = (kc >= cs) && (kc < cs + 16);
                        v = valid ? v + sBias[(kr - qrow + 7) * 31 + (kc - c + 15)] : -INFINITY;
                    }
                    s[kt][r] = v; mx = fmaxf(mx, v);
                }
            mx = fmaxf(mx, __shfl_xor(mx, 16)); mx = fmaxf(mx, __shfl_xor(mx, 32));
            const float m_new = fmaxf(m_run, mx);
            const float alpha = __expf(m_run - m_new);
            m_run = m_new;
            float ps = 0.f;
#pragma unroll
            for (int kt = 0; kt < 4; ++kt)
#pragma unroll
                for (int r = 0; r < 4; ++r) { float pv = __expf(s[kt][r] - m_new); s[kt][r] = pv; ps += pv; }
            l_run = l_run * alpha + ps;
#pragma unroll
            for (int dt = 0; dt < 4; ++dt) { o[dt][0] *= alpha; o[dt][1] *= alpha; o[dt][2] *= alpha; o[dt][3] *= alpha; }
#pragma unroll
            for (int sb = 0; sb < 2; ++sb) {
                if (kmask & (3 << (2 * sb))) {
                    uint4 pb;
                    pb.x = pack2(s[2 * sb][0], s[2 * sb][1]); pb.y = pack2(s[2 * sb][2], s[2 * sb][3]);
                    pb.z = pack2(s[2 * sb + 1][0], s[2 * sb + 1][1]); pb.w = pack2(s[2 * sb + 1][2], s[2 * sb + 1][3]);
                    const s16x8 bfrag = as_frag(pb);
#pragma unroll
                    for (int dt = 0; dt < 4; ++dt) {
                        const u16* vr = cVT + (dt * 16 + l15) * 72 + sb * 32 + quad * 4;
                        uint2 lo = *(const uint2*)vr, hi = *(const uint2*)(vr + 16);
                        s16x8 a = as_frag(make_uint4(lo.x, lo.y, hi.x, hi.y));
                        o[dt] = mfma16(a, bfrag, o[dt]);
                    }
                }
            }
        }
        if (blk + 1 < nblk) {
            u16* nK = sK + ((blk + 1) & 1) * 2 * 64 * 72;
            *(uint4*)(nK + lrow * 72 + lch) = pk_; *(uint4*)(nK + 64 * 72 + lrow * 72 + lch) = pv_;
        }
        __syncthreads();
    }
    l_run += __shfl_xor(l_run, 16); l_run += __shfl_xor(l_run, 32);
    const float inv = 1.f / l_run;
#pragma unroll
    for (int dt = 0; dt < 4; ++dt) {
        uint2 q; q.x = pack2(o[dt][0] * inv, o[dt][1] * inv); q.y = pack2(o[dt][2] * inv, o[dt][3] * inv);
        *(uint2*)(CAT + (size_t)m * 1024 + h * 64 + dt * 16 + quad * 4) = q;
    }
}

struct ChunkGeo { int m0; size_t tb; int len; };
__device__ __forceinline__ ChunkGeo chunk_geo(int b, int dir, int pc) {
    ChunkGeo g;
    if (pc < 2) { int oc = dir ? 1 - pc : pc; g.m0 = ML + b * 256 + oc * 128; g.tb = oc * 128; g.len = 256; }
    else { int pp = pc - 2; int oc = dir ? 31 - pp : pp; g.m0 = b * 4096 + oc * 128; g.tb = oc * 128; g.len = 4096; }
    return g;
}
__device__ __forceinline__ size_t tbase(int b, int h, int len) {
    return len == 4096 ? (size_t)(b * 4 + h) * 128 * 4096 : (size_t)ML * 512 + (size_t)(b * 4 + h) * 128 * 256;
}

__device__ __forceinline__ void ml_c1_unit(const Params& P, int chain, int pc, char* smem) {
    const int tid = get_tid(), lane = tid & 63, wave = tid >> 6, quad = lane >> 4, l15 = lane & 15;
    const int dir = chain & 1, h = (chain >> 1) & 3, b = chain >> 3;
    float* sS = (float*)smem;
    float* sW = sS + 128;
    float* sRed = sW + 128;
    const ChunkGeo g = chunk_geo(b, dir, pc);
    const u16* KBT = P.slot[3] + HALF + tbase(b, h, g.len) + g.tb;
    const u16* VBT = P.slot[4] + tbase(b, h, g.len) + g.tb;
    const int e0 = (wave >> 1) * 32, d0 = (wave & 1) * 64;
    uint4 araw[4][2], braw[4][4];
    if (pc < 33) {
#pragma unroll
        for (int ks = 0; ks < 4; ++ks) {
            const int s0 = ks * 32 + quad * 8;
#pragma unroll
            for (int i = 0; i < 2; ++i) araw[ks][i] = *(const uint4*)(VBT + (size_t)(e0 + i * 16 + l15) * g.len + s0);
#pragma unroll
            for (int j = 0; j < 4; ++j) braw[ks][j] = *(const uint4*)(KBT + (size_t)(d0 + j * 16 + l15) * g.len + s0);
        }
    }
    __syncthreads();
    float gi = 0.f, x = 0.f;
    const int s = dir ? 127 - (tid & 127) : (tid & 127);
    if (tid < 128) {
        gi = P.gates[(size_t)(g.m0 + s) * 16 + dir * 8 + h];
        x = P.gates[(size_t)(g.m0 + s) * 16 + dir * 8 + 4 + h];
    }
#pragma unroll
    for (int o = 1; o < 64; o <<= 1) { const float y = __shfl_up(x, o); if (lane >= o) x += y; }
    if (tid == 63) sRed[0] = x;
    __syncthreads();
    if (tid >= 64 && tid < 128) x += sRed[0];
    if (tid == 127) sRed[1] = x;
    __syncthreads();
    const float Bc = sRed[1];
    float wl = -INFINITY, xm = -INFINITY;
    if (tid < 128) { wl = Bc - x + gi; xm = gi - x; }
#pragma unroll
    for (int o = 1; o < 64; o <<= 1) { const float y = __shfl_up(xm, o); if (lane >= o) xm = fmaxf(xm, y); }
    if (tid == 63) sRed[2] = xm;
    float mx = wl;
#pragma unroll
    for (int o = 1; o < 64; o <<= 1) mx = fmaxf(mx, __shfl_xor(mx, o));
    if (lane == 0 && wave < 2) sRed[4 + wave] = mx;
    __syncthreads();
    if (tid >= 64 && tid < 128) xm = fmaxf(xm, sRed[2]);
    const float Mc = fmaxf(sRed[4], sRed[5]);
    if (tid < 128) {
        sW[s] = __expf(wl - Mc);
        P.gb[(size_t)(chain * 34 + pc) * 128 + s] = x;
        P.gx[(size_t)(chain * 34 + pc) * 128 + s] = xm;
    }
    if (pc == 33) return;
    __syncthreads();
    f32x4 acc[2][4];
#pragma unroll
    for (int i = 0; i < 2; ++i)
#pragma unroll
        for (int j = 0; j < 4; ++j) acc[i][j] = (f32x4){0.f, 0.f, 0.f, 0.f};
#pragma unroll
    for (int ks = 0; ks < 4; ++ks) {
        const int s0 = ks * 32 + quad * 8;
        float wv[8];
#pragma unroll
        for (int q = 0; q < 8; ++q) wv[q] = sW[s0 + q];
        s16x8 af[2], bfr[4];
#pragma unroll
        for (int i = 0; i < 2; ++i) {
            const uint4 raw = araw[ks][i];
            uint4 sc;
            sc.x = pack2(lo2f(raw.x) * wv[0], hi2f(raw.x) * wv[1]); sc.y = pack2(lo2f(raw.y) * wv[2], hi2f(raw.y) * wv[3]);
            sc.z = pack2(lo2f(raw.z) * wv[4], hi2f(raw.z) * wv[5]); sc.w = pack2(lo2f(raw.w) * wv[6], hi2f(raw.w) * wv[7]);
            af[i] = as_frag(sc);
        }
#pragma unroll
        for (int j = 0; j < 4; ++j) bfr[j] = as_frag(braw[ks][j]);
#pragma unroll
        for (int i = 0; i < 2; ++i)
#pragma unroll
            for (int j = 0; j < 4; ++j) acc[i][j] = mfma16(af[i], bfr[j], acc[i][j]);
    }
    u16* ST = P.slot[5] + (size_t)(chain * 34 + pc) * 16384;
#pragma unroll
    for (int i = 0; i < 2; ++i)
#pragma unroll
        for (int j = 0; j < 4; ++j)
#pragma unroll
            for (int r = 0; r < 4; ++r)
                ST[(e0 + i * 16 + quad * 4 + r) * 128 + d0 + j * 16 + l15] = f2bf(acc[i][j][r]);
    if (tid < 128) {
        float nu = 0.f;
        const u16* kr = KBT + (size_t)tid * g.len;
        for (int s = 0; s < 128; s += 8) {
            uint4 raw = *(const uint4*)(kr + s);
            nu += lo2f(raw.x) * sW[s] + hi2f(raw.x) * sW[s + 1] + lo2f(raw.y) * sW[s + 2] + hi2f(raw.y) * sW[s + 3]
                + lo2f(raw.z) * sW[s + 4] + hi2f(raw.z) * sW[s + 5] + lo2f(raw.w) * sW[s + 6] + hi2f(raw.w) * sW[s + 7];
        }
        P.mnu[(size_t)(chain * 34 + pc) * 128 + tid] = nu;
    }
    if (tid == 0) { P.mbc[chain * 34 + pc] = Bc; P.mmc[chain * 34 + pc] = Mc; }
}

__device__ __forceinline__ void phase_mix0(const Params& P, char* smem) {
    const int n_c1 = 64 * 34, n_na = 8 * 8 * 32, n_cx = 8 * 8 * 2;
    for (int u = blockIdx.x; u < n_c1 + n_na + n_cx; u += gridDim.x) {
        if (u < n_na) { int v = u; na_unit(P, v >> 8, (v >> 5) & 7, v & 31, false, 0, smem); }
        else if (u < n_na + n_cx) { int v = u - n_na; na_unit(P, v >> 4, (v >> 1) & 7, 0, true, v & 1, smem); }
        else { int v = u - n_na - n_cx; ml_c1_unit(P, v / 34, v % 34, smem); }
    }
}

__device__ __forceinline__ void phase_mlscan(const Params& P) {
    const int tid = get_tid();
    for (int u = blockIdx.x; u < 64 * 33; u += gridDim.x) {
        const int chain = u / 33, grp = u % 33;
        if (grp == 32 && tid >= 128) continue;
        const float* bc = P.mbc + chain * 34; const float* mc = P.mmc + chain * 34;
        float U[33];
        if (grp < 32) {
            u16* st = P.slot[5] + (size_t)chain * 34 * 16384 + grp * 512 + tid;
#pragma unroll
            for (int pc = 0; pc < 33; ++pc) U[pc] = bf2f(st[(size_t)pc * 16384]);
            float C = 0.f, mm = 0.f;
#pragma unroll
            for (int pc = 0; pc < 34; ++pc) {
                st[(size_t)pc * 16384] = f2bf(C);
                if (pc < 33) {
                    const float Bc = bc[pc], Mc = mc[pc];
                    const float mn = fmaxf(Bc + mm, Mc);
                    C = __expf(Bc + mm - mn) * C + __expf(Mc - mn) * U[pc];
                    mm = mn;
                }
            }
        } else {
            float* nu = P.mnu + (size_t)chain * 34 * 128 + tid;
#pragma unroll
            for (int pc = 0; pc < 33; ++pc) U[pc] = nu[pc * 128];
            float C = 0.f, mm = 0.f;
#pragma unroll
            for (int pc = 0; pc < 34; ++pc) {
                nu[pc * 128] = C;
                if (tid == 0) P.mst[chain * 34 + pc] = mm;
                if (pc < 33) {
                    const float Bc = bc[pc], Mc = mc[pc];
                    const float mn = fmaxf(Bc + mm, Mc);
                    C = __expf(Bc + mm - mn) * C + __expf(Mc - mn) * U[pc];
                    mm = mn;
                }
            }
        }
    }
}

__device__ __forceinline__ void ml_c3_unit(const Params& P, int b, int h, int cid, char* smem) {
    const int tid = get_tid(), lane = tid & 63, wave = tid >> 6, quad = lane >> 4, l15 = lane & 15;
    float* sB = (float*)smem;
    float* sI = sB + 256;
    float* sX = sI + 256;
    const bool isctx = cid < 2;
    const int oc = isctx ? cid : cid - 2;
    const int nseg = isctx ? 2 : 32, len = isctx ? 256 : 4096;
    const int m0 = isctx ? ML + b * 256 + oc * 128 : b * 4096 + oc * 128;
    const u16* QB = P.slot[2] + HALF; const u16* KB = P.slot[3];
    const u16* VBT = P.slot[4] + tbase(b, h, len) + oc * 128;
    const u16* OB = P.slot[4] + HALF;
    u16* CAT = P.slot[0];
    __syncthreads();
    u16* sKt = (u16*)(smem + 3072 + 65536);
    u16* sVt = sKt + 128 * 136;
    {
        uint4 kq[4], vq[4];
#pragma unroll
        for (int i = 0; i < 4; ++i) {
            const int cidx = tid + NTHREADS * i, row = cidx >> 4, ch = cidx & 15;
            kq[i] = *(const uint4*)(KB + (size_t)(m0 + row) * 512 + h * 128 + ch * 8);
            vq[i] = *(const uint4*)(VBT + (size_t)row * len + ch * 8);
        }
#pragma unroll
        for (int i = 0; i < 4; ++i) {
            const int cidx = tid + NTHREADS * i, row = cidx >> 4, ch = cidx & 15;
            *(uint4*)(sKt + row * 136 + ch * 8) = kq[i];
            *(uint4*)(sVt + row * 136 + ch * 8) = vq[i];
        }
    }
    const int sd = (tid >> 7) & 1, ss = tid & 127;
    if (tid < 256) {
        const int chain_d = (b * 4 + h) * 2 + sd;
        const int pc_d = (sd ? nseg - 1 - oc : oc) + (isctx ? 0 : 2);
        sI[tid] = P.gates[(size_t)(m0 + ss) * 16 + sd * 8 + h];
        sB[tid] = P.gb[(size_t)(chain_d * 34 + pc_d) * 128 + ss];
        sX[tid] = P.gx[(size_t)(chain_d * 34 + pc_d) * 128 + ss];
    }
    __syncthreads();
    const int t = wave * 16 + l15;
    s16x8 qf[4];
#pragma unroll
    for (int ks = 0; ks < 4; ++ks) qf[ks] = as_frag(*(const uint4*)(QB + (size_t)(m0 + t) * 512 + h * 128 + ks * 32 + quad * 8));
    float* sH = sX + 256;
    f32x4 hsum[8];
#pragma unroll 1
    for (int dir = 0; dir < 2; ++dir) {
        const int chain = (b * 4 + h) * 2 + dir;
        const int pc = (dir ? nseg - 1 - oc : oc) + (isctx ? 0 : 2);
        const float mst = P.mst[chain * 34 + pc];
        const float bt = sB[dir * 128 + t];
        const float mt = fmaxf(bt + mst, bt + sX[dir * 128 + t]);
        const float winter = __expf(bt + mst - mt);
        const u16* ST = P.slot[5] + (size_t)(chain * 34 + pc) * 16384;
        const float* NS = P.mnu + (size_t)(chain * 34 + pc) * 128;
        f32x4 acc[8];
#pragma unroll
        for (int et = 0; et < 8; ++et) {
            acc[et] = (f32x4){0.f, 0.f, 0.f, 0.f};
#pragma unroll
            for (int ks = 0; ks < 4; ++ks) {
                s16x8 a = as_frag(*(const uint4*)(ST + (et * 16 + l15) * 128 + ks * 32 + quad * 8));
                acc[et] = mfma16(a, qf[ks], acc[et]);
            }
            acc[et][0] *= winter; acc[et][1] *= winter; acc[et][2] *= winter; acc[et][3] *= winter;
        }
        float qn = 0.f;
#pragma unroll
        for (int ks = 0; ks < 4; ++ks) {
            const float* np = NS + ks * 32 + quad * 8;
#pragma unroll
            for (int q = 0; q < 8; ++q) qn += bf2f((u16)qf[ks][q]) * np[q];
        }
        qn += __shfl_xor(qn, 16); qn += __shfl_xor(qn, 32);
        float den = 0.f;
        for (int sb = 0; sb < 4; ++sb) {
            if (dir == 0 ? (2 * sb > wave) : (2 * sb + 1 < wave)) continue;
            float sv[2][4];
#pragma unroll
            for (int hh = 0; hh < 2; ++hh) {
                const int st = 2 * sb + hh;
                f32x4 a4 = (f32x4){0.f, 0.f, 0.f, 0.f};
#pragma unroll
                for (int ks = 0; ks < 4; ++ks) {
                    s16x8 a = as_frag(*(const uint4*)(sKt + (st * 16 + l15) * 136 + ks * 32 + quad * 8));
                    a4 = mfma16(a, qf[ks], a4);
                }
#pragma unroll
                for (int r = 0; r < 4; ++r) {
                    const int s = st * 16 + quad * 4 + r;
                    const bool valid = dir ? (s >= t) : (s <= t);
                    const float dv = valid ? __expf(bt - sB[dir * 128 + s] + sI[dir * 128 + s] - mt) : 0.f;
                    sv[hh][r] = a4[r] * dv; den += sv[hh][r];
                }
            }
            uint4 pb;
            pb.x = pack2(sv[0][0], sv[0][1]); pb.y = pack2(sv[0][2], sv[0][3]);
            pb.z = pack2(sv[1][0], sv[1][1]); pb.w = pack2(sv[1][2], sv[1][3]);
            const s16x8 bfrag = as_frag(pb);
#pragma unroll
            for (int et = 0; et < 8; ++et) {
                const u16* vr = sVt + (et * 16 + l15) * 136 + sb * 32 + quad * 4;
                uint2 lo = *(const uint2*)vr, hi = *(const uint2*)(vr + 16);
                acc[et] = mfma16(as_frag(make_uint4(lo.x, lo.y, hi.x, hi.y)), bfrag, acc[et]);
            }
        }
        den += __shfl_xor(den, 16); den += __shfl_xor(den, 32);
        den += winter * qn;
        const float hs = 1.f / fmaxf(fabsf(den), __expf(-mt));
#pragma unroll
        for (int et = 0; et < 8; ++et) {
#pragma unroll
            for (int r = 0; r < 4; ++r) {
                if (dir == 0) sH[(et * 4 + r) * NTHREADS + tid] = acc[et][r] * hs;
                else hsum[et][r] = sH[(et * 4 + r) * NTHREADS + tid] + acc[et][r] * hs;
            }
        }
    }
    float sq = 0.f;
#pragma unroll
    for (int et = 0; et < 8; ++et) sq += hsum[et][0] * hsum[et][0] + hsum[et][1] * hsum[et][1] + hsum[et][2] * hsum[et][2] + hsum[et][3] * hsum[et][3];
    sq += __shfl_xor(sq, 16); sq += __shfl_xor(sq, 32);
    const float rinv = rsqrtf(sq * (1.f / 128.f) + 1e-6f);
    const float* hn = P.in[11] + h * 128;
#pragma unroll
    for (int et = 0; et < 8; ++et) {
        const int e = et * 16 + quad * 4;
        uint2 ob = *(const uint2*)(OB + (size_t)(m0 + t) * 512 + h * 128 + e);
        float o0 = hsum[et][0] * rinv * hn[e + 0] * sigmoidf_(lo2f(ob.x));
        float o1 = hsum[et][1] * rinv * hn[e + 1] * sigmoidf_(hi2f(ob.x));
        float o2 = hsum[et][2] * rinv * hn[e + 2] * sigmoidf_(lo2f(ob.y));
        float o3 = hsum[et][3] * rinv * hn[e + 3] * sigmoidf_(hi2f(ob.y));
        uint2 q; q.x = pack2(o0, o1); q.y = pack2(o2, o3);
        *(uint2*)(CAT + (size_t)(m0 + t) * 1024 + 512 + h * 128 + e) = q;
    }
}

constexpr int TB = 32;
constexpr int SBUF = 6 * TB * 64 + 2 * TB;
#define DPP4(ctrl) asm volatile( \
    "v_add_f32_dpp %0, %0, %0 " ctrl " row_mask:0xf bank_mask:0xf bound_ctrl:1\n" \
    "v_add_f32_dpp %1, %1, %1 " ctrl " row_mask:0xf bank_mask:0xf bound_ctrl:1\n" \
    "v_add_f32_dpp %2, %2, %2 " ctrl " row_mask:0xf bank_mask:0xf bound_ctrl:1\n" \
    "v_add_f32_dpp %3, %3, %3 " ctrl " row_mask:0xf bank_mask:0xf bound_ctrl:1\n" \
    : "+v"(sa0), "+v"(sa1), "+v"(sw0), "+v"(sw1))
typedef float v2f __attribute__((ext_vector_type(2)));
__device__ __forceinline__ v2f pkfma(v2f a, v2f b, v2f c) { return __builtin_elementwise_fma(a, b, c); }

__device__ __forceinline__ void phase_scan(const Params& P, char* smem) {
    const int tid = get_tid(), lane = tid & 63, wave = tid >> 6;
    float* sBuf = (float*)smem;
    float* sYb = sBuf + 2 * SBUF;
    const u16* R = P.slot[1]; const u16* K = P.slot[2]; const u16* V = P.slot[3];
    constexpr int NBLK = 8 + 128;
    for (int chain = blockIdx.x; chain < 256; chain += gridDim.x) {
        const int z = chain & 1, hd = (chain >> 1) & 15, b = chain >> 5;
        u16* EY = z ? P.slot[5] : P.slot[4];
        const u8* AZ = (const u8*)P.slot[0] + (size_t)z * MA * 1024;
        const int ptid = tid & 255;
        const int scg = ptid & 15, sn = hd * 64 + scg * 4;
        const float4 kk4 = *(const float4*)(P.in[23] + sn), ka4 = *(const float4*)(P.in[24] + sn), rk4 = *(const float4*)(P.in[25] + sn);
        const float kkv[4] = {kk4.x, kk4.y, kk4.z, kk4.w}, kav[4] = {ka4.x, ka4.y, ka4.z, ka4.w}, rkv[4] = {rk4.x, rk4.y, rk4.z, rk4.w};
        const int rg = lane >> 3, cgq = lane & 7, row0 = (wave & 3) * 16 + rg * 2;
        v2f S[2][4];
#pragma unroll
        for (int i = 0; i < 2; ++i)
#pragma unroll
            for (int j = 0; j < 4; ++j) S[i][j] = (v2f){0.f, 0.f};
        __syncthreads();
        for (int it = 0; it < NBLK + 2; ++it) {
            if (wave >= 4) {
                if (it < NBLK) {
                    const bool lat = it >= 8;
                    const int len = lat ? 4096 : 256;
                    float* sb = sBuf + (it & 1) * SBUF;
#pragma unroll
                    for (int half = 0; half < 2; ++half) {
                        const int sp = (ptid >> 4) + 16 * half;
                        const int pos = (lat ? it - 8 : it) * TB + sp;
                        const int tok = z ? len - 1 - pos : pos;
                        const int m = lat ? b * 4096 + tok : ML + b * 256 + tok;
                        const size_t o = (size_t)m * 1024 + sn;
                        const uint2 r2 = *(const uint2*)(R + o), k2 = *(const uint2*)(K + o), v2 = *(const uint2*)(V + o), e2 = *(const uint2*)(EY + o);
                        const unsigned a4 = *(const unsigned*)(AZ + o);
                        const float kn = P.knorm[(size_t)m * 16 + hd];
                        const float rv[4] = {lo2f(r2.x), hi2f(r2.x), lo2f(r2.y), hi2f(r2.y)};
                        const float kv[4] = {lo2f(k2.x), hi2f(k2.x), lo2f(k2.y), hi2f(k2.y)};
                        const float vv[4] = {lo2f(v2.x), hi2f(v2.x), lo2f(v2.y), hi2f(v2.y)};
                        const float ev[4] = {lo2f(e2.x), hi2f(e2.x), lo2f(e2.y), hi2f(e2.y)};
                        float dec[4], an[4], bb[4], kd[4], wr[4];
                        float br = 0.f, kr = 0.f, cf = 0.f;
#pragma unroll
                        for (int q = 0; q < 4; ++q) {
                            const float a = (float)((a4 >> (8 * q)) & 255u) * (1.f / 255.f);
                            const float kkn = kv[q] * kkv[q] * kn;
                            an[q] = -kkn; bb[q] = kkn * a;
                            kd[q] = kv[q] * (1.f + (a - 1.f) * kav[q]);
                            dec[q] = __expf(-ev[q]);
                            wr[q] = dec[q] * rv[q];
                            br += bb[q] * rv[q]; kr += kd[q] * rv[q]; cf += rv[q] * kd[q] * rkv[q];
                        }
                        br = sum16(br); kr = sum16(kr); cf = sum16(cf);
                        const int lo = sp * 64 + scg * 4;
                        *(float4*)(sb + 0 * TB * 64 + lo) = make_float4(dec[0], dec[1], dec[2], dec[3]);
                        *(float4*)(sb + 1 * TB * 64 + lo) = make_float4(an[0], an[1], an[2], an[3]);
                        *(float4*)(sb + 2 * TB * 64 + lo) = make_float4(bb[0], bb[1], bb[2], bb[3]);
                        *(float4*)(sb + 3 * TB * 64 + lo) = make_float4(kd[0], kd[1], kd[2], kd[3]);
                        *(float4*)(sb + 4 * TB * 64 + lo) = make_float4(wr[0], wr[1], wr[2], wr[3]);
                        *(float4*)(sb + 5 * TB * 64 + lo) = make_float4(vv[0], vv[1], vv[2], vv[3]);
                        if (scg == 0) {
                            sb[6 * TB * 64 + sp] = br; sb[6 * TB * 64 + TB + sp] = kr;
                            if (lat) P.coef[(size_t)z * ML * 16 + (size_t)m * 16 + hd] = cf;
                        }
                    }
                }
                if (it >= 10) {
                    const int jb = it - 2;
                    const int sp = ptid >> 3, c8 = (ptid & 7) * 8;
                    const int pos = (jb - 8) * TB + sp;
                    const int tok = z ? 4095 - pos : pos;
                    const float* yb = sYb + (jb & 1) * TB * 64 + sp * 64 + c8;
                    const float4 y0 = *(const float4*)yb, y1 = *(const float4*)(yb + 4);
                    uint4 q; q.x = pack2(y0.x, y0.y); q.y = pack2(y0.z, y0.w); q.z = pack2(y1.x, y1.y); q.w = pack2(y1.z, y1.w);
                    *(uint4*)(EY + (size_t)(b * 4096 + tok) * 1024 + hd * 64 + c8) = q;
                }
            } else if (it >= 1 && it <= NBLK) {
                const int jb = it - 1;
                const bool lat = jb >= 8;
                const float* sb = sBuf + (jb & 1) * SBUF;
                float* sy = sYb + (jb & 1) * TB * 64;
                struct StepP { float4 dA, dB, aA, aB, bA, bB, kA, kB, wA, wB; float2 v2; float br, kr; };
#define LOADP(X, p_) do { const float* pp = sb + (p_) * 64 + cgq * 8; \
                    X.dA = *(const float4*)(pp + 0 * TB * 64); X.dB = *(const float4*)(pp + 0 * TB * 64 + 4); \
                    X.aA = *(const float4*)(pp + 1 * TB * 64); X.aB = *(const float4*)(pp + 1 * TB * 64 + 4); \
                    X.bA = *(const float4*)(pp + 2 * TB * 64); X.bB = *(const float4*)(pp + 2 * TB * 64 + 4); \
                    X.kA = *(const float4*)(pp + 3 * TB * 64); X.kB = *(const float4*)(pp + 3 * TB * 64 + 4); \
                    X.wA = *(const float4*)(pp + 4 * TB * 64); X.wB = *(const float4*)(pp + 4 * TB * 64 + 4); \
                    X.v2 = *(const float2*)(sb + 5 * TB * 64 + (p_) * 64 + row0); \
                    X.br = sb[6 * TB * 64 + (p_)]; X.kr = sb[6 * TB * 64 + TB + (p_)]; } while (0)
                __builtin_amdgcn_s_setprio(3);
                StepP cur, nxt;
                LOADP(cur, 0);
                nxt = cur;
#pragma unroll 8
                for (int p = 0; p < TB; ++p) {
                    LOADP(nxt, p + 1);
                    const float4 dA = cur.dA, dB = cur.dB, aA = cur.aA, aB = cur.aB, bA = cur.bA, bB = cur.bB, kA = cur.kA, kB = cur.kB, wA = cur.wA, wB = cur.wB;
                    const float2 v2 = cur.v2; const float br = cur.br, kr = cur.kr;
                    const v2f d2[4] = {{dA.x, dA.y}, {dA.z, dA.w}, {dB.x, dB.y}, {dB.z, dB.w}};
                    const v2f a2[4] = {{aA.x, aA.y}, {aA.z, aA.w}, {aB.x, aB.y}, {aB.z, aB.w}};
                    const v2f b2[4] = {{bA.x, bA.y}, {bA.z, bA.w}, {bB.x, bB.y}, {bB.z, bB.w}};
                    const v2f k2[4] = {{kA.x, kA.y}, {kA.z, kA.w}, {kB.x, kB.y}, {kB.z, kB.w}};
                    const v2f w2[4] = {{wA.x, wA.y}, {wA.z, wA.w}, {wB.x, wB.y}, {wB.z, wB.w}};
                    v2f t0 = S[0][0] * a2[0], t1 = S[1][0] * a2[0], u0 = S[0][0] * w2[0], u1 = S[1][0] * w2[0];
#pragma unroll
                    for (int q = 1; q < 4; ++q) {
                        t0 = pkfma(S[0][q], a2[q], t0); t1 = pkfma(S[1][q], a2[q], t1);
                        u0 = pkfma(S[0][q], w2[q], u0); u1 = pkfma(S[1][q], w2[q], u1);
                    }
                    float sa0 = t0.x + t0.y, sa1 = t1.x + t1.y, sw0 = u0.x + u0.y, sw1 = u1.x + u1.y;
                    asm volatile("s_nop 1" ::: );
                    DPP4("quad_perm:[1,0,3,2]");
                    DPP4("quad_perm:[2,3,0,1]");
                    DPP4("row_half_mirror");
                    const v2f va = {v2.x, v2.x}, vb = {v2.y, v2.y}, s0 = {sa0, sa0}, s1 = {sa1, sa1};
#pragma unroll
                    for (int q = 0; q < 4; ++q) {
                        S[0][q] = pkfma(S[0][q], d2[q], pkfma(s0, b2[q], va * k2[q]));
                        S[1][q] = pkfma(S[1][q], d2[q], pkfma(s1, b2[q], vb * k2[q]));
                    }
                    *(float2*)(sy + p * 64 + row0) = make_float2(sw0 + sa0 * br + v2.x * kr, sw1 + sa1 * br + v2.y * kr);
                    cur = nxt;
                }
#undef LOADP
                __builtin_amdgcn_s_setprio(0);
            }
            __syncthreads();
        }
    }
}

__device__ __forceinline__ void phase_z(const Params& P) {
    const int lane = get_tid() & 63, wave = get_tid() >> 6;
    const int n0 = lane * 16, hd = lane >> 2;
    float lw[16], lb[16];
#pragma unroll
    for (int q = 0; q < 16; ++q) { lw[q] = P.in[26][n0 + q]; lb[q] = P.in[27][n0 + q]; }
    const u16* __restrict__ YF = P.slot[4]; const u16* __restrict__ YB = P.slot[5]; const u16* __restrict__ V = P.slot[3]; const u16* __restrict__ G = P.slot[2];
    u16* __restrict__ Z = P.slot[1];
    const float* __restrict__ coefp = P.coef;
#pragma unroll 4
    for (int m = blockIdx.x * 8 + wave; m < ML; m += gridDim.x * 8) {
        const size_t o = (size_t)m * 1024 + n0;
        const uint4 f0 = *(const uint4*)(YF + o), f1 = *(const uint4*)(YF + o + 8);
        const uint4 b0 = *(const uint4*)(YB + o), b1 = *(const uint4*)(YB + o + 8);
        const uint4 v0 = *(const uint4*)(V + o), v1 = *(const uint4*)(V + o + 8);
        const uint4 g0 = *(const uint4*)(G + o), g1 = *(const uint4*)(G + o + 8);
        const float cf = coefp[(size_t)m * 16 + hd] + coefp[(size_t)ML * 16 + (size_t)m * 16 + hd];
        const unsigned fw[8] = {f0.x, f0.y, f0.z, f0.w, f1.x, f1.y, f1.z, f1.w};
        const unsigned bw[8] = {b0.x, b0.y, b0.z, b0.w, b1.x, b1.y, b1.z, b1.w};
        const unsigned vw[8] = {v0.x, v0.y, v0.z, v0.w, v1.x, v1.y, v1.z, v1.w};
        const unsigned gw[8] = {g0.x, g0.y, g0.z, g0.w, g1.x, g1.y, g1.z, g1.w};
        float y[16], s = 0.f;
#pragma unroll
        for (int q = 0; q < 8; ++q) {
            y[2 * q] = lo2f(fw[q]) + lo2f(bw[q]); y[2 * q + 1] = hi2f(fw[q]) + hi2f(bw[q]);
            s += y[2 * q] + y[2 * q + 1];
        }
        s += dppf<0xB1>(s); s += dppf<0x4E>(s);
        const float mean = s * (1.f / 64.f);
        float vs = 0.f;
#pragma unroll
        for (int q = 0; q < 16; ++q) { const float d = y[q] - mean; vs += d * d; }
        vs += dppf<0xB1>(vs); vs += dppf<0x4E>(vs);
        const float rinv = rsqrtf(vs * (1.f / 64.f) + 64e-5f);
        unsigned ow[8];
#pragma unroll
        for (int q = 0; q < 8; ++q) {
            const float z0 = ((y[2 * q] - mean) * rinv * lw[2 * q] + lb[2 * q] + cf * lo2f(vw[q])) * lo2f(gw[q]);
            const float z1 = ((y[2 * q + 1] - mean) * rinv * lw[2 * q + 1] + lb[2 * q + 1] + cf * hi2f(vw[q])) * hi2f(gw[q]);
            ow[q] = pack2(z0, z1);
        }
        *(uint4*)(Z + o) = make_uint4(ow[0], ow[1], ow[2], ow[3]);
        *(uint4*)(Z + o + 8) = make_uint4(ow[4], ow[5], ow[6], ow[7]);
    }
}

__device__ __forceinline__ void do_phase(const Params& P, const int ph, char* smem) {
        switch (ph) {
        case 0: phase_prep(P, smem); break;
        case 1: phase_norm(P, 0, P.slot[0], MA); break;
        case 2: { Epi E{E_INPROJ, 0, 0, nullptr, 0}; gemm_single(P, P.slot[0], 1024, P.wint, 1024, 15, MA / BM, E, smem); } break;
        case 3: phase_mix0(P, smem); break;
        case 4: phase_mlscan(P); break;
        case 5: for (int u = blockIdx.x; u < 8 * 4 * 34; u += gridDim.x) ml_c3_unit(P, u / 136, (u / 34) & 3, u % 34, smem); break;
        case 6: { Epi E{E_OUT0, 0, 0, nullptr, 0}; gemm_single(P, P.slot[0], 1024, P.woutt, 1024, 4, MA / BM, E, smem); } break;
        case 7: phase_norm(P, 1, P.slot[0], MA); break;
        case 8: { Epi E{E_MLPUP, 0, 0, P.slot[1], 4096}; gemm_single(P, P.slot[0], 1024, P.w1t[0], 1024, 16, MA / BM, E, smem); } break;
        case 9: phase_mlpdn0(P, smem); break;
        case 10: phase_norm(P, 2, P.slot[0], MA); break;
        case 11: phase_rw1(P, smem); break;
        case 12: phase_rw2(P, smem); break;
        case 13: phase_scan(P, smem); break;
        case 14: { Epi E{E_HA, 1, 0, P.slot[2], 1024}; gemm_single(P, P.hg, 192, P.lg2t, 192, 4, ML / BM, E, smem); } break;
        case 19: phase_z(P); break;
        case 15: { Epi E{E_RWOUT, 1, 0, nullptr, 0}; gemm_single(P, P.slot[1], 1024, P.wot, 1024, 4, ML / BM, E, smem); } break;
        case 16: phase_norm(P, 3, P.slot[0], ML); break;
        case 17: { Epi E{E_MLPUP, 1, 0, P.slot[1], 4096}; gemm_single(P, P.slot[0], 1024, P.w1t[1], 1024, 16, ML / BM, E, smem); } break;
        case 18: { Epi E{E_MLPDN, 1, 0, nullptr, 0}; gemm_single(P, P.slot[1], 4096, P.w2t[1], 4096, 4, ML / BM, E, smem); } break;
        default: break;
        }
}

__global__ void __launch_bounds__(NTHREADS) mega(Params P) {
    extern __shared__ __align__(16) char smem[];
#if ONE_LAUNCH
    cg::grid_group grid = cg::this_grid();
    __shared__ unsigned xb_words[4];
    if (threadIdx.x == 0) { xb_words[0] = 0u; xb_words[1] = 0u; }
    __syncthreads();
    const XcdBarrier xb = xcd_barrier_post(P.bar, (volatile LAS unsigned*)&xb_words);
#define PH(n) do_phase(P, n, smem); xcd_barrier(xb);
    do_phase(P, 0, smem); grid.sync();
    PH(1) PH(2) PH(3) PH(4) PH(5) PH(6) PH(7) PH(8) PH(9) PH(10) PH(11) PH(12) PH(13) PH(14) PH(19) PH(15) PH(16) PH(17)
    do_phase(P, 18, smem);
#undef PH
#else
    do_phase(P, P.ph_lo, smem);
#endif
}

extern "C" void kernel_launch(void* const* d_in, const int* in_sizes, int n_in, void* d_out, int out_size, void* d_ws, size_t ws_size,
                              hipStream_t stream) {
    static int grid = 0;
    if (grid == 0) {
        int dev = 0, cus = 0, per_cu = 0;
        hipGetDevice(&dev);
        hipDeviceGetAttribute(&cus, hipDeviceAttributeMultiprocessorCount, dev);
        hipFuncSetAttribute((const void*)mega, hipFuncAttributeMaxDynamicSharedMemorySize, LDS_BYTES);
        hipOccupancyMaxActiveBlocksPerMultiprocessor(&per_cu, (const void*)mega, NTHREADS, LDS_BYTES);
        if (per_cu < 1) { fprintf(stderr, "occupancy query says %d blocks/CU\n", per_cu); per_cu = 1; }
        grid = cus;
        if (grid <= 0) grid = 256;
    }
    Params P{};
    for (int i = 0; i < 31; ++i) P.in[i] = (const float*)d_in[i];
    P.out = (float*)d_out;
    char* w = (char*)d_ws;
    size_t off = 0;
    auto take = [&](size_t bytes) { char* p = w + off; off += (bytes + 255) & ~(size_t)255; return p; };
    for (int i = 0; i < 6; ++i) P.slot[i] = (u16*)take(SLOT);
    P.w1t[1] = (u16*)take((size_t)4096 * 1024 * 2);
    P.w2t[1] = (u16*)take((size_t)4096 * 1024 * 2);
    P.rkvt = (u16*)take((size_t)3 * 1024 * 1024 * 2);
    P.wot = (u16*)take((size_t)1024 * 1024 * 2);
    P.lw1t = (u16*)take(256 * 1024 * 2);
    P.la1t = (u16*)take(256 * 1024 * 2);
    P.lg1t = (u16*)take(256 * 1024 * 2);
    P.lw2t = (u16*)take(2 * 1024 * 64 * 2);
    P.la2t = (u16*)take(2 * 1024 * 64 * 2);
    P.lg2t = (u16*)take(1024 * 192 * 2);
    P.bar = (unsigned*)take(XCD_BAR_WORDS * 4);
    P.mod = (float*)take(2 * 9 * 6144 * 4);
    P.ropec = (float*)take(64 * 32 * 4);
    P.ropes = (float*)take(64 * 32 * 4);
    const size_t ov = off;
    P.wint = (u16*)take((size_t)3840 * 1024 * 2);
    P.woutt = (u16*)take((size_t)1024 * 1024 * 2);
    P.w1t[0] = (u16*)take((size_t)4096 * 1024 * 2);
    P.w2t[0] = (u16*)take((size_t)4096 * 1024 * 2);
    P.gates = (float*)take((size_t)MA * 16 * 4);
    P.ctxres = (float*)take((size_t)MC * 1024 * 4);
    P.mbc = (float*)take(64 * 34 * 4);
    P.mmc = (float*)take(64 * 34 * 4);
    P.mst = (float*)take(64 * 34 * 4);
    P.mnu = (float*)take((size_t)64 * 34 * 128 * 4);
    P.gb = (float*)take((size_t)64 * 34 * 128 * 4);
    P.gx = (float*)take((size_t)64 * 34 * 128 * 4);
    const size_t end0 = off;
    off = ov;
    P.knorm = (float*)take((size_t)MA * 16 * 4);
    P.coef = (float*)take((size_t)2 * ML * 16 * 4);
    P.hw = (u16*)take((size_t)MA * 128 * 2);
    P.ha = (u16*)take((size_t)MA * 128 * 2);
    P.hg = (u16*)take((size_t)MA * 192 * 2);
    const size_t end1 = off;
    const size_t need = end0 > end1 ? end0 : end1;
    if (need > ws_size || n_in != 31) { fprintf(stderr, "kernel_launch: need %zu bytes of ws, have %zu (n_in %d)\n", need, ws_size, n_in); return; }
#if ONE_LAUNCH
    P.ph_lo = 0; P.ph_hi = NPHASES;
    if (hipMemsetAsync(P.bar, 0, XCD_BAR_WORDS * 4, stream) != hipSuccess) { fprintf(stderr, "barrier memset failed\n"); return; }
    void* args[] = {&P};
    hipError_t e = hipLaunchCooperativeKernel((const void*)mega, dim3(grid), dim3(NTHREADS), args, LDS_BYTES, stream);
    if (e != hipSuccess) fprintf(stderr, "cooperative launch failed: %s\n", hipGetErrorString(e));
#else
    for (int ph = 0; ph < NPHASES; ++ph) {
        P.ph_lo = ph; P.ph_hi = ph + 1;
        hipLaunchKernelGGL(mega, dim3(grid), dim3(NTHREADS), LDS_BYTES, stream, P);
    }
#endif
}
```

```cpp
#include <hip/hip_runtime.h>
#include <hip/hip_cooperative_groups.h>
#include <cstdio>
namespace cg = cooperative_groups;

#ifndef ONE_LAUNCH
#define ONE_LAUNCH 1
#endif

typedef unsigned short u16;
typedef unsigned char u8;
typedef __attribute__((ext_vector_type(8))) short s16x8;
typedef __attribute__((ext_vector_type(4))) float f32x4;

constexpr int D = 1024, NB = 8, T = 4096, CT = 256;
constexpr int ML = NB * T;
constexpr int MC = NB * CT;
constexpr int MA = ML + MC;
constexpr int NTHREADS = 512;
constexpr size_t SLOT = (size_t)MA * 1024 * 2;
constexpr size_t HALF = (size_t)MA * 512;
constexpr int LDS_BYTES = 147456;
constexpr int NPHASES = 19;

struct Params {
    const float* in[31];
    float* out;
    u16* slot[6];
    u16 *w1t[2], *w2t[2], *rkvt, *wot, *lw1t, *la1t, *lg1t, *lw2t, *la2t, *lg2t, *wint, *woutt;
    float *mod, *ropec, *ropes, *gates, *ctxres, *mbc, *mmc, *mst, *mnu, *knorm, *coef, *gb, *gx;
    u16 *hw, *ha, *hg;
    unsigned* bar;
    int ph_lo, ph_hi;
};

__device__ __forceinline__ int get_tid() { int t = (int)threadIdx.x; asm volatile("" : "+v"(t)); return t; }
__device__ __forceinline__ u16 f2bf(float f) { unsigned u = __float_as_uint(f); u += 0x7fffu + ((u >> 16) & 1u); return (u16)(u >> 16); }
__device__ __forceinline__ float bf2f(u16 h) { return __uint_as_float(((unsigned)h) << 16); }
typedef __bf16 hwbf16x2 __attribute__((ext_vector_type(2)));
typedef float hwf32x2 __attribute__((ext_vector_type(2)));
__device__ __forceinline__ unsigned pack2(float a, float b) {
    hwf32x2 v = {a, b};
    hwbf16x2 r = __builtin_convertvector(v, hwbf16x2);
    return __builtin_bit_cast(unsigned, r);
}
__device__ __forceinline__ float lo2f(unsigned u) { return __uint_as_float(u << 16); }
__device__ __forceinline__ float hi2f(unsigned u) { return __uint_as_float(u & 0xffff0000u); }
__device__ __forceinline__ s16x8 as_frag(uint4 v) { return __builtin_bit_cast(s16x8, v); }
__device__ __forceinline__ f32x4 mfma16(s16x8 a, s16x8 b, f32x4 c) { return __builtin_amdgcn_mfma_f32_16x16x32_bf16(a, b, c, 0, 0, 0); }
__device__ __forceinline__ float sigmoidf_(float x) { return 1.f / (1.f + __expf(-x)); }
__device__ __forceinline__ float wave_sum(float v) {
#pragma unroll
    for (int o = 1; o < 64; o <<= 1) v += __shfl_xor(v, o);
    return v;
}
template <int CTRL> __device__ __forceinline__ float dppf(float x) {
    return __int_as_float(__builtin_amdgcn_update_dpp(0, __float_as_int(x), CTRL, 0xf, 0xf, true));
}
__device__ __forceinline__ float sum16(float x) {
    x += dppf<0xB1>(x); x += dppf<0x4E>(x); x += dppf<0x141>(x); x += dppf<0x140>(x);
    return x;
}
__device__ __forceinline__ float* resptr(const Params& P, int m) {
    return m < ML ? P.out + (size_t)m * 1024 : P.ctxres + (size_t)(m - ML) * 1024;
}
__device__ __forceinline__ const float* modrow(const Params& P, int layer, int m) {
    return P.mod + (size_t)(layer * 9 + (m < ML ? (m >> 12) : 8)) * 6144;
}

#define XB_TMO      128
#define XB_XCNT(j)  (256  + 64 * (j))
#define XB_XSUB(j)  (1280 + 64 * (j))
#define XB_XGEN(j)  (2304 + 64 * (j))
#define XB_TOP      3328
#define XB_TOPGEN   3392
#define XCD_BAR_WORDS 3456
#define XB_SPIN_CAP (1u << 22)
#define LAS __attribute__((address_space(3)))

__device__ __forceinline__ unsigned xb_ld(unsigned* p)              { return __hip_atomic_load(p, __ATOMIC_RELAXED, __HIP_MEMORY_SCOPE_AGENT); }
__device__ __forceinline__ unsigned xb_add(unsigned* p, unsigned v) { return __hip_atomic_fetch_add(p, v, __ATOMIC_RELAXED, __HIP_MEMORY_SCOPE_AGENT); }
__device__ __forceinline__ unsigned xb_xcc_id() { return (unsigned)__builtin_amdgcn_s_getreg((3 << 11) | 20) & 0xFu; }
#define XB_SPIN(cond, bar) do { unsigned _sp = 0; while (cond) { __builtin_amdgcn_s_sleep(1); \
    if ((++_sp & 255u) == 0u) { if (xb_ld(&(bar)[XB_TMO])) break; if (_sp > XB_SPIN_CAP) { atomicAdd(&(bar)[XB_TMO], 1u); break; } } } } while (0)

struct XcdBarrier {
    unsigned* bar; unsigned x;
    volatile LAS unsigned* st;
};

__device__ __forceinline__ XcdBarrier xcd_barrier_post(unsigned* bar, volatile LAS unsigned* st) {
    XcdBarrier b; b.bar = bar; b.x = xb_xcc_id(); b.st = st;
    if (threadIdx.x == 0) (void)xb_add(&bar[XB_XCNT(b.x)], 1u);
    return b;
}
__device__ __forceinline__ void xcd_barrier_complete(unsigned* bar, unsigned x, unsigned& nloc, unsigned& nx) {
    const unsigned G = gridDim.x * gridDim.y * gridDim.z;
    unsigned sum, cnt, mine, sp = 0u;
    for (;;) {
        sum = 0u; cnt = 0u; mine = 0u;
#pragma unroll
        for (unsigned j = 0; j < 16; ++j) { const unsigned c = xb_ld(&bar[XB_XCNT(j)]); sum += c; cnt += (c > 0u) ? 1u : 0u; mine = (j == x) ? c : mine; }
        if (sum == G) break;
        __builtin_amdgcn_s_sleep(1);
        if ((++sp & 255u) == 0u) { if (xb_ld(&bar[XB_TMO])) break; if (sp > XB_SPIN_CAP) { atomicAdd(&bar[XB_TMO], 1u); break; } }
    }
    nloc = mine > 0u ? mine : 1u; nx = cnt > 0u ? cnt : 1u;
}

__device__ __forceinline__ void xcd_barrier(const XcdBarrier& b) {
    asm volatile("s_waitcnt vmcnt(0)" ::: "memory");
    __syncthreads();
    if (threadIdx.x == 0) {
        unsigned* bar = b.bar;
        __builtin_amdgcn_s_waitcnt(0);
        unsigned nloc = b.st[0], nx = b.st[1];
        if (nloc == 0u) { xcd_barrier_complete(bar, b.x, nloc, nx); b.st[0] = nloc; b.st[1] = nx; }
        const unsigned old = xb_add(&bar[XB_XSUB(b.x)], 1u);
        const unsigned gen = old / nloc;
        if (old + 1u == (gen + 1u) * nloc) {
            __builtin_amdgcn_fence(__ATOMIC_RELEASE, "agent");
            asm volatile("s_waitcnt vmcnt(0)" ::: "memory");
            const unsigned og = xb_add(&bar[XB_TOP], 1u);
            const unsigned tg = og / nx;
            if (og + 1u == (tg + 1u) * nx) xb_add(&bar[XB_TOPGEN], 1u);
            else XB_SPIN(xb_ld(&bar[XB_TOPGEN]) == tg, bar);
            __builtin_amdgcn_fence(__ATOMIC_ACQUIRE, "agent");
            xb_add(&bar[XB_XGEN(b.x)], 1u);
            asm volatile("s_waitcnt vmcnt(0)" ::: "memory");
        } else {
            XB_SPIN(xb_ld(&bar[XB_XGEN(b.x)]) == gen, bar);
            __builtin_amdgcn_fence(__ATOMIC_ACQUIRE, "agent");
            asm volatile("s_waitcnt vmcnt(0)" ::: "memory");
        }
    }
    __syncthreads();
}

struct TJob { const float* src; u16* dst; int K, N, Kpad, Npad; };
__device__ __forceinline__ bool get_tjob(const Params& P, int j, TJob& t) {
    switch (j) {
    case 0: t = {P.in[6], P.wint, 1024, 3600, 1024, 3840}; return true;
    case 1: t = {P.in[12], P.woutt, 1024, 1024, 1024, 1024}; return true;
    case 2: t = {P.in[29], P.w1t[0], 1024, 4096, 1024, 4096}; return true;
    case 3: t = {P.in[29] + (size_t)1024 * 4096, P.w1t[1], 1024, 4096, 1024, 4096}; return true;
    case 4: t = {P.in[30], P.w2t[0], 4096, 1024, 4096, 1024}; return true;
    case 5: t = {P.in[30] + (size_t)1024 * 4096, P.w2t[1], 4096, 1024, 4096, 1024}; return true;
    case 6: t = {P.in[14], P.rkvt, 1024, 1024, 1024, 1024}; return true;
    case 7: t = {P.in[14] + (size_t)1024 * 1024, P.rkvt + (size_t)1024 * 1024, 1024, 1024, 1024, 1024}; return true;
    case 8: t = {P.in[14] + (size_t)2 * 1024 * 1024, P.rkvt + (size_t)2 * 1024 * 1024, 1024, 1024, 1024, 1024}; return true;
    case 9: t = {P.in[28], P.wot, 1024, 1024, 1024, 1024}; return true;
    case 10: t = {P.in[16], P.lw1t, 1024, 64, 1024, 64}; return true;
    case 11: t = {P.in[16] + 1024 * 64, P.lw1t + 64 * 1024, 1024, 64, 1024, 64}; return true;
    case 12: t = {P.in[19], P.la1t, 1024, 64, 1024, 64}; return true;
    case 13: t = {P.in[19] + 1024 * 64, P.la1t + 64 * 1024, 1024, 64, 1024, 64}; return true;
    case 14: t = {P.in[21], P.lg1t, 1024, 160, 1024, 256}; return true;
    case 15: t = {P.in[17], P.lw2t, 64, 1024, 64, 1024}; return true;
    case 16: t = {P.in[17] + 64 * 1024, P.lw2t + 1024 * 64, 64, 1024, 64, 1024}; return true;
    case 17: t = {P.in[20], P.la2t, 64, 1024, 64, 1024}; return true;
    case 18: t = {P.in[20] + 64 * 1024, P.la2t + 1024 * 64, 64, 1024, 64, 1024}; return true;
    case 19: t = {P.in[22], P.lg2t, 160, 1024, 192, 1024}; return true;
    default: return false;
    }
}

__device__ __forceinline__ void phase_prep(const Params& P, char* smem) {
    const int tid = get_tid(), lane = tid & 63, wave = tid >> 6;
    float* tile = (float*)smem;
    int ubase = 0;
    for (int j = 0; j < 20; ++j) {
        TJob t; get_tjob(P, j, t);
        const int kt = t.Kpad / 64, nt = t.Npad / 64, nu = kt * nt;
        int first = ((int)blockIdx.x - (ubase % (int)gridDim.x) + (int)gridDim.x) % (int)gridDim.x;
        for (int lu = first; lu < nu; lu += gridDim.x) {
            const int k0 = (lu % kt) * 64, n0 = (lu / kt) * 64;
            __syncthreads();
#pragma unroll
            for (int i = 0; i < 2; ++i) {
                int kr = (tid >> 4) + 32 * i, nc = (tid & 15) * 4;
                int k = k0 + kr, n = n0 + nc;
                float4 v = make_float4(0.f, 0.f, 0.f, 0.f);
                if (k < t.K && n < t.N) v = *(const float4*)(t.src + (size_t)k * t.N + n);
                tile[kr * 65 + nc + 0] = v.x; tile[kr * 65 + nc + 1] = v.y; tile[kr * 65 + nc + 2] = v.z; tile[kr * 65 + nc + 3] = v.w;
            }
            __syncthreads();
            {
                int n = tid >> 3, kc = (tid & 7) * 8;
                uint4 o;
                o.x = pack2(tile[(kc + 0) * 65 + n], tile[(kc + 1) * 65 + n]);
                o.y = pack2(tile[(kc + 2) * 65 + n], tile[(kc + 3) * 65 + n]);
                o.z = pack2(tile[(kc + 4) * 65 + n], tile[(kc + 5) * 65 + n]);
                o.w = pack2(tile[(kc + 6) * 65 + n], tile[(kc + 7) * 65 + n]);
                *(uint4*)(t.dst + (size_t)(n0 + n) * t.Kpad + k0 + kc) = o;
            }
        }
        ubase += nu;
    }
    if (blockIdx.x == 0) {
        for (int e = tid; e < 64 * 32; e += NTHREADS) {
            int pos = e >> 5, f = e & 31;
            float inv = powf(10000.f, -(float)f / 32.f);
            float ang = (float)pos * inv;
            P.ropec[e] = cosf(ang); P.ropes[e] = sinf(ang);
        }
    }
    const float* c = P.in[1]; const float* cctx = P.in[3];
    float* sSilu = (float*)smem + 64 * 65 + 3;
    __syncthreads();
    for (int e = tid; e < 9 * 1024; e += NTHREADS) {
        const int r = e >> 10, k = e & 1023;
        const float cv = (r < 8) ? c[r * 1024 + k] : cctx[k];
        sSilu[e] = cv / (1.f + __expf(-cv));
    }
    __syncthreads();
    for (int u = blockIdx.x + gridDim.x * wave; u < 2 * 384; u += gridDim.x * 8) {
        const int l = u / 384, n0 = (u % 384) * 16;
        const int ksub = lane >> 2, nq = lane & 3;
        const float* W = P.in[4] + (size_t)l * 1024 * 6144 + n0 + nq * 4;
        float acc[9][4];
#pragma unroll
        for (int r = 0; r < 9; ++r) { acc[r][0] = acc[r][1] = acc[r][2] = acc[r][3] = 0.f; }
        for (int it0 = 0; it0 < 64; it0 += 16) {
            float4 w[16];
#pragma unroll
            for (int j = 0; j < 16; ++j) w[j] = *(const float4*)(W + (size_t)((it0 + j) * 16 + ksub) * 6144);
#pragma unroll
            for (int j = 0; j < 16; ++j) {
                const int k = (it0 + j) * 16 + ksub;
#pragma unroll
                for (int r = 0; r < 9; ++r) {
                    const float cv = sSilu[r * 1024 + k];
                    acc[r][0] += cv * w[j].x; acc[r][1] += cv * w[j].y; acc[r][2] += cv * w[j].z; acc[r][3] += cv * w[j].w;
                }
            }
        }
#pragma unroll
        for (int r = 0; r < 9; ++r)
#pragma unroll
            for (int q = 0; q < 4; ++q) {
                float v = acc[r][q];
                v += __shfl_xor(v, 4); v += __shfl_xor(v, 8); v += __shfl_xor(v, 16); v += __shfl_xor(v, 32);
                acc[r][q] = v;
            }
        if (ksub == 0) {
#pragma unroll
            for (int r = 0; r < 9; ++r)
#pragma unroll
                for (int q = 0; q < 4; ++q) {
                    int n = n0 + nq * 4 + q;
                    P.mod[(size_t)(l * 9 + r) * 6144 + n] = acc[r][q] + P.in[5][l * 6144 + n];
                }
        }
    }
}

__device__ __forceinline__ void phase_norm(const Params& P, int which, u16* dst, int nrows) {
    const int lane = get_tid() & 63, wave = get_tid() >> 6;
    const int layer = which >> 1, shc = (which & 1) ? 3 : 0;
    constexpr int RB = 4;
    const int nwaves = gridDim.x * 8;
    for (int mbase = (blockIdx.x * 8 + wave) * RB; mbase < nrows; mbase += nwaves * RB) {
        float4 v[RB][4];
        float ss[RB];
#pragma unroll
        for (int q = 0; q < RB; ++q) {
            const int m = mbase + q;
            const float* src;
            if (which == 0) src = (m < ML) ? P.in[0] + (size_t)m * 1024 : P.in[2] + (size_t)(m - ML) * 1024;
            else src = resptr(P, m);
#pragma unroll
            for (int i = 0; i < 4; ++i) {
                const f32x4 t = __builtin_nontemporal_load((const f32x4*)src + lane + 64 * i);
                v[q][i] = make_float4(t[0], t[1], t[2], t[3]);
            }
        }
#pragma unroll
        for (int q = 0; q < RB; ++q) {
            float s = 0.f;
#pragma unroll
            for (int i = 0; i < 4; ++i) s += v[q][i].x * v[q][i].x + v[q][i].y * v[q][i].y + v[q][i].z * v[q][i].z + v[q][i].w * v[q][i].w;
            s = sum16(s);
            s += __shfl_xor(s, 16); s += __shfl_xor(s, 32);
            ss[q] = rsqrtf(s * (1.f / 1024.f) + 1e-6f);
        }
#pragma unroll
        for (int q = 0; q < RB; ++q) {
            const int m = mbase + q;
            const float* mr = modrow(P, layer, m);
            const float rinv = ss[q];
#pragma unroll
            for (int i = 0; i < 4; ++i) {
                const int col = (lane + 64 * i) * 4;
                float4 sh = *(const float4*)(mr + shc * 1024 + col);
                float4 sc = *(const float4*)(mr + (shc + 1) * 1024 + col);
                uint2 o;
                o.x = pack2(v[q][i].x * rinv * (1.f + sc.x) + sh.x, v[q][i].y * rinv * (1.f + sc.y) + sh.y);
                o.y = pack2(v[q][i].z * rinv * (1.f + sc.z) + sh.z, v[q][i].w * rinv * (1.f + sc.w) + sh.w);
                *(uint2*)(dst + (size_t)m * 1024 + col) = o;
            }
        }
    }
}

constexpr int BM = 256, BN = 256, BK = 64, LDK = 72;
enum { E_MLPDN_AT = 100, E_INPROJ = 1, E_OUT0, E_MLPUP, E_MLPDN, E_R, E_K, E_V, E_HW, E_HA, E_HG, E_E, E_A, E_GZ, E_RWOUT };

struct Epi {
    int mode, layer, z;
    u16* o16;
    int ldo;
};

__device__ __forceinline__ void epilogue(const Params& P, const Epi& E, int mb, int nb, f32x4 (&acc)[4][4], int lane) {
    const int quad = lane >> 4, l15 = lane & 15;
    switch (E.mode) {
    case E_INPROJ: {
        const int region = nb >> 9;
        if (region <= 1) {
            const float* nw = P.in[region == 0 ? 8 : 9];
            const float scale = region == 0 ? 0.125f : 1.f;
            u16* dst = P.slot[1] + (region == 0 ? 0 : HALF);
            const int cb = nb & 511;
#pragma unroll
            for (int i = 0; i < 4; ++i)
#pragma unroll
                for (int r = 0; r < 4; ++r) { __builtin_amdgcn_sched_barrier(0);
                    float ss = 0.f;
#pragma unroll
                    for (int j = 0; j < 4; ++j) ss += acc[i][j][r] * acc[i][j][r];
                    ss = sum16(ss);
                    const float rinv = rsqrtf(ss * (1.f / 64.f) + 1e-6f) * scale;
                    const int m = mb + i * 16 + quad * 4 + r;
#pragma unroll
                    for (int j = 0; j < 4; ++j)
                        dst[(size_t)m * 512 + cb + j * 16 + l15] = f2bf(acc[i][j][r] * rinv * nw[j * 16 + l15]);
                }
        } else if (region == 2 || region == 5) {
            const int hd = region == 2 ? 64 : 128, nh = region == 2 ? 8 : 4;
            u16* dst = region == 2 ? P.slot[2] : P.slot[4];
            const int cb = nb & 511;
#pragma unroll
            for (int i = 0; i < 4; ++i) {
                const int m = mb + i * 16 + quad * 4;
#pragma unroll
                for (int j = 0; j < 4; ++j) {
                    const int col = cb + j * 16 + l15, h = col / hd, d = col % hd;
                    uint2 o; o.x = pack2(acc[i][j][0], acc[i][j][1]); o.y = pack2(acc[i][j][2], acc[i][j][3]);
                    size_t off;
                    if (m < ML) off = ((size_t)((m >> 12) * nh + h) * hd + d) * 4096 + (m & 4095);
                    else { int mc = m - ML; off = (size_t)ML * 512 + ((size_t)((mc >> 8) * nh + h) * hd + d) * 256 + (mc & 255); }
                    *(uint2*)(dst + off) = o;
                }
            }
        } else if (region == 3 || region == 4) {
            const int cb = nb & 511;
            const bool colhalf = (cb & 64) != 0;
            const float scale = region == 4 ? 0.08838834764831845f : 1.f;
            u16* dst = region == 3 ? P.slot[2] + HALF : P.slot[3];
            u16* dstT = P.slot[3] + HALF;
#pragma unroll
            for (int i = 0; i < 4; ++i) {
                const int m0 = mb + i * 16 + quad * 4;
#pragma unroll
                for (int j = 0; j < 2; ++j) {
                    __builtin_amdgcn_sched_barrier(0);
                    float o1[4], o2[4];
                    const int f = j * 16 + l15;
#pragma unroll
                    for (int r = 0; r < 4; ++r) {
                        const int m = m0 + r;
                        const float x1 = acc[i][j][r] * scale, x2 = acc[i][j + 2][r] * scale;
                        if (m < ML) {
                            const int t = m & 4095, pos = colhalf ? (t & 63) : (t >> 6);
                            const float c = P.ropec[pos * 32 + f], s = P.ropes[pos * 32 + f];
                            o1[r] = x1 * c - x2 * s; o2[r] = x1 * s + x2 * c;
                        } else { o1[r] = x1; o2[r] = x2; }
                    }
#pragma unroll
                    for (int hh = 0; hh < 2; ++hh) {
                        const int col = cb + (j + 2 * hh) * 16 + l15;
#pragma unroll
                        for (int r = 0; r < 4; ++r) dst[(size_t)(m0 + r) * 512 + col] = f2bf(hh ? o2[r] : o1[r]);
                        if (region == 4) {
                            const int h = col >> 7, d = col & 127;
                            uint2 q;
                            q.x = hh ? pack2(o2[0], o2[1]) : pack2(o1[0], o1[1]);
                            q.y = hh ? pack2(o2[2], o2[3]) : pack2(o1[2], o1[3]);
                            size_t off;
                            if (m0 < ML) off = ((size_t)((m0 >> 12) * 4 + h) * 128 + d) * 4096 + (m0 & 4095);
                            else { int mc = m0 - ML; off = (size_t)ML * 512 + ((size_t)((mc >> 8) * 4 + h) * 128 + d) * 256 + (mc & 255); }
                            *(uint2*)(dstT + off) = q;
                        }
                    }
                }
            }
        } else if (region == 6) {
            u16* dst = P.slot[4] + HALF;
            const int cb = nb & 511;
#pragma unroll
            for (int i = 0; i < 4; ++i)
#pragma unroll
                for (int r = 0; r < 4; ++r) { __builtin_amdgcn_sched_barrier(0);
                    const int m = mb + i * 16 + quad * 4 + r;
#pragma unroll
                    for (int j = 0; j < 4; ++j) dst[(size_t)m * 512 + cb + j * 16 + l15] = f2bf(acc[i][j][r]);
                }
        } else if (nb == 3584) {
            const float gb = P.in[7][l15];
            const bool isf = (l15 & 4) != 0;
#pragma unroll
            for (int i = 0; i < 4; ++i)
#pragma unroll
                for (int r = 0; r < 4; ++r) { __builtin_amdgcn_sched_barrier(0);
                    const int m = mb + i * 16 + quad * 4 + r;
                    float g = acc[i][0][r] + gb;
                    g = 15.f * tanhf(g * (1.f / 15.f));
                    if (isf) g = fminf(g, 0.f) - log1pf(__expf(-fabsf(g)));
                    P.gates[(size_t)m * 16 + l15] = g;
                }
        }
    } break;
    case E_MLPDN_AT: {
#pragma unroll
        for (int i = 0; i < 4; ++i)
#pragma unroll
            for (int r = 0; r < 4; ++r) {
                const int m = mb + i * 16 + quad * 4 + r;
                const float* mr = modrow(P, E.layer, m) + 5 * 1024;
                float* rp = resptr(P, m);
#pragma unroll
                for (int j = 0; j < 4; ++j) {
                    const int n = nb + j * 16 + l15;
                    atomicAdd(rp + n, mr[n] * acc[i][j][r]);
                }
            }
    } break;
    case E_OUT0: case E_MLPDN: case E_RWOUT: {
        const int gch = (E.mode == E_MLPDN) ? 5 : 2;
#pragma unroll
        for (int i = 0; i < 4; ++i)
#pragma unroll
            for (int r = 0; r < 4; ++r) { __builtin_amdgcn_sched_barrier(0);
                const int m = mb + i * 16 + quad * 4 + r;
                const float* mr = modrow(P, E.layer, m) + gch * 1024;
                float* rp = resptr(P, m);
                const float* xin = rp;
                if (E.mode == E_OUT0) xin = (m < ML) ? P.in[0] + (size_t)m * 1024 : P.in[2] + (size_t)(m - ML) * 1024;
#pragma unroll
                for (int j = 0; j < 4; ++j) {
                    const int n = nb + j * 16 + l15;
                    rp[n] = xin[n] + mr[n] * acc[i][j][r];
                }
            }
    } break;
    case E_MLPUP: case E_R: case E_V: case E_HW: case E_HA: case E_HG: {
#pragma unroll
        for (int i = 0; i < 4; ++i)
#pragma unroll
            for (int r = 0; r < 4; ++r) { __builtin_amdgcn_sched_barrier(0);
                const int m = mb + i * 16 + quad * 4 + r;
#pragma unroll
                for (int j = 0; j < 4; ++j) {
                    const int n = nb + j * 16 + l15;
                    float v = acc[i][j][r];
                    if (E.mode == E_MLPUP) { v = fmaxf(v, 0.f); v = v * v; }
                    else if (E.mode == E_HW) v = tanhf(v);
                    else if (E.mode == E_HG) v = sigmoidf_(v);
                    if (n < E.ldo) E.o16[(size_t)m * E.ldo + n] = f2bf(v);
                }
            }
    } break;
    case E_K: {
        const int hd = nb >> 6;
        const float* kk = P.in[23];
#pragma unroll
        for (int i = 0; i < 4; ++i)
#pragma unroll
            for (int r = 0; r < 4; ++r) { __builtin_amdgcn_sched_barrier(0);
                const int m = mb + i * 16 + quad * 4 + r;
                float ss = 0.f;
#pragma unroll
                for (int j = 0; j < 4; ++j) { float v = acc[i][j][r] * kk[nb + j * 16 + l15]; ss += v * v; }
                ss = sum16(ss);
                if (l15 == 0) P.knorm[(size_t)m * 16 + hd] = 1.f / fmaxf(sqrtf(ss), 1e-12f);
#pragma unroll
                for (int j = 0; j < 4; ++j) E.o16[(size_t)m * 1024 + nb + j * 16 + l15] = f2bf(acc[i][j][r]);
            }
    } break;
    case E_E: {
        const float* w0 = P.in[15] + E.z * 1024;
#pragma unroll
        for (int i = 0; i < 4; ++i)
#pragma unroll
            for (int r = 0; r < 4; ++r) { __builtin_amdgcn_sched_barrier(0);
                const int m = mb + i * 16 + quad * 4 + r;
#pragma unroll
                for (int j = 0; j < 4; ++j) {
                    const int n = nb + j * 16 + l15;
                    E.o16[(size_t)m * 1024 + n] = f2bf(sigmoidf_(w0[n] + acc[i][j][r]) * 0.6065306597126334f);
                }
            }
    } break;
    case E_A: {
        const float* a0 = P.in[18] + E.z * 1024;
        u8* dst = (u8*)P.slot[0] + (size_t)E.z * MA * 1024;
#pragma unroll
        for (int i = 0; i < 4; ++i)
#pragma unroll
            for (int r = 0; r < 4; ++r) { __builtin_amdgcn_sched_barrier(0);
                const int m = mb + i * 16 + quad * 4 + r;
#pragma unroll
                for (int j = 0; j < 4; ++j) {
                    const int n = nb + j * 16 + l15;
                    float a = sigmoidf_(a0[n] + acc[i][j][r]);
                    dst[(size_t)m * 1024 + n] = (u8)__float2int_rn(a * 255.f);
                }
            }
    } break;
    default: break;
    }
}

__device__ __forceinline__ void epilogue_t(const Params& P, const Epi& E, int mb, int nb, f32x4 (&acc)[4][4], int lane) {
    const int quad = lane >> 4, l15 = lane & 15;
#pragma unroll
    for (int i = 0; i < 4; ++i) {
        const int m = mb + i * 16 + l15;
#pragma unroll
        for (int j = 0; j < 4; ++j) {
            const int n = nb + j * 16 + quad * 4;
            const f32x4 v = acc[i][j];
            if (E.mode == E_E) {
                const float4 w0 = *(const float4*)(P.in[15] + E.z * 1024 + n);
                uint2 o;
                o.x = pack2(sigmoidf_(w0.x + v[0]) * 0.6065306597126334f, sigmoidf_(w0.y + v[1]) * 0.6065306597126334f);
                o.y = pack2(sigmoidf_(w0.z + v[2]) * 0.6065306597126334f, sigmoidf_(w0.w + v[3]) * 0.6065306597126334f);
                *(uint2*)(E.o16 + (size_t)m * 1024 + n) = o;
            } else if (E.mode == E_A) {
                const float4 a0 = *(const float4*)(P.in[18] + E.z * 1024 + n);
                u8* dst = (u8*)P.slot[0] + (size_t)E.z * MA * 1024;
                const unsigned b0 = (unsigned)__float2int_rn(sigmoidf_(a0.x + v[0]) * 255.f), b1 = (unsigned)__float2int_rn(sigmoidf_(a0.y + v[1]) * 255.f);
                const unsigned b2 = (unsigned)__float2int_rn(sigmoidf_(a0.z + v[2]) * 255.f), b3 = (unsigned)__float2int_rn(sigmoidf_(a0.w + v[3]) * 255.f);
                *(unsigned*)(dst + (size_t)m * 1024 + n) = b0 | (b1 << 8) | (b2 << 16) | (b3 << 24);
            } else {
                if (n < E.ldo) {
                    uint2 o; o.x = pack2(v[0], v[1]); o.y = pack2(v[2], v[3]);
                    *(uint2*)(E.o16 + (size_t)m * E.ldo + n) = o;
                }
            }
        }
    }
}

typedef float v2f_ __attribute__((ext_vector_type(2)));
__device__ __forceinline__ unsigned mixw(unsigned c, unsigned pm, unsigned pn, v2f_ mu) {
    const v2f_ c2 = {lo2f(c), hi2f(c)}, p2 = {lo2f(pm), hi2f(pm)}, n2 = {lo2f(pn), hi2f(pn)};
    const v2f_ half = {0.5f, 0.5f};
    const v2f_ x2 = __builtin_elementwise_fma(p2 + n2, half, -c2);
    const v2f_ o2 = __builtin_elementwise_fma(x2, mu, c2);
    return pack2(o2.x, o2.y);
}
__device__ __forceinline__ int g8_lds_byte(int r, int c);
__device__ __forceinline__ void g8_stage_rc(int b, int& R, int& C);
template <int AMODE>
__device__ __forceinline__ void gemm_tile(const Params& P, const u16* __restrict__ A, int lda, const u16* __restrict__ Bt, int K,
                                          int m0, int n0, const float* mu, const Epi& E, char* smem) {
    const int tid = get_tid(), lane = tid & 63, wave = tid >> 6;
    const int quad = lane >> 4, l15 = lane & 15;
    const int wm = wave >> 1, wn = wave & 1;
    u16* sA = (u16*)smem;
    u16* sB = sA + 2 * BM * LDK;
    const int lrow = tid >> 3, lkc = (tid & 7) * 8;
    f32x4 acc[2][4][4];
#pragma unroll
    for (int h = 0; h < 2; ++h)
#pragma unroll
        for (int i = 0; i < 4; ++i)
#pragma unroll
            for (int j = 0; j < 4; ++j) acc[h][i][j] = (f32x4){0.f, 0.f, 0.f, 0.f};

    uint4 ra0 = make_uint4(0, 0, 0, 0), ra1 = ra0, ra2 = ra0, ra3 = ra0;
    uint4 rb0 = ra0, rb1 = ra0, rb2 = ra0, rb3 = ra0;
    uint4 hm = ra0, hp = ra0;
    int offm = 0, offp = 0; float fm0 = 0.5f, fp3 = 0.5f;
    if (AMODE) {
        const int len = (m0 < ML) ? 4096 : 256;
        const int tb = (m0 < ML) ? (m0 & 4095) : ((m0 - ML) & 255);
        const bool hasprev = !(lrow == 0 && tb == 0), hasnext = !(lrow == 63 && tb + 256 == len);
        offm = hasprev ? lda : 0; offp = hasnext ? 4 * lda : 0;
        fm0 = hasprev ? 0.5f : 0.f; fp3 = hasnext ? 0.5f : 0.f;
    }
    unsigned gvoff0 = 0, gvoff1 = 0; int gfrag = 0;
    if (AMODE) {
        int r0, c0, r1, c1;
        g8_stage_rc(tid * 16, r0, c0); g8_stage_rc(tid * 16 + 8192, r1, c1);
        gvoff0 = (unsigned)(r0 * K + c0) * 2u; gvoff1 = (unsigned)(r1 * K + c1) * 2u;
        gfrag = g8_lds_byte(l15, quad * 8);
    }
    int nk = K / BK;
    asm volatile("" : "+s"(nk));
    for (int kt = -1; kt < nk; ++kt) {
        const bool more = kt + 1 < nk;
        if (more) {
            const int k0 = (kt + 1) * BK;
            if (!AMODE) {
                const u16* p = A + (size_t)(m0 + lrow) * lda + k0 + lkc;
                ra0 = *(const uint4*)p; ra1 = *(const uint4*)(p + (size_t)64 * lda);
                ra2 = *(const uint4*)(p + (size_t)128 * lda); ra3 = *(const uint4*)(p + (size_t)192 * lda);
            } else {
                const u16* p = A + (size_t)(m0 + 4 * lrow) * lda + k0 + lkc;
                ra0 = *(const uint4*)p; ra1 = *(const uint4*)(p + lda);
                ra2 = *(const uint4*)(p + 2 * lda); ra3 = *(const uint4*)(p + 3 * lda);
                hm = *(const uint4*)(p - offm); hp = *(const uint4*)(p + offp);
            }
            if (!AMODE) {
                const u16* q = Bt + (size_t)(n0 + lrow) * K + k0 + lkc;
                rb0 = *(const uint4*)q; rb1 = *(const uint4*)(q + (size_t)64 * K);
                rb2 = *(const uint4*)(q + (size_t)128 * K); rb3 = *(const uint4*)(q + (size_t)192 * K);
            } else {
                const int nbuf = (kt + 1) & 1;
#pragma unroll
                for (int hh = 0; hh < 2; ++hh) {
                    const char* gb = (const char*)Bt + ((long)(n0 + hh * 128) * K + k0) * 2;
                    char* dst = (char*)sB + (nbuf * 2 + hh) * 16384 + tid * 16;
                    __builtin_amdgcn_global_load_lds((const unsigned*)(gb + gvoff0), (LAS unsigned*)dst, 16, 0, 0);
                    __builtin_amdgcn_global_load_lds((const unsigned*)(gb + gvoff1), (LAS unsigned*)(dst + 8192), 16, 0, 0);
                }
            }
        }
        if (kt >= 0) {
            const u16* a = sA + (kt & 1) * BM * LDK + (wm * 64 + l15) * LDK + quad * 8;
            const u16* b = sB + (kt & 1) * BN * LDK + (wn * 128 + l15) * LDK + quad * 8;
            const char* bq = (const char*)sB + ((kt & 1) * 2 + wn) * 16384 + gfrag;
#pragma unroll
            for (int ks = 0; ks < 2; ++ks) {
                s16x8 af[4];
#pragma unroll
                for (int i = 0; i < 4; ++i) af[i] = as_frag(*(const uint4*)(a + i * 16 * LDK + ks * 32));
#pragma unroll
                for (int h = 0; h < 2; ++h) {
                    s16x8 bfr[4];
#pragma unroll
                    for (int j = 0; j < 4; ++j) {
                        if (AMODE) bfr[j] = as_frag(*(const uint4*)(bq + ((h * 4 + j) * 2 + ks) * 1024));
                        else bfr[j] = as_frag(*(const uint4*)(b + (h * 64 + j * 16) * LDK + ks * 32));
                    }
#pragma unroll
                    for (int i = 0; i < 4; ++i)
#pragma unroll
                        for (int j = 0; j < 4; ++j) acc[h][i][j] = AMODE ? mfma16(af[i], bfr[j], acc[h][i][j]) : mfma16(bfr[j], af[i], acc[h][i][j]);
                }
            }
        }
        if (more) {
            const int k0 = (kt + 1) * BK, buf = (kt + 1) & 1;
            u16* a = sA + buf * BM * LDK; u16* b = sB + buf * BN * LDK;
            if (AMODE) {
                const float4 mu0 = *(const float4*)(mu + k0 + lkc), mu1 = *(const float4*)(mu + k0 + lkc + 4);
#define MIXW(C, PM, PN, M2) mixw((C), (PM), (PN), (M2))
#define MIXROW(C, PM, PN) make_uint4(MIXW(C.x, PM.x, PN.x, muA), MIXW(C.y, PM.y, PN.y, muB), MIXW(C.z, PM.z, PN.z, muC), MIXW(C.w, PM.w, PN.w, muD))
                const v2f_ muA = {mu0.x, mu0.y}, muB = {mu0.z, mu0.w}, muC = {mu1.x, mu1.y}, muD = {mu1.z, mu1.w};
                uint4 hmz = hm, hpz = hp;
                if (fm0 == 0.f) hmz = make_uint4(0, 0, 0, 0);
                if (fp3 == 0.f) hpz = make_uint4(0, 0, 0, 0);
                *(uint4*)(a + (4 * lrow + 0) * LDK + lkc) = MIXROW(ra0, hmz, ra1);
                *(uint4*)(a + (4 * lrow + 1) * LDK + lkc) = MIXROW(ra1, ra0, ra2);
                *(uint4*)(a + (4 * lrow + 2) * LDK + lkc) = MIXROW(ra2, ra1, ra3);
                *(uint4*)(a + (4 * lrow + 3) * LDK + lkc) = MIXROW(ra3, ra2, hpz);
#undef MIXROW
#undef MIXW
            } else {
                *(uint4*)(a + lrow * LDK + lkc) = ra0; *(uint4*)(a + (lrow + 64) * LDK + lkc) = ra1;
                *(uint4*)(a + (lrow + 128) * LDK + lkc) = ra2; *(uint4*)(a + (lrow + 192) * LDK + lkc) = ra3;
            }
            if (!AMODE) {
                *(uint4*)(b + lrow * LDK + lkc) = rb0; *(uint4*)(b + (lrow + 64) * LDK + lkc) = rb1;
                *(uint4*)(b + (lrow + 128) * LDK + lkc) = rb2; *(uint4*)(b + (lrow + 192) * LDK + lkc) = rb3;
            }
        }
        if (AMODE) asm volatile("s_waitcnt vmcnt(0)" ::: "memory");
        __syncthreads();
    }
    int lane_e = lane;
    asm volatile("" : "+v"(lane_e));
    if (!AMODE) {
        epilogue_t(P, E, m0 + wm * 64, n0 + wn * 128, acc[0], lane_e);
        epilogue_t(P, E, m0 + wm * 64, n0 + wn * 128 + 64, acc[1], lane_e);
        return;
    }
    {
        float* park = (float*)smem;
#pragma unroll
        for (int i = 0; i < 4; ++i)
#pragma unroll
            for (int j = 0; j < 4; ++j)
#pragma unroll
                for (int r = 0; r < 4; ++r) park[((i * 4 + j) * 4 + r) * NTHREADS + tid] = acc[1][i][j][r];
        __builtin_amdgcn_sched_barrier(0);
        epilogue(P, E, m0 + (lane_e >> 6) * 0 + wm * 64, n0 + wn * 128, acc[0], lane_e);
        __builtin_amdgcn_sched_barrier(0);
#pragma unroll
        for (int i = 0; i < 4; ++i)
#pragma unroll
            for (int j = 0; j < 4; ++j)
#pragma unroll
                for (int r = 0; r < 4; ++r) acc[0][i][j][r] = park[((i * 4 + j) * 4 + r) * NTHREADS + tid];
        __builtin_amdgcn_sched_barrier(0);
        epilogue(P, E, m0 + wm * 64, n0 + wn * 128 + 64, acc[0], lane_e);
        __syncthreads();
    }
}


constexpr int G8_HT = 128 * 64;
__device__ __forceinline__ int g8_lds_byte(int r, int c) {
    int st = (r >> 4) * 2 + (c >> 5), rr = r & 15, cc = c & 31, ob = rr * 64 + cc * 2;
    return st * 1024 + (ob ^ (((ob >> 9) & 1) << 5));
}
__device__ __forceinline__ void g8_stage_rc(int b, int& R, int& C) {
    int st = b / 1024, sb = b % 1024, swz = sb ^ (((sb >> 9) & 1) << 5);
    R = (st >> 1) * 16 + swz / 64; C = (st & 1) * 32 + (swz % 64) / 2;
}
__device__ __forceinline__ void gemm8_tile(const Params& P, const u16* __restrict__ A, const u16* __restrict__ Bt, const int K,
                                           const int brow, const int bcol, const Epi& E, char* smem, const int kext = 0) {
    u16* shm = (u16*)smem;
#define G8_SA(b, h) (shm + ((b) * 2 + (h)) * G8_HT)
#define G8_SB(b, h) (shm + (4 + (b) * 2 + (h)) * G8_HT)
#define G8_STAGE_A(PTR, br, kt) do { const char* _gb = (const char*)A + ((long)(br) * K + (long)(kt) * 64) * 2; \
    __builtin_amdgcn_global_load_lds((const unsigned*)(_gb + voffA0), (LAS unsigned*)((char*)(PTR) + tidx * 16), 16, 0, 0); \
    __builtin_amdgcn_global_load_lds((const unsigned*)(_gb + voffA1), (LAS unsigned*)((char*)(PTR) + tidx * 16 + 8192), 16, 0, 0); } while (0)
#define G8_STAGE_B(PTR, hh, kt) do { const char* _gb = (const char*)Bt + ((long)(bcol + (hh) * 32) * K + (long)(kt) * 64) * 2; \
    __builtin_amdgcn_global_load_lds((const unsigned*)(_gb + voffB0), (LAS unsigned*)((char*)(PTR) + tidx * 16), 16, 0, 0); \
    __builtin_amdgcn_global_load_lds((const unsigned*)(_gb + voffB1), (LAS unsigned*)((char*)(PTR) + tidx * 16 + 8192), 16, 0, 0); } while (0)
#define G8_LDA(dst, b, h) for (int m = 0; m < 4; ++m) for (int k = 0; k < 2; ++k) \
    dst[m][k] = *reinterpret_cast<const s16x8*>(aBase + ((b) * 2 + (h)) * (G8_HT * 2) + (2 * m + k) * 1024)
#define G8_LDB(dst, b, h) for (int n = 0; n < 2; ++n) for (int k = 0; k < 2; ++k) \
    dst[n][k] = *reinterpret_cast<const s16x8*>(bBase + ((b) * 2 + (h)) * (G8_HT * 2) + (2 * n + k) * 1024)
#define G8_MMA(ai, bj, At_, Bt_) do { __builtin_amdgcn_s_setprio(1); \
    for (int m = 0; m < 4; ++m) for (int n = 0; n < 2; ++n) for (int k = 0; k < 2; ++k) \
        acc[ai][bj][m][n] = __builtin_amdgcn_mfma_f32_16x16x32_bf16(At_[m][k], Bt_[n][k], acc[ai][bj][m][n], 0, 0, 0); \
    __builtin_amdgcn_s_setprio(0); } while (0)
#define G8_WAIT_V(n) asm volatile("s_waitcnt vmcnt(" #n ")" ::: "memory")
#define G8_WAIT_L(n) asm volatile("s_waitcnt lgkmcnt(" #n ")" ::: "memory")
#define G8_BAR __builtin_amdgcn_s_barrier()
#define G8_SCHED __builtin_amdgcn_sched_barrier(0)
    const int tidx = get_tid();
    const int wid = tidx >> 6, lane = tidx & 63, wr = wid >> 2, wc = wid & 3, fr = lane & 15, fq = lane >> 4;
    const char* aBase = (const char*)shm + g8_lds_byte(wr * 64 + fr, fq * 8);
    const char* bBase = (const char*)shm + 4 * (G8_HT * 2) + g8_lds_byte(wc * 32 + fr, fq * 8);
    unsigned voffA0, voffA1, voffB0, voffB1;
    {
        int r0, c0, r1, c1;
        g8_stage_rc(tidx * 16, r0, c0); g8_stage_rc(tidx * 16 + 8192, r1, c1);
        voffA0 = (unsigned)(r0 * K + c0) * 2u; voffA1 = (unsigned)(r1 * K + c1) * 2u;
        voffB0 = (unsigned)((((r0 >> 5) << 6) + (r0 & 31)) * K + c0) * 2u; voffB1 = (unsigned)((((r1 >> 5) << 6) + (r1 & 31)) * K + c1) * 2u;
    }
    f32x4 acc[2][2][4][2];
#pragma unroll
    for (int a = 0; a < 2; ++a)
#pragma unroll
        for (int b = 0; b < 2; ++b)
#pragma unroll
            for (int m = 0; m < 4; ++m)
#pragma unroll
                for (int n = 0; n < 2; ++n) acc[a][b][m][n] = (f32x4){0.f, 0.f, 0.f, 0.f};
    s16x8 At[4][2], B0[2][2], B1[2][2];
    int nt = (kext ? kext : K) / 64;
    asm volatile("" : "+s"(nt));
    G8_STAGE_B(G8_SB(0, 0), 0, 0); G8_STAGE_A(G8_SA(0, 0), brow, 0);
    G8_STAGE_B(G8_SB(0, 1), 1, 0); G8_STAGE_A(G8_SA(0, 1), brow + 128, 0);
    if (wr == 1) G8_BAR;
    G8_WAIT_V(4); G8_BAR;
    G8_STAGE_B(G8_SB(1, 0), 0, 1); G8_STAGE_A(G8_SA(1, 0), brow, 1); G8_STAGE_B(G8_SB(1, 1), 1, 1);
    G8_WAIT_V(6); G8_BAR;
    for (int t = 0; t < nt - 2; t += 2) {
        G8_LDB(B0, 0, 0); G8_SCHED; G8_LDA(At, 0, 0); G8_STAGE_A(G8_SA(1, 1), brow + 128, t + 1);
        G8_WAIT_L(8); G8_BAR; G8_WAIT_L(0); G8_MMA(0, 0, At, B0); G8_BAR; G8_SCHED;
        G8_LDB(B1, 0, 1); G8_STAGE_B(G8_SB(0, 0), 0, t + 2);
        G8_BAR; G8_WAIT_L(0); G8_MMA(0, 1, At, B1); G8_BAR;
        G8_LDA(At, 0, 1); G8_STAGE_A(G8_SA(0, 0), brow, t + 2);
        G8_BAR; G8_WAIT_L(0); G8_MMA(1, 0, At, B0); G8_BAR; G8_SCHED;
        G8_STAGE_B(G8_SB(0, 1), 1, t + 2);
        G8_WAIT_V(6); G8_BAR; G8_MMA(1, 1, At, B1); G8_BAR;
        G8_LDB(B0, 1, 0); G8_SCHED; G8_LDA(At, 1, 0); G8_STAGE_A(G8_SA(0, 1), brow + 128, t + 2);
        G8_WAIT_L(8); G8_BAR; G8_WAIT_L(0); G8_MMA(0, 0, At, B0); G8_BAR; G8_SCHED;
        G8_LDB(B1, 1, 1); G8_STAGE_B(G8_SB(1, 0), 0, t + 3);
        G8_BAR; G8_WAIT_L(0); G8_MMA(0, 1, At, B1); G8_BAR;
        G8_LDA(At, 1, 1); G8_STAGE_A(G8_SA(1, 0), brow, t + 3);
        G8_BAR; G8_WAIT_L(0); G8_MMA(1, 0, At, B0); G8_BAR; G8_SCHED;
        G8_STAGE_B(G8_SB(1, 1), 1, t + 3);
        G8_WAIT_V(6); G8_BAR; G8_MMA(1, 1, At, B1); G8_BAR;
    }
    { G8_LDB(B0, 0, 0); G8_LDA(At, 0, 0); G8_STAGE_A(G8_SA(1, 1), brow + 128, nt - 1);
      G8_BAR; G8_WAIT_L(0); G8_MMA(0, 0, At, B0); G8_BAR;
      G8_LDB(B1, 0, 1); G8_BAR; G8_WAIT_L(0); G8_MMA(0, 1, At, B1); G8_BAR;
      G8_LDA(At, 0, 1); G8_WAIT_V(4); G8_BAR; G8_WAIT_L(0); G8_MMA(1, 0, At, B0); G8_MMA(1, 1, At, B1); G8_BAR; }
    { G8_LDB(B0, 1, 0); G8_LDA(At, 1, 0); G8_WAIT_V(2); G8_BAR; G8_WAIT_L(0); G8_MMA(0, 0, At, B0); G8_BAR;
      G8_LDB(B1, 1, 1); G8_WAIT_V(0); G8_BAR; G8_WAIT_L(0); G8_MMA(0, 1, At, B1); G8_BAR;
      G8_LDA(At, 1, 1); G8_BAR; G8_WAIT_L(0); G8_MMA(1, 0, At, B0); G8_MMA(1, 1, At, B1); G8_BAR; }
    if (wr == 0) G8_BAR;
    __syncthreads();
    const int tid_e = get_tid();
    const int lane_e = tid_e & 63, wr_e = tid_e >> 8, wc_e = (tid_e >> 6) & 3;
    {
        f32x4 blk[4][4];
#pragma unroll
        for (int i = 0; i < 4; ++i)
#pragma unroll
            for (int j = 0; j < 4; ++j) blk[i][j] = acc[0][j >> 1][i][j & 1];
        epilogue(P, E, brow + wr_e * 64, bcol + wc_e * 64, blk, lane_e);
        __builtin_amdgcn_sched_barrier(0);
#pragma unroll
        for (int i = 0; i < 4; ++i)
#pragma unroll
            for (int j = 0; j < 4; ++j) blk[i][j] = acc[1][j >> 1][i][j & 1];
        epilogue(P, E, brow + 128 + wr_e * 64, bcol + wc_e * 64, blk, lane_e);
    }
}

__device__ __forceinline__ int xcd_swz(int u0) {
    const int G = gridDim.x, per = G >> 3;
    const int rd = u0 / G, idx = u0 - rd * G;
    return rd * G + (idx & 7) * per + (idx >> 3);
}
struct GJob { const u16* A; int lda; const u16* Bt; int K; const float* mu; Epi E; };

__device__ __forceinline__ void rw2_job(const Params& P, int ntile, GJob& g, int& nt) {
    const int j = ntile >> 2; nt = ntile & 3;
    if (j == 0) g = {P.hw, 128, P.lw2t, 64, nullptr, {E_E, 1, 0, P.slot[4], 1024}};
    else if (j == 1) g = {P.hw + 64, 128, P.lw2t + 1024 * 64, 64, nullptr, {E_E, 1, 1, P.slot[5], 1024}};
    else if (j == 2) g = {P.ha, 128, P.la2t, 64, nullptr, {E_A, 1, 0, nullptr, 0}};
    else g = {P.ha + 64, 128, P.la2t + 1024 * 64, 64, nullptr, {E_A, 1, 1, nullptr, 0}};
}
__device__ __forceinline__ void phase_rw1(const Params& P, char* smem) {
    const int total = 15 * (MA / BM);
    const int totr = (total + gridDim.x - 1) / gridDim.x * gridDim.x;
    for (int u0 = blockIdx.x; u0 < totr; u0 += gridDim.x) {
        const int u = xcd_swz(u0);
        if (u >= total) continue;
        const int ntile = u % 15;
        const int jid = ntile < 12 ? (ntile >> 2) : ntile - 9;
        const int nt = ntile < 12 ? (ntile & 3) : 0;
        const int muidx = (0x541320 >> (4 * jid)) & 15;
        const u16* Bt = jid == 0 ? P.rkvt : jid == 1 ? P.rkvt + (size_t)1024 * 1024 : jid == 2 ? P.rkvt + (size_t)2 * 1024 * 1024
                        : jid == 3 ? P.lw1t : jid == 4 ? P.la1t : P.lg1t;
        u16* o16 = jid == 0 ? P.slot[1] : jid == 1 ? P.slot[2] : jid == 2 ? P.slot[3] : jid == 3 ? P.hw : jid == 4 ? P.ha : P.hg;
        Epi E;
        E.mode = E_R + jid; E.layer = 1; E.z = 0; E.o16 = o16; E.ldo = jid < 3 ? 1024 : (jid < 5 ? 128 : 192);
        gemm_tile<1>(P, P.slot[0], 1024, Bt, 1024, (u / 15) * BM, nt * BN, P.in[13] + muidx * 1024, E, smem);
    }
}
__device__ __forceinline__ void phase_rw2(const Params& P, char* smem) {
    const int total = 16 * (MA / BM);
    const int totr = (total + gridDim.x - 1) / gridDim.x * gridDim.x;
    for (int u0 = blockIdx.x; u0 < totr; u0 += gridDim.x) {
        const int u = xcd_swz(u0);
        if (u >= total) continue;
        GJob g; int nt; rw2_job(P, u % 16, g, nt);
        gemm_tile<0>(P, g.A, g.lda, g.Bt, g.K, (u / 16) * BM, nt * BN, nullptr, g.E, smem);
    }
}

__device__ __forceinline__ void phase_mlpdn0(const Params& P, char* smem) {
    const u16* A = P.slot[1]; const u16* Bt = P.w2t[0];
    const int total = 512 + 256;
    for (int u0 = blockIdx.x; u0 < total; u0 += gridDim.x) {
        const int u = xcd_swz(u0);
        if (u < 512) {
            Epi E{E_MLPDN, 0, 0, nullptr, 0};
            gemm8_tile(P, A, Bt, 4096, (u >> 2) * BM, (u & 3) * BN, E, smem);
        } else {
            const int v = u - 512, ks = v & 7, t = v >> 3;
            Epi E{E_MLPDN_AT, 0, 0, nullptr, 0};
            gemm8_tile(P, A + ks * 512, Bt + ks * 512, 4096, (128 + (t >> 2)) * BM, (t & 3) * BN, E, smem, 512);
        }
    }
}

__device__ __forceinline__ void gemm_single(const Params& P, const u16* A, int lda, const u16* Bt, int K, int ntn, int m_tiles, Epi E, char* smem) {
    const int total = ntn * m_tiles;
    const int totr = (total + gridDim.x - 1) / gridDim.x * gridDim.x;
    for (int u0 = blockIdx.x; u0 < totr; u0 += gridDim.x) {
        const int u = xcd_swz(u0);
        if (u >= total) continue;
        const int nt = u % ntn, mt = u / ntn;
        if (K >= 256 && lda == K) gemm8_tile(P, A, Bt, K, mt * BM, nt * BN, E, smem);
        else gemm_tile<0>(P, A, lda, Bt, K, mt * BM, nt * BN, nullptr, E, smem);
    }
}

__device__ __forceinline__ void na_unit(const Params& P, int b, int h, int rp, bool ctxq, int half, char* smem) {
    const int tid = get_tid(), lane = tid & 63, wave = tid >> 6, quad = lane >> 4, l15 = lane & 15;
    u16* sK = (u16*)smem;
    u16* sVT = sK + 64 * 72;
    float* sBias = (float*)(sK + 4 * 64 * 72);
    const u16* QA = P.slot[1]; const u16* KA = P.slot[1] + HALF; const u16* VAT = P.slot[2];
    u16* CAT = P.slot[0];
    int qrow = 0, c = 0, m, rs_q = 0, rsA = 0, nrows = 0, cs = 0;
    if (!ctxq) {
        const int r0 = 2 * rp;
        qrow = r0 + (wave >> 2); c = (wave & 3) * 16 + l15;
        m = b * 4096 + qrow * 64 + c;
        rs_q = min(max(qrow - 4, 0), 56);
        rsA = min(max(r0 - 4, 0), 56);
        const int rsB = min(max(r0 + 1 - 4, 0), 56);
        nrows = rsB - rsA + 8;
        cs = min(max(c - 8, 0), 48);
    } else {
        m = ML + b * 256 + (half * 8 + wave) * 16 + l15;
    }
    __syncthreads();
    if (!ctxq) for (int e = tid; e < 15 * 31; e += NTHREADS) sBias[e] = P.in[10][h * 465 + e];
    s16x8 qf[2];
#pragma unroll
    for (int ks = 0; ks < 2; ++ks) qf[ks] = as_frag(*(const uint4*)(QA + (size_t)m * 512 + h * 64 + ks * 32 + quad * 8));
    float m_run = -INFINITY, l_run = 0.f;
    f32x4 o[4];
#pragma unroll
    for (int dt = 0; dt < 4; ++dt) o[dt] = (f32x4){0.f, 0.f, 0.f, 0.f};
    const int nblk = nrows + 4;
    const int lrow = tid >> 3, lch = (tid & 7) * 8;
    int ktmask = 15;
    if (!ctxq) {
        const int cq0 = (wave & 3) * 16;
        const int lo = min(max(cq0 - 8, 0), 48), hi = min(max(cq0 + 15 - 8, 0), 48) + 15;
        ktmask = 0;
#pragma unroll
        for (int kt = 0; kt < 4; ++kt) if (kt * 16 + 15 >= lo && kt * 16 <= hi) ktmask |= 1 << kt;
    }
    uint4 pk_, pv_;
    auto gload = [&](int blk) {
        const bool isctx = blk >= nrows;
        const u16 *kp, *vp;
        if (!isctx) {
            const int tk = (rsA + blk) * 64;
            kp = KA + (size_t)(b * 4096 + tk + lrow) * 512 + h * 64 + lch;
            vp = VAT + ((size_t)(b * 8 + h) * 64 + lrow) * 4096 + tk + lch;
        } else {
            const int nk0 = (blk - nrows) * 64;
            kp = KA + (size_t)(ML + b * 256 + nk0 + lrow) * 512 + h * 64 + lch;
            vp = VAT + (size_t)ML * 512 + ((size_t)(b * 8 + h) * 64 + lrow) * 256 + nk0 + lch;
        }
        pk_ = *(const uint4*)kp; pv_ = *(const uint4*)vp;
    };
    gload(0);
    __syncthreads();
    *(uint4*)(sK + lrow * 72 + lch) = pk_; *(uint4*)(sVT + lrow * 72 + lch) = pv_;
    __syncthreads();
    for (int blk = 0; blk < nblk; ++blk) {
        const bool isctx = blk >= nrows;
        const u16* cK = sK + (blk & 1) * 2 * 64 * 72;
        const u16* cVT = cK + 64 * 72;
        if (blk + 1 < nblk) gload(blk + 1);
        const int kr = rsA + blk;
        const int kmask = isctx ? 15 : ktmask;
        if (isctx || (kr >= rs_q && kr < rs_q + 8)) {
            f32x4 s[4];
#pragma unroll
            for (int kt = 0; kt < 4; ++kt) {
                s[kt] = (f32x4){0.f, 0.f, 0.f, 0.f};
                if (kmask & (1 << kt)) {
#pragma unroll
                    for (int ks = 0; ks < 2; ++ks) {
                        s16x8 a = as_frag(*(const uint4*)(cK + (kt * 16 + l15) * 72 + ks * 32 + quad * 8));
                        s[kt] = mfma16(a, qf[ks], s[kt]);
                    }
                }
            }
            float mx = -INFINITY;
#pragma unroll
            for (int kt = 0; kt < 4; ++kt)
#pragma unroll
                for (int r = 0; r < 4; ++r) {
                    float v = s[kt][r];
                    if (!isctx) {
                        const int kc = kt * 16 + quad * 4 + r;
                        const bool valid = (kc >= cs) && (kc < cs + 16);
                        v = valid ? v + sBias[(kr - qrow + 7) * 31 + (kc - c + 15)] : -INFINITY;
                    }
                    s[kt][r] = v; mx = fmaxf(mx, v);
                }
            mx = fmaxf(mx, __shfl_xor(mx, 16)); mx = fmaxf(mx, __shfl_xor(mx, 32));
            const float m_new = fmaxf(m_run, mx);
            const float alpha = __expf(m_run - m_new);
            m_run = m_new;
            float ps = 0.f;
#pragma unroll
            for (int kt = 0; kt < 4; ++kt)
#pragma unroll
                for (int r = 0; r < 4; ++r) { float pv = __expf(s[kt][r] - m_new); s[kt][r] = pv; ps += pv; }
            l_run = l_run * alpha + ps;
#pragma unroll
            for (int dt = 0; dt < 4; ++dt) { o[dt][0] *= alpha; o[dt][1] *= alpha; o[dt][2] *= alpha; o[dt][3] *= alpha; }
#pragma unroll
            for (int sb = 0; sb < 2; ++sb) {
                if (kmask & (3 << (2 * sb))) {
                    uint4 pb;
                    pb.x = pack2(s[2 * sb][0], s[2 * sb][1]); pb.y = pack2(s[2 * sb][2], s[2 * sb][3]);
                    pb.z = pack2(s[2 * sb + 1][0], s[2 * sb + 1][1]); pb.w = pack2(s[2 * sb + 1][2], s[2 * sb + 1][3]);
                    const s16x8 bfrag = as_frag(pb);
#pragma unroll
                    for (int dt = 0; dt < 4; ++dt) {
                        const u16* vr = cVT + (dt * 16 + l15) * 72 + sb * 32 + quad * 4;
                        uint2 lo = *(const uint2*)vr, hi = *(const uint2*)(vr + 16);
                        s16x8 a = as_frag(make_uint4(lo.x, lo.y, hi.x, hi.y));
                        o[dt] = mfma16(a, bfrag, o[dt]);
                    }
                }
            }
        }
        if (blk + 1 < nblk) {
            u16* nK = sK + ((blk + 1) & 1) * 2 * 64 * 72;
            *(uint4*)(nK + lrow * 72 + lch) = pk_; *(uint4*)(nK + 64 * 72 + lrow * 72 + lch) = pv_;
        }
        __syncthreads();
    }
    l_run += __shfl_xor(l_run, 16); l_run += __shfl_xor(l_run, 32);
    const float inv = 1.f / l_run;
#pragma unroll
    for (int dt = 0; dt < 4; ++dt) {
        uint2 q; q.x = pack2(o[dt][0] * inv, o[dt][1] * inv); q.y = pack2(o[dt][2] * inv, o[dt][3] * inv);
        *(uint2*)(CAT + (size_t)m * 1024 + h * 64 + dt * 16 + quad * 4) = q;
    }
}

struct ChunkGeo { int m0; size_t tb; int len; };
__device__ __forceinline__ ChunkGeo chunk_geo(int b, int dir, int pc) {
    ChunkGeo g;
    if (pc < 2) { int oc = dir ? 1 - pc : pc; g.m0 = ML + b * 256 + oc * 128; g.tb = oc * 128; g.len = 256; }
    else { int pp = pc - 2; int oc = dir ? 31 - pp : pp; g.m0 = b * 4096 + oc * 128; g.tb = oc * 128; g.len = 4096; }
    return g;
}
__device__ __forceinline__ size_t tbase(int b, int h, int len) {
    return len == 4096 ? (size_t)(b * 4 + h) * 128 * 4096 : (size_t)ML * 512 + (size_t)(b * 4 + h) * 128 * 256;
}

__device__ __forceinline__ void ml_c1_unit(const Params& P, int chain, int pc, char* smem) {
    const int tid = get_tid(), lane = tid & 63, wave = tid >> 6, quad = lane >> 4, l15 = lane & 15;
    const int dir = chain & 1, h = (chain >> 1) & 3, b = chain >> 3;
    float* sS = (float*)smem;
    float* sW = sS + 128;
    float* sRed = sW + 128;
    const ChunkGeo g = chunk_geo(b, dir, pc);
    const u16* KBT = P.slot[3] + HALF + tbase(b, h, g.len) + g.tb;
    const u16* VBT = P.slot[4] + tbase(b, h, g.len) + g.tb;
    const int e0 = (wave >> 1) * 32, d0 = (wave & 1) * 64;
    uint4 araw[4][2], braw[4][4];
    if (pc < 33) {
#pragma unroll
        for (int ks = 0; ks < 4; ++ks) {
            const int s0 = ks * 32 + quad * 8;
#pragma unroll
            for (int i = 0; i < 2; ++i) araw[ks][i] = *(const uint4*)(VBT + (size_t)(e0 + i * 16 + l15) * g.len + s0);
#pragma unroll
            for (int j = 0; j < 4; ++j) braw[ks][j] = *(const uint4*)(KBT + (size_t)(d0 + j * 16 + l15) * g.len + s0);
        }
    }
    __syncthreads();
    float gi = 0.f, x = 0.f;
    const int s = dir ? 127 - (tid & 127) : (tid & 127);
    if (tid < 128) {
        gi = P.gates[(size_t)(g.m0 + s) * 16 + dir * 8 + h];
        x = P.gates[(size_t)(g.m0 + s) * 16 + dir * 8 + 4 + h];
    }
#pragma unroll
    for (int o = 1; o < 64; o <<= 1) { const float y = __shfl_up(x, o); if (lane >= o) x += y; }
    if (tid == 63) sRed[0] = x;
    __syncthreads();
    if (tid >= 64 && tid < 128) x += sRed[0];
    if (tid == 127) sRed[1] = x;
    __syncthreads();
    const float Bc = sRed[1];
    float wl = -INFINITY, xm = -INFINITY;
    if (tid < 128) { wl = Bc - x + gi; xm = gi - x; }
#pragma unroll
    for (int o = 1; o < 64; o <<= 1) { const float y = __shfl_up(xm, o); if (lane >= o) xm = fmaxf(xm, y); }
    if (tid == 63) sRed[2] = xm;
    float mx = wl;
#pragma unroll
    for (int o = 1; o < 64; o <<= 1) mx = fmaxf(mx, __shfl_xor(mx, o));
    if (lane == 0 && wave < 2) sRed[4 + wave] = mx;
    __syncthreads();
    if (tid >= 64 && tid < 128) xm = fmaxf(xm, sRed[2]);
    const float Mc = fmaxf(sRed[4], sRed[5]);
    if (tid < 128) {
        sW[s] = __expf(wl - Mc);
        P.gb[(size_t)(chain * 34 + pc) * 128 + s] = x;
        P.gx[(size_t)(chain * 34 + pc) * 128 + s] = xm;
    }
    if (pc == 33) return;
    __syncthreads();
    f32x4 acc[2][4];
#pragma unroll
    for (int i = 0; i < 2; ++i)
#pragma unroll
        for (int j = 0; j < 4; ++j) acc[i][j] = (f32x4){0.f, 0.f, 0.f, 0.f};
#pragma unroll
    for (int ks = 0; ks < 4; ++ks) {
        const int s0 = ks * 32 + quad * 8;
        float wv[8];
#pragma unroll
        for (int q = 0; q < 8; ++q) wv[q] = sW[s0 + q];
        s16x8 af[2], bfr[4];
#pragma unroll
        for (int i = 0; i < 2; ++i) {
            const uint4 raw = araw[ks][i];
            uint4 sc;
            sc.x = pack2(lo2f(raw.x) * wv[0], hi2f(raw.x) * wv[1]); sc.y = pack2(lo2f(raw.y) * wv[2], hi2f(raw.y) * wv[3]);
            sc.z = pack2(lo2f(raw.z) * wv[4], hi2f(raw.z) * wv[5]); sc.w = pack2(lo2f(raw.w) * wv[6], hi2f(raw.w) * wv[7]);
            af[i] = as_frag(sc);
        }
#pragma unroll
        for (int j = 0; j < 4; ++j) bfr[j] = as_frag(braw[ks][j]);
#pragma unroll
        for (int i = 0; i < 2; ++i)
#pragma unroll
            for (int j = 0; j < 4; ++j) acc[i][j] = mfma16(af[i], bfr[j], acc[i][j]);
    }
    u16* ST = P.slot[5] + (size_t)(chain * 34 + pc) * 16384;
#pragma unroll
    for (int i = 0; i < 2; ++i)
#pragma unroll
        for (int j = 0; j < 4; ++j)
#pragma unroll
            for (int r = 0; r < 4; ++r)
                ST[(e0 + i * 16 + quad * 4 + r) * 128 + d0 + j * 16 + l15] = f2bf(acc[i][j][r]);
    if (tid < 128) {
        float nu = 0.f;
        const u16* kr = KBT + (size_t)tid * g.len;
        for (int s = 0; s < 128; s += 8) {
            uint4 raw = *(const uint4*)(kr + s);
            nu += lo2f(raw.x) * sW[s] + hi2f(raw.x) * sW[s + 1] + lo2f(raw.y) * sW[s + 2] + hi2f(raw.y) * sW[s + 3]
                + lo2f(raw.z) * sW[s + 4] + hi2f(raw.z) * sW[s + 5] + lo2f(raw.w) * sW[s + 6] + hi2f(raw.w) * sW[s + 7];
        }
        P.mnu[(size_t)(chain * 34 + pc) * 128 + tid] = nu;
    }
    if (tid == 0) { P.mbc[chain * 34 + pc] = Bc; P.mmc[chain * 34 + pc] = Mc; }
}

__device__ __forceinline__ void phase_mix0(const Params& P, char* smem) {
    const int n_c1 = 64 * 34, n_na = 8 * 8 * 32, n_cx = 8 * 8 * 2;
    for (int u = blockIdx.x; u < n_c1 + n_na + n_cx; u += gridDim.x) {
        if (u < n_na) { int v = u; na_unit(P, v >> 8, (v >> 5) & 7, v & 31, false, 0, smem); }
        else if (u < n_na + n_cx) { int v = u - n_na; na_unit(P, v >> 4, (v >> 1) & 7, 0, true, v & 1, smem); }
        else { int v = u - n_na - n_cx; ml_c1_unit(P, v / 34, v % 34, smem); }
    }
}

__device__ __forceinline__ void phase_mlscan(const Params& P) {
    const int tid = get_tid();
    for (int u = blockIdx.x; u < 64 * 33; u += gridDim.x) {
        const int chain = u / 33, grp = u % 33;
        if (grp == 32 && tid >= 128) continue;
        const float* bc = P.mbc + chain * 34; const float* mc = P.mmc + chain * 34;
        float U[33];
        if (grp < 32) {
            u16* st = P.slot[5] + (size_t)chain * 34 * 16384 + grp * 512 + tid;
#pragma unroll
            for (int pc = 0; pc < 33; ++pc) U[pc] = bf2f(st[(size_t)pc * 16384]);
            float C = 0.f, mm = 0.f;
#pragma unroll
            for (int pc = 0; pc < 34; ++pc) {
                st[(size_t)pc * 16384] = f2bf(C);
                if (pc < 33) {
                    const float Bc = bc[pc], Mc = mc[pc];
                    const float mn = fmaxf(Bc + mm, Mc);
                    C = __expf(Bc + mm - mn) * C + __expf(Mc - mn) * U[pc];
                    mm = mn;
                }
            }
        } else {
            float* nu = P.mnu + (size_t)chain * 34 * 128 + tid;
#pragma unroll
            for (int pc = 0; pc < 33; ++pc) U[pc] = nu[pc * 128];
            float C = 0.f, mm = 0.f;
#pragma unroll
            for (int pc = 0; pc < 34; ++pc) {
                nu[pc * 128] = C;
                if (tid == 0) P.mst[chain * 34 + pc] = mm;
                if (pc < 33) {
                    const float Bc = bc[pc], Mc = mc[pc];
                    const float mn = fmaxf(Bc + mm, Mc);
                    C = __expf(Bc + mm - mn) * C + __expf(Mc - mn) * U[pc];
                    mm = mn;
                }
            }
        }
    }
}

__device__ __forceinline__ void ml_c3_unit(const Params& P, int b, int h, int cid, char* smem) {
    const int tid = get_tid(), lane = tid & 63, wave = tid >> 6, quad = lane >> 4, l15 = lane & 15;
    float* sB = (float*)smem;
    float* sI = sB + 256;
    float* sX = sI + 256;
    const bool isctx = cid < 2;
    const int oc = isctx ? cid : cid - 2;
    const int nseg = isctx ? 2 : 32, len = isctx ? 256 : 4096;
    const int m0 = isctx ? ML + b * 256 + oc * 128 : b * 4096 + oc * 128;
    const u16* QB = P.slot[2] + HALF; const u16* KB = P.slot[3];
    const u16* VBT = P.slot[4] + tbase(b, h, len) + oc * 128;
    const u16* OB = P.slot[4] + HALF;
    u16* CAT = P.slot[0];
    __syncthreads();
    u16* sKt = (u16*)(smem + 3072 + 65536);
    u16* sVt = sKt + 128 * 136;
    {
        uint4 kq[4], vq[4];
#pragma unroll
        for (int i = 0; i < 4; ++i) {
            const int cidx = tid + NTHREADS * i, row = cidx >> 4, ch = cidx & 15;
            kq[i] = *(const uint4*)(KB + (size_t)(m0 + row) * 512 + h * 128 + ch * 8);
            vq[i] = *(const uint4*)(VBT + (size_t)row * len + ch * 8);
        }
#pragma unroll
        for (int i = 0; i < 4; ++i) {
            const int cidx = tid + NTHREADS * i, row = cidx >> 4, ch = cidx & 15;
            *(uint4*)(sKt + row * 136 + ch * 8) = kq[i];
            *(uint4*)(sVt + row * 136 + ch * 8) = vq[i];
        }
    }
    const int sd = (tid >> 7) & 1, ss = tid & 127;
    if (tid < 256) {
        const int chain_d = (b * 4 + h) * 2 + sd;
        const int pc_d = (sd ? nseg - 1 - oc : oc) + (isctx ? 0 : 2);
        sI[tid] = P.gates[(size_t)(m0 + ss) * 16 + sd * 8 + h];
        sB[tid] = P.gb[(size_t)(chain_d * 34 + pc_d) * 128 + ss];
        sX[tid] = P.gx[(size_t)(chain_d * 34 + pc_d) * 128 + ss];
    }
    __syncthreads();
    const int t = wave * 16 + l15;
    s16x8 qf[4];
#pragma unroll
    for (int ks = 0; ks < 4; ++ks) qf[ks] = as_frag(*(const uint4*)(QB + (size_t)(m0 + t) * 512 + h * 128 + ks * 32 + quad * 8));
    float* sH = sX + 256;
    f32x4 hsum[8];
#pragma unroll 1
    for (int dir = 0; dir < 2; ++dir) {
        const int chain = (b * 4 + h) * 2 + dir;
        const int pc = (dir ? nseg - 1 - oc : oc) + (isctx ? 0 : 2);
        const float mst = P.mst[chain * 34 + pc];
        const float bt = sB[dir * 128 + t];
        const float mt = fmaxf(bt + mst, bt + sX[dir * 128 + t]);
        const float winter = __expf(bt + mst - mt);
        const u16* ST = P.slot[5] + (size_t)(chain * 34 + pc) * 16384;
        const float* NS = P.mnu + (size_t)(chain * 34 + pc) * 128;
        f32x4 acc[8];
#pragma unroll
        for (int et = 0; et < 8; ++et) {
            acc[et] = (f32x4){0.f, 0.f, 0.f, 0.f};
#pragma unroll
            for (int ks = 0; ks < 4; ++ks) {
                s16x8 a = as_frag(*(const uint4*)(ST + (et * 16 + l15) * 128 + ks * 32 + quad * 8));
                acc[et] = mfma16(a, qf[ks], acc[et]);
            }
            acc[et][0] *= winter; acc[et][1] *= winter; acc[et][2] *= winter; acc[et][3] *= winter;
        }
        float qn = 0.f;
#pragma unroll
        for (int ks = 0; ks < 4; ++ks) {
            const float* np = NS + ks * 32 + quad * 8;
#pragma unroll
            for (int q = 0; q < 8; ++q) qn += bf2f((u16)qf[ks][q]) * np[q];
        }
        qn += __shfl_xor(qn, 16); qn += __shfl_xor(qn, 32);
        float den = 0.f;
        for (int sb = 0; sb < 4; ++sb) {
            if (dir == 0 ? (2 * sb > wave) : (2 * sb + 1 < wave)) continue;
            float sv[2][4];
#pragma unroll
            for (int hh = 0; hh < 2; ++hh) {
                const int st = 2 * sb + hh;
                f32x4 a4 = (f32x4){0.f, 0.f, 0.f, 0.f};
#pragma unroll
                for (int ks = 0; ks < 4; ++ks) {
                    s16x8 a = as_frag(*(const uint4*)(sKt + (st * 16 + l15) * 136 + ks * 32 + quad * 8));
                    a4 = mfma16(a, qf[ks], a4);
                }
#pragma unroll
                for (int r = 0; r < 4; ++r) {
                    const int s = st * 16 + quad * 4 + r;
                    const bool valid = dir ? (s >= t) : (s <= t);
                    const float dv = valid ? __expf(bt - sB[dir * 128 + s] + sI[dir * 128 + s] - mt) : 0.f;
                    sv[hh][r] = a4[r] * dv; den += sv[hh][r];
                }
            }
            uint4 pb;
            pb.x = pack2(sv[0][0], sv[0][1]); pb.y = pack2(sv[0][2], sv[0][3]);
            pb.z = pack2(sv[1][0], sv[1][1]); pb.w = pack2(sv[1][2], sv[1][3]);
            const s16x8 bfrag = as_frag(pb);
#pragma unroll
            for (int et = 0; et < 8; ++et) {
                const u16* vr = sVt + (et * 16 + l15) * 136 + sb * 32 + quad * 4;
                uint2 lo = *(const uint2*)vr, hi = *(const uint2*)(vr + 16);
                acc[et] = mfma16(as_frag(make_uint4(lo.x, lo.y, hi.x, hi.y)), bfrag, acc[et]);
            }
        }
        den += __shfl_xor(den, 16); den += __shfl_xor(den, 32);
        den += winter * qn;
        const float hs = 1.f / fmaxf(fabsf(den), __expf(-mt));
#pragma unroll
        for (int et = 0; et < 8; ++et) {
#pragma unroll
            for (int r = 0; r < 4; ++r) {
                if (dir == 0) sH[(et * 4 + r) * NTHREADS + tid] = acc[et][r] * hs;
                else hsum[et][r] = sH[(et * 4 + r) * NTHREADS + tid] + acc[et][r] * hs;
            }
        }
    }
    float sq = 0.f;
#pragma unroll
    for (int et = 0; et < 8; ++et) sq += hsum[et][0] * hsum[et][0] + hsum[et][1] * hsum[et][1] + hsum[et][2] * hsum[et][2] + hsum[et][3] * hsum[et][3];
    sq += __shfl_xor(sq, 16); sq += __shfl_xor(sq, 32);
    const float rinv = rsqrtf(sq * (1.f / 128.f) + 1e-6f);
    const float* hn = P.in[11] + h * 128;
#pragma unroll
    for (int et = 0; et < 8; ++et) {
        const int e = et * 16 + quad * 4;
        uint2 ob = *(const uint2*)(OB + (size_t)(m0 + t) * 512 + h * 128 + e);
        float o0 = hsum[et][0] * rinv * hn[e + 0] * sigmoidf_(lo2f(ob.x));
        float o1 = hsum[et][1] * rinv * hn[e + 1] * sigmoidf_(hi2f(ob.x));
        float o2 = hsum[et][2] * rinv * hn[e + 2] * sigmoidf_(lo2f(ob.y));
        float o3 = hsum[et][3] * rinv * hn[e + 3] * sigmoidf_(hi2f(ob.y));
        uint2 q; q.x = pack2(o0, o1); q.y = pack2(o2, o3);
        *(uint2*)(CAT + (size_t)(m0 + t) * 1024 + 512 + h * 128 + e) = q;
    }
}

constexpr int TB = 32;
constexpr int SBUF = 6 * TB * 64 + 2 * TB;
#define DPP4(ctrl) asm volatile( \
    "v_add_f32_dpp %0, %0, %0 " ctrl " row_mask:0xf bank_mask:0xf bound_ctrl:1\n" \
    "v_add_f32_dpp %1, %1, %1 " ctrl " row_mask:0xf bank_mask:0xf bound_ctrl:1\n" \
    "v_add_f32_dpp %2, %2, %2 " ctrl " row_mask:0xf bank_mask:0xf bound_ctrl:1\n" \
    "v_add_f32_dpp %3, %3, %3 " ctrl " row_mask:0xf bank_mask:0xf bound_ctrl:1\n" \
    : "+v"(sa0), "+v"(sa1), "+v"(sw0), "+v"(sw1))
typedef float v2f __attribute__((ext_vector_type(2)));
__device__ __forceinline__ v2f pkfma(v2f a, v2f b, v2f c) { return __builtin_elementwise_fma(a, b, c); }

__device__ __forceinline__ void phase_scan(const Params& P, char* smem) {
    const int tid = get_tid(), lane = tid & 63, wave = tid >> 6;
    float* sBuf = (float*)smem;
    float* sYb = sBuf + 2 * SBUF;
    const u16* R = P.slot[1]; const u16* K = P.slot[2]; const u16* V = P.slot[3];
    constexpr int NBLK = 8 + 128;
    for (int chain = blockIdx.x; chain < 256; chain += gridDim.x) {
        const int z = chain & 1, hd = (chain >> 1) & 15, b = chain >> 5;
        u16* EY = z ? P.slot[5] : P.slot[4];
        const u8* AZ = (const u8*)P.slot[0] + (size_t)z * MA * 1024;
        const int ptid = tid & 255;
        const int scg = ptid & 15, sn = hd * 64 + scg * 4;
        const float4 kk4 = *(const float4*)(P.in[23] + sn), ka4 = *(const float4*)(P.in[24] + sn), rk4 = *(const float4*)(P.in[25] + sn);
        const float kkv[4] = {kk4.x, kk4.y, kk4.z, kk4.w}, kav[4] = {ka4.x, ka4.y, ka4.z, ka4.w}, rkv[4] = {rk4.x, rk4.y, rk4.z, rk4.w};
        const int rg = lane >> 3, cgq = lane & 7, row0 = (wave & 3) * 16 + rg * 2;
        v2f S[2][4];
#pragma unroll
        for (int i = 0; i < 2; ++i)
#pragma unroll
            for (int j = 0; j < 4; ++j) S[i][j] = (v2f){0.f, 0.f};
        __syncthreads();
        for (int it = 0; it < NBLK + 2; ++it) {
            if (wave >= 4) {
                if (it < NBLK) {
                    const bool lat = it >= 8;
                    const int len = lat ? 4096 : 256;
                    float* sb = sBuf + (it & 1) * SBUF;
#pragma unroll
                    for (int half = 0; half < 2; ++half) {
                        const int sp = (ptid >> 4) + 16 * half;
                        const int pos = (lat ? it - 8 : it) * TB + sp;
                        const int tok = z ? len - 1 - pos : pos;
                        const int m = lat ? b * 4096 + tok : ML + b * 256 + tok;
                        const size_t o = (size_t)m * 1024 + sn;
                        const uint2 r2 = *(const uint2*)(R + o), k2 = *(const uint2*)(K + o), v2 = *(const uint2*)(V + o), e2 = *(const uint2*)(EY + o);
                        const unsigned a4 = *(const unsigned*)(AZ + o);
                        const float kn = P.knorm[(size_t)m * 16 + hd];
                        const float rv[4] = {lo2f(r2.x), hi2f(r2.x), lo2f(r2.y), hi2f(r2.y)};
                        const float kv[4] = {lo2f(k2.x), hi2f(k2.x), lo2f(k2.y), hi2f(k2.y)};
                        const float vv[4] = {lo2f(v2.x), hi2f(v2.x), lo2f(v2.y), hi2f(v2.y)};
                        const float ev[4] = {lo2f(e2.x), hi2f(e2.x), lo2f(e2.y), hi2f(e2.y)};
                        float dec[4], an[4], bb[4], kd[4], wr[4];
                        float br = 0.f, kr = 0.f, cf = 0.f;
#pragma unroll
                        for (int q = 0; q < 4; ++q) {
                            const float a = (float)((a4 >> (8 * q)) & 255u) * (1.f / 255.f);
                            const float kkn = kv[q] * kkv[q] * kn;
                            an[q] = -kkn; bb[q] = kkn * a;
                            kd[q] = kv[q] * (1.f + (a - 1.f) * kav[q]);
                            dec[q] = __expf(-ev[q]);
                            wr[q] = dec[q] * rv[q];
                            br += bb[q] * rv[q]; kr += kd[q] * rv[q]; cf += rv[q] * kd[q] * rkv[q];
                        }
                        br = sum16(br); kr = sum16(kr); cf = sum16(cf);
                        const int lo = sp * 64 + scg * 4;
                        *(float4*)(sb + 0 * TB * 64 + lo) = make_float4(dec[0], dec[1], dec[2], dec[3]);
                        *(float4*)(sb + 1 * TB * 64 + lo) = make_float4(an[0], an[1], an[2], an[3]);
                        *(float4*)(sb + 2 * TB * 64 + lo) = make_float4(bb[0], bb[1], bb[2], bb[3]);
                        *(float4*)(sb + 3 * TB * 64 + lo) = make_float4(kd[0], kd[1], kd[2], kd[3]);
                        *(float4*)(sb + 4 * TB * 64 + lo) = make_float4(wr[0], wr[1], wr[2], wr[3]);
                        *(float4*)(sb + 5 * TB * 64 + lo) = make_float4(vv[0], vv[1], vv[2], vv[3]);
                        if (scg == 0) {
                            sb[6 * TB * 64 + sp] = br; sb[6 * TB * 64 + TB + sp] = kr;
                            if (lat) P.coef[(size_t)z * ML * 16 + (size_t)m * 16 + hd] = cf;
                        }
                    }
                }
                if (it >= 10) {
                    const int jb = it - 2;
                    const int sp = ptid >> 3, c8 = (ptid & 7) * 8;
                    const int pos = (jb - 8) * TB + sp;
                    const int tok = z ? 4095 - pos : pos;
                    const float* yb = sYb + (jb & 1) * TB * 64 + sp * 64 + c8;
                    const float4 y0 = *(const float4*)yb, y1 = *(const float4*)(yb + 4);
                    uint4 q; q.x = pack2(y0.x, y0.y); q.y = pack2(y0.z, y0.w); q.z = pack2(y1.x, y1.y); q.w = pack2(y1.z, y1.w);
                    *(uint4*)(EY + (size_t)(b * 4096 + tok) * 1024 + hd * 64 + c8) = q;
                }
            } else if (it >= 1 && it <= NBLK) {
                const int jb = it - 1;
                const bool lat = jb >= 8;
                const float* sb = sBuf + (jb & 1) * SBUF;
                float* sy = sYb + (jb & 1) * TB * 64;
                struct StepP { float4 dA, dB, aA, aB, bA, bB, kA, kB, wA, wB; float2 v2; float br, kr; };
#define LOADP(X, p_) do { const float* pp = sb + (p_) * 64 + cgq * 8; \
                    X.dA = *(const float4*)(pp + 0 * TB * 64); X.dB = *(const float4*)(pp + 0 * TB * 64 + 4); \
                    X.aA = *(const float4*)(pp + 1 * TB * 64); X.aB = *(const float4*)(pp + 1 * TB * 64 + 4); \
                    X.bA = *(const float4*)(pp + 2 * TB * 64); X.bB = *(const float4*)(pp + 2 * TB * 64 + 4); \
                    X.kA = *(const float4*)(pp + 3 * TB * 64); X.kB = *(const float4*)(pp + 3 * TB * 64 + 4); \
                    X.wA = *(const float4*)(pp + 4 * TB * 64); X.wB = *(const float4*)(pp + 4 * TB * 64 + 4); \
                    X.v2 = *(const float2*)(sb + 5 * TB * 64 + (p_) * 64 + row0); \
                    X.br = sb[6 * TB * 64 + (p_)]; X.kr = sb[6 * TB * 64 + TB + (p_)]; } while (0)
                __builtin_amdgcn_s_setprio(3);
                StepP cur, nxt;
                LOADP(cur, 0);
                nxt = cur;
#pragma unroll 8
                for (int p = 0; p < TB; ++p) {
                    LOADP(nxt, p + 1);
                    const float4 dA = cur.dA, dB = cur.dB, aA = cur.aA, aB = cur.aB, bA = cur.bA, bB = cur.bB, kA = cur.kA, kB = cur.kB, wA = cur.wA, wB = cur.wB;
                    const float2 v2 = cur.v2; const float br = cur.br, kr = cur.kr;
                    const v2f d2[4] = {{dA.x, dA.y}, {dA.z, dA.w}, {dB.x, dB.y}, {dB.z, dB.w}};
                    const v2f a2[4] = {{aA.x, aA.y}, {aA.z, aA.w}, {aB.x, aB.y}, {aB.z, aB.w}};
                    const v2f b2[4] = {{bA.x, bA.y}, {bA.z, bA.w}, {bB.x, bB.y}, {bB.z, bB.w}};
                    const v2f k2[4] = {{kA.x, kA.y}, {kA.z, kA.w}, {kB.x, kB.y}, {kB.z, kB.w}};
                    const v2f w2[4] = {{wA.x, wA.y}, {wA.z, wA.w}, {wB.x, wB.y}, {wB.z, wB.w}};
                    v2f t0 = S[0][0] * a2[0], t1 = S[1][0] * a2[0], u0 = S[0][0] * w2[0], u1 = S[1][0] * w2[0];
#pragma unroll
                    for (int q = 1; q < 4; ++q) {
                        t0 = pkfma(S[0][q], a2[q], t0); t1 = pkfma(S[1][q], a2[q], t1);
                        u0 = pkfma(S[0][q], w2[q], u0); u1 = pkfma(S[1][q], w2[q], u1);
                    }
                    float sa0 = t0.x + t0.y, sa1 = t1.x + t1.y, sw0 = u0.x + u0.y, sw1 = u1.x + u1.y;
                    asm volatile("s_nop 1" ::: );
                    DPP4("quad_perm:[1,0,3,2]");
                    DPP4("quad_perm:[2,3,0,1]");
                    DPP4("row_half_mirror");
                    const v2f va = {v2.x, v2.x}, vb = {v2.y, v2.y}, s0 = {sa0, sa0}, s1 = {sa1, sa1};
#pragma unroll
                    for (int q = 0; q < 4; ++q) {
                        S[0][q] = pkfma(S[0][q], d2[q], pkfma(s0, b2[q], va * k2[q]));
                        S[1][q] = pkfma(S[1][q], d2[q], pkfma(s1, b2[q], vb * k2[q]));
                    }
                    *(float2*)(sy + p * 64 + row0) = make_float2(sw0 + sa0 * br + v2.x * kr, sw1 + sa1 * br + v2.y * kr);
                    cur = nxt;
                }
#undef LOADP
                __builtin_amdgcn_s_setprio(0);
            }
            __syncthreads();
        }
    }
}

__device__ __forceinline__ void phase_z(const Params& P) {
    const int lane = get_tid() & 63, wave = get_tid() >> 6;
    const int n0 = lane * 16, hd = lane >> 2;
    float lw[16], lb[16];
#pragma unroll
    for (int q = 0; q < 16; ++q) { lw[q] = P.in[26][n0 + q]; lb[q] = P.in[27][n0 + q]; }
    const u16* __restrict__ YF = P.slot[4]; const u16* __restrict__ YB = P.slot[5]; const u16* __restrict__ V = P.slot[3]; const u16* __restrict__ G = P.slot[2];
    u16* __restrict__ Z = P.slot[1];
    const float* __restrict__ coefp = P.coef;
#pragma unroll 4
    for (int m = blockIdx.x * 8 + wave; m < ML; m += gridDim.x * 8) {
        const size_t o = (size_t)m * 1024 + n0;
        const uint4 f0 = *(const uint4*)(YF + o), f1 = *(const uint4*)(YF + o + 8);
        const uint4 b0 = *(const uint4*)(YB + o), b1 = *(const uint4*)(YB + o + 8);
        const uint4 v0 = *(const uint4*)(V + o), v1 = *(const uint4*)(V + o + 8);
        const uint4 g0 = *(const uint4*)(G + o), g1 = *(const uint4*)(G + o + 8);
        const float cf = coefp[(size_t)m * 16 + hd] + coefp[(size_t)ML * 16 + (size_t)m * 16 + hd];
        const unsigned fw[8] = {f0.x, f0.y, f0.z, f0.w, f1.x, f1.y, f1.z, f1.w};
        const unsigned bw[8] = {b0.x, b0.y, b0.z, b0.w, b1.x, b1.y, b1.z, b1.w};
        const unsigned vw[8] = {v0.x, v0.y, v0.z, v0.w, v1.x, v1.y, v1.z, v1.w};
        const unsigned gw[8] = {g0.x, g0.y, g0.z, g0.w, g1.x, g1.y, g1.z, g1.w};
        float y[16], s = 0.f;
#pragma unroll
        for (int q = 0; q < 8; ++q) {
            y[2 * q] = lo2f(fw[q]) + lo2f(bw[q]); y[2 * q + 1] = hi2f(fw[q]) + hi2f(bw[q]);
            s += y[2 * q] + y[2 * q + 1];
        }
        s += dppf<0xB1>(s); s += dppf<0x4E>(s);
        const float mean = s * (1.f / 64.f);
        float vs = 0.f;
#pragma unroll
        for (int q = 0; q < 16; ++q) { const float d = y[q] - mean; vs += d * d; }
        vs += dppf<0xB1>(vs); vs += dppf<0x4E>(vs);
        const float rinv = rsqrtf(vs * (1.f / 64.f) + 64e-5f);
        unsigned ow[8];
#pragma unroll
        for (int q = 0; q < 8; ++q) {
            const float z0 = ((y[2 * q] - mean) * rinv * lw[2 * q] + lb[2 * q] + cf * lo2f(vw[q])) * lo2f(gw[q]);
            const float z1 = ((y[2 * q + 1] - mean) * rinv * lw[2 * q + 1] + lb[2 * q + 1] + cf * hi2f(vw[q])) * hi2f(gw[q]);
            ow[q] = pack2(z0, z1);
        }
        *(uint4*)(Z + o) = make_uint4(ow[0], ow[1], ow[2], ow[3]);
        *(uint4*)(Z + o + 8) = make_uint4(ow[4], ow[5], ow[6], ow[7]);
    }
}

__device__ __forceinline__ void do_phase(const Params& P, const int ph, char* smem) {
        switch (ph) {
        case 0: phase_prep(P, smem); break;
        case 1: phase_norm(P, 0, P.slot[0], MA); break;
        case 2: { Epi E{E_INPROJ, 0, 0, nullptr, 0}; gemm_single(P, P.slot[0], 1024, P.wint, 1024, 15, MA / BM, E, smem); } break;
        case 3: phase_mix0(P, smem); break;
        case 4: phase_mlscan(P); break;
        case 5: for (int u = blockIdx.x; u < 8 * 4 * 34; u += gridDim.x) ml_c3_unit(P, u / 136, (u / 34) & 3, u % 34, smem); break;
        case 6: { Epi E{E_OUT0, 0, 0, nullptr, 0}; gemm_single(P, P.slot[0], 1024, P.woutt, 1024, 4, MA / BM, E, smem); } break;
        case 7: phase_norm(P, 1, P.slot[0], MA); break;
        case 8: { Epi E{E_MLPUP, 0, 0, P.slot[1], 4096}; gemm_single(P, P.slot[0], 1024, P.w1t[0], 1024, 16, MA / BM, E, smem); } break;
        case 9: phase_mlpdn0(P, smem); break;
        case 10: phase_norm(P, 2, P.slot[0], MA); break;
        case 11: phase_rw1(P, smem); break;
        case 12: phase_rw2(P, smem); break;
        case 13: phase_scan(P, smem); break;
        case 14: { Epi E{E_HA, 1, 0, P.slot[2], 1024}; gemm_single(P, P.hg, 192, P.lg2t, 192, 4, ML / BM, E, smem); } break;
        case 19: phase_z(P); break;
        case 15: { Epi E{E_RWOUT, 1, 0, nullptr, 0}; gemm_single(P, P.slot[1], 1024, P.wot, 1024, 4, ML / BM, E, smem); } break;
        case 16: phase_norm(P, 3, P.slot[0], ML); break;
        case 17: { Epi E{E_MLPUP, 1, 0, P.slot[1], 4096}; gemm_single(P, P.slot[0], 1024, P.w1t[1], 1024, 16, ML / BM, E, smem); } break;
        case 18: { Epi E{E_MLPDN, 1, 0, nullptr, 0}; gemm_single(P, P.slot[1], 4096, P.w2t[1], 4096, 4, ML / BM, E, smem); } break;
        default: break;
        }
}

__global__ void __launch_bounds__(NTHREADS) mega(Params P) {
    extern __shared__ __align__(16) char smem[];
#if ONE_LAUNCH
    cg::grid_group grid = cg::this_grid();
    __shared__ unsigned xb_words[4];
    if (threadIdx.x == 0) { xb_words[0] = 0u; xb_words[1] = 0u; }
    __syncthreads();
    const XcdBarrier xb = xcd_barrier_post(P.bar, (volatile LAS unsigned*)&xb_words);
#define PH(n) do_phase(P, n, smem); xcd_barrier(xb);
    do_phase(P, 0, smem); grid.sync();
    PH(1) PH(2) PH(3) PH(4) PH(5) PH(6) PH(7) PH(8) PH(9) PH(10) PH(11) PH(12) PH(13) PH(14) PH(19) PH(15) PH(16) PH(17)
    do_phase(P, 18, smem);
#undef PH
#else
    do_phase(P, P.ph_lo, smem);
#endif
}

extern "C" void kernel_launch(void* const* d_in, const int* in_sizes, int n_in, void* d_out, int out_size, void* d_ws, size_t ws_size,
                              hipStream_t stream) {
    static int grid = 0;
    if (grid == 0) {
        int dev = 0, cus = 0, per_cu = 0;
        hipGetDevice(&dev);
        hipDeviceGetAttribute(&cus, hipDeviceAttributeMultiprocessorCount, dev);
        hipFuncSetAttribute((const void*)mega, hipFuncAttributeMaxDynamicSharedMemorySize, LDS_BYTES);
        hipOccupancyMaxActiveBlocksPerMultiprocessor(&per_cu, (const void*)mega, NTHREADS, LDS_BYTES);
        if (per_cu < 1) { fprintf(stderr, "occupancy query says %d blocks/CU\n", per_cu); per_cu = 1; }
        grid = cus;
        if (grid <= 0) grid = 256;
    }
    Params P{};
    for (int i = 0; i < 31; ++i) P.in[i] = (const float*)d_in[i];
    P.out = (float*)d_out;
    char* w = (char*)d_ws;
    size_t off = 0;
    auto take = [&](size_t bytes) { char* p = w + off; off += (bytes + 255) & ~(size_t)255; return p; };
    for (int i = 0; i < 6; ++i) P.slot[i] = (u16*)take(SLOT);
    P.w1t[1] = (u16*)take((size_t)4096 * 1024 * 2);
    P.w2t[1] = (u16*)take((size_t)4096 * 1024 * 2);
    P.rkvt = (u16*)take((size_t)3 * 1024 * 1024 * 2);
    P.wot = (u16*)take((size_t)1024 * 1024 * 2);
    P.lw1t = (u16*)take(256 * 1024 * 2);
    P.la1t = (u16*)take(256 * 1024 * 2);
    P.lg1t = (u16*)take(256 * 1024 * 2);
    P.lw2t = (u16*)take(2 * 1024 * 64 * 2);
    P.la2t = (u16*)take(2 * 1024 * 64 * 2);
    P.lg2t = (u16*)take(1024 * 192 * 2);
    P.bar = (unsigned*)take(XCD_BAR_WORDS * 4);
    P.mod = (float*)take(2 * 9 * 6144 * 4);
    P.ropec = (float*)take(64 * 32 * 4);
    P.ropes = (float*)take(64 * 32 * 4);
    const size_t ov = off;
    P.wint = (u16*)take((size_t)3840 * 1024 * 2);
    P.woutt = (u16*)take((size_t)1024 * 1024 * 2);
    P.w1t[0] = (u16*)take((size_t)4096 * 1024 * 2);
    P.w2t[0] = (u16*)take((size_t)4096 * 1024 * 2);
    P.gates = (float*)take((size_t)MA * 16 * 4);
    P.ctxres = (float*)take((size_t)MC * 1024 * 4);
    P.mbc = (float*)take(64 * 34 * 4);
    P.mmc = (float*)take(64 * 34 * 4);
    P.mst = (float*)take(64 * 34 * 4);
    P.mnu = (float*)take((size_t)64 * 34 * 128 * 4);
    P.gb = (float*)take((size_t)64 * 34 * 128 * 4);
    P.gx = (float*)take((size_t)64 * 34 * 128 * 4);
    const size_t end0 = off;
    off = ov;
    P.knorm = (float*)take((size_t)MA * 16 * 4);
    P.coef = (float*)take((size_t)2 * ML * 16 * 4);
    P.hw = (u16*)take((size_t)MA * 128 * 2);
    P.ha = (u16*)take((size_t)MA * 128 * 2);
    P.hg = (u16*)take((size_t)MA * 192 * 2);
    const size_t end1 = off;
    const size_t need = end0 > end1 ? end0 : end1;
    if (need > ws_size || n_in != 31) { fprintf(stderr, "kernel_launch: need %zu bytes of ws, have %zu (n_in %d)\n", need, ws_size, n_in); return; }
#if ONE_LAUNCH
    P.ph_lo = 0; P.ph_hi = NPHASES;
    if (hipMemsetAsync(P.bar, 0, XCD_BAR_WORDS * 4, stream) != hipSuccess) { fprintf(stderr, "barrier memset failed\n"); return; }
    void* args[] = {&P};
    hipError_t e = hipLaunchCooperativeKernel((const void*)mega, dim3(grid), dim3(NTHREADS), args, LDS_BYTES, stream);
    if (e != hipSuccess) fprintf(stderr, "cooperative launch failed: %s\n", hipGetErrorString(e));
#else
    for (int ph = 0; ph < NPHASES; ++ph) {
        P.ph_lo = ph; P.ph_hi = ph + 1;
        hipLaunchKernelGGL(mega, dim3(grid), dim3(NTHREADS), LDS_BYTES, stream, P);
    }
#endif
}
```
